# Optimizing an MI355X kernel written in HIP

```python
import math
import jax, jax.numpy as jnp
from jax import lax
import numpy as np


D_MODEL = 2048
BATCH = 2
SEQ = 4096
DEPTH = 4

N_MIXERS = 4
HEAD_DIM = 128
N_SB_HEADS = D_MODEL // HEAD_DIM
N_FOX_HEADS = D_MODEL // HEAD_DIM
SWA_HEAD_DIM = 64
N_SWA_HEADS = D_MODEL // SWA_HEAD_DIM
N_SWA_KV_HEADS = N_SWA_HEADS // 8
WINDOW = 128
MLA_HEADS = D_MODEL // 128
Q_LORA = D_MODEL // 4
KV_LORA = D_MODEL // 8
QK_NOPE = 128
QK_ROPE = 64
V_HEAD = 128
ROPE_THETA = 10000.0
MEM_LEN = 256
MEM_HEADS = 4
MEM_HEAD_DIM = 128
D_FF = ((8 * D_MODEL // 3 + 255) // 256) * 256
CONV_WIDTH = 3
NUM_BUCKETS = 32
MAX_DISTANCE = 128
Q_BLOCK = 128
EPS = 1e-6

SB_W = N_SB_HEADS * HEAD_DIM
FOX_W = N_FOX_HEADS * HEAD_DIM
SWA_W = N_SWA_HEADS * SWA_HEAD_DIM
SWA_KV_W = N_SWA_KV_HEADS * SWA_HEAD_DIM
MLA_W = MLA_HEADS * V_HEAD
MEM_W = MEM_HEADS * MEM_HEAD_DIM

kernel_name = 'hybrid_interleaved_sb_fox_swa_mla'


def _n_uses(m):
    return (DEPTH - m + N_MIXERS - 1) // N_MIXERS


def _rmsnorm(x, g):
    x32 = x.astype(jnp.float32)
    y = x32 * lax.rsqrt(jnp.mean(x32 * x32, axis=-1, keepdims=True) + EPS)
    return y.astype(x.dtype) * g


def _to_blocks(a):
    B, H, S = a.shape[:3]
    a = a.reshape((B, H, S // Q_BLOCK, Q_BLOCK) + a.shape[3:])
    return jnp.moveaxis(a, 2, 0)


def _from_blocks(a):
    nb, B, H, qb = a.shape[:4]
    return jnp.moveaxis(a, 0, 2).reshape((B, H, nb * qb) + a.shape[4:])


def _stick_breaking_attention(q, k, v):
    S = q.shape[2]
    scale = q.shape[-1] ** -0.5
    kpos = jnp.arange(S)

    def block(xs):
        qb, i = xs
        qpos = i * Q_BLOCK + jnp.arange(Q_BLOCK)
        z = jnp.einsum('bhqd,bhkd->bhqk', qb, k).astype(jnp.float32) * scale
        strict = kpos[None, :] < qpos[:, None]
        log_keep = jnp.where(strict, jax.nn.log_sigmoid(-z), 0.0)
        log_after = lax.cumsum(log_keep, axis=3, reverse=True) - log_keep
        a = jnp.where(strict, jnp.exp(jax.nn.log_sigmoid(z) + log_after), 0.0)
        return jnp.einsum('bhqk,bhkd->bhqd', a.astype(v.dtype), v)

    out = lax.map(block, (_to_blocks(q), jnp.arange(S // Q_BLOCK)))
    return _from_blocks(out)


def _causal_softmax_attention(q, k, v, log_fcum=None):
    S = q.shape[2]
    scale = q.shape[-1] ** -0.5
    kpos = jnp.arange(S)
    nb = S // Q_BLOCK

    def block(xs):
        qb, i = xs[0], xs[1]
        qpos = i * Q_BLOCK + jnp.arange(Q_BLOCK)
        logits = jnp.einsum('bhqd,bhkd->bhqk', qb, k).astype(jnp.float32) * scale
        if log_fcum is not None:
            logits = logits + (xs[2][..., :, None] - log_fcum[:, :, None, :])
        logits = jnp.where(kpos[None, :] <= qpos[:, None], logits, -jnp.inf)
        p = jax.nn.softmax(logits, axis=-1)
        return jnp.einsum('bhqk,bhkd->bhqd', p.astype(v.dtype), v)

    if log_fcum is None:
        xs = (_to_blocks(q), jnp.arange(nb))
    else:
        xs = (_to_blocks(q), jnp.arange(nb), _to_blocks(log_fcum))
    return _from_blocks(lax.map(block, xs))


def _memory_attention(q_mem, mem_h, w_mem_kv):
    B, S, _ = q_mem.shape
    q = q_mem.reshape(B, S, MEM_HEADS, MEM_HEAD_DIM)
    kv = (mem_h @ w_mem_kv).reshape(B, mem_h.shape[1], 2, MEM_HEADS, MEM_HEAD_DIM)
    logits = jnp.einsum('bshd,bmhd->bhsm', q, kv[:, :, 0]).astype(jnp.float32) * MEM_HEAD_DIM ** -0.5
    p = jax.nn.softmax(logits, axis=-1)
    o = jnp.einsum('bhsm,bmhd->bshd', p.astype(q.dtype), kv[:, :, 1])
    return o.reshape(B, S, MEM_W)


def _heads(t, n, d):
    B, S, _ = t.shape
    return t.reshape(B, S, n, d).transpose(0, 2, 1, 3)


def _merge_heads(t):
    B, H, S, d = t.shape
    return t.transpose(0, 2, 1, 3).reshape(B, S, H * d)


def _sb_mixer(h, mem_h, w_in, w_mem_kv, w_out):
    q, k, v, q_mem = jnp.split(h @ w_in, [SB_W, 2 * SB_W, 3 * SB_W], axis=-1)
    o = _stick_breaking_attention(_heads(q, N_SB_HEADS, HEAD_DIM), _heads(k, N_SB_HEADS, HEAD_DIM),
                                  _heads(v, N_SB_HEADS, HEAD_DIM))
    o_mem = _memory_attention(q_mem, mem_h, w_mem_kv)
    return jnp.concatenate([_merge_heads(o), o_mem], axis=-1) @ w_out


def _fox_mixer(h, mem_h, w_in, b_f, w_mem_kv, w_out):
    q, k, v, f_logit, q_mem = jnp.split(
        h @ w_in, [FOX_W, 2 * FOX_W, 3 * FOX_W, 3 * FOX_W + N_FOX_HEADS], axis=-1)
    log_f = jax.nn.log_sigmoid((f_logit + b_f).astype(jnp.float32))
    log_fcum = jnp.cumsum(log_f, axis=1).transpose(0, 2, 1)
    o = _causal_softmax_attention(_heads(q, N_FOX_HEADS, HEAD_DIM), _heads(k, N_FOX_HEADS, HEAD_DIM),
                                  _heads(v, N_FOX_HEADS, HEAD_DIM), log_fcum)
    o_mem = _memory_attention(q_mem, mem_h, w_mem_kv)
    return jnp.concatenate([_merge_heads(o), o_mem], axis=-1) @ w_out


def _t5_bucket(dist):
    max_exact = NUM_BUCKETS // 2
    d = jnp.maximum(dist, 1).astype(jnp.float32)
    large = max_exact + (jnp.log(d / max_exact) / math.log(MAX_DISTANCE / max_exact)
                         * (NUM_BUCKETS - max_exact)).astype(jnp.int32)
    return jnp.where(dist < max_exact, dist, jnp.minimum(large, NUM_BUCKETS - 1))


def _swa_mixer(h, mem_h, rel_bias, w_in, sinks, w_mem_kv, w_out):
    B, S, _ = h.shape
    q, k, v, q_mem = jnp.split(h @ w_in, [SWA_W, SWA_W + SWA_KV_W, SWA_W + 2 * SWA_KV_W], axis=-1)
    nb = S // WINDOW
    G = N_SWA_HEADS // N_SWA_KV_HEADS
    qb = q.reshape(B, nb, WINDOW, N_SWA_KV_HEADS, G, SWA_HEAD_DIM)

    def window_keys(t):
        t = jnp.pad(t.reshape(B, S, N_SWA_KV_HEADS, SWA_HEAD_DIM), ((0, 0), (WINDOW, 0), (0, 0), (0, 0)))
        t = t.reshape(B, nb + 1, WINDOW, N_SWA_KV_HEADS, SWA_HEAD_DIM)
        return jnp.concatenate([t[:, :-1], t[:, 1:]], axis=2)

    kw, vw = window_keys(k), window_keys(v)
    logits = jnp.einsum('bnqhgd,bnkhd->bnhgqk', qb, kw).astype(jnp.float32) * SWA_HEAD_DIM ** -0.5
    qi = jnp.arange(WINDOW)[:, None]
    kj = jnp.arange(2 * WINDOW)[None, :]
    dist = WINDOW + qi - kj
    band = (dist >= 0) & (dist < WINDOW)
    real = (jnp.arange(nb)[:, None, None] * WINDOW + kj[None] - WINDOW) >= 0
    mask = band[None] & real
    bias = rel_bias[_t5_bucket(jnp.maximum(dist, 0))]
    bias = bias.transpose(2, 0, 1).reshape(N_SWA_KV_HEADS, G, WINDOW, 2 * WINDOW)
    logits = jnp.where(mask[None, :, None, None], logits + bias.astype(jnp.float32), -jnp.inf)
    sink = sinks.reshape(N_SWA_KV_HEADS, G)[None, None, :, :, None, None].astype(jnp.float32)
    m = jnp.maximum(jnp.max(logits, axis=-1, keepdims=True), sink)
    p = jnp.exp(logits - m)
    w = p / (jnp.sum(p, axis=-1, keepdims=True) + jnp.exp(sink - m))
    o = jnp.einsum('bnhgqk,bnkhd->bnqhgd', w.astype(vw.dtype), vw).reshape(B, S, SWA_W)
    o_mem = _memory_attention(q_mem, mem_h, w_mem_kv)
    return jnp.concatenate([o, o_mem], axis=-1) @ w_out


def _rope(x, positions):
    half = x.shape[-1] // 2
    inv_freq = ROPE_THETA ** (-jnp.arange(half, dtype=jnp.float32) / half)
    ang = positions.astype(jnp.float32)[:, :, None, None] * inv_freq
    cos, sin = jnp.cos(ang).astype(x.dtype), jnp.sin(ang).astype(x.dtype)
    x1, x2 = x[..., :half], x[..., half:]
    return jnp.concatenate([x1 * cos - x2 * sin, x2 * cos + x1 * sin], axis=-1)


def _mla_mixer(h, mem_h, positions, w_in, q_norm, w_uq, kv_norm, w_ukv, w_mem_kv, w_out):
    B, S, _ = h.shape
    c_q, c_kv, k_rope, q_mem = jnp.split(
        h @ w_in, [Q_LORA, Q_LORA + KV_LORA, Q_LORA + KV_LORA + QK_ROPE], axis=-1)
    q = (_rmsnorm(c_q, q_norm) @ w_uq).reshape(B, S, MLA_HEADS, QK_NOPE + QK_ROPE)
    kv = (_rmsnorm(c_kv, kv_norm) @ w_ukv).reshape(B, S, MLA_HEADS, QK_NOPE + V_HEAD)
    q_nope, q_pe = jnp.split(q, [QK_NOPE], axis=-1)
    k_nope, v = jnp.split(kv, [QK_NOPE], axis=-1)
    q_pe = _rope(q_pe, positions)
    k_pe = _rope(k_rope[:, :, None, :], positions)
    q = jnp.concatenate([q_nope, q_pe], axis=-1)
    k = jnp.concatenate([k_nope, jnp.broadcast_to(k_pe, (B, S, MLA_HEADS, QK_ROPE))], axis=-1)
    o = _causal_softmax_attention(q.transpose(0, 2, 1, 3), k.transpose(0, 2, 1, 3), v.transpose(0, 2, 1, 3))
    o_mem = _memory_attention(q_mem, mem_h, w_mem_kv)
    return jnp.concatenate([_merge_heads(o), o_mem], axis=-1) @ w_out


def _conv_ffn(h, w_up, conv_w, conv_b, w_down):
    S = h.shape[1]
    u = h @ w_up
    up = jnp.pad(u, ((0, 0), (CONV_WIDTH - 1, 0), (0, 0)))
    c = conv_b
    for tap in range(CONV_WIDTH):
        c = c + conv_w[tap] * up[:, tap:tap + S]
    gate, val = jnp.split(c, [D_FF], axis=-1)
    return (jax.nn.silu(gate) * val) @ w_down


def setup_inputs(seed: int = 0) -> dict:
    key = jax.random.key(seed)
    ks = iter(jax.random.split(key, 32))
    f32 = jnp.float32

    def w(shape, fan_in):
        return jax.random.normal(next(ks), shape, f32) * fan_in ** -0.5

    def gain(shape):
        return 1.0 + 0.05 * jax.random.normal(next(ks), shape, f32)

    na, nb, nc, nd = _n_uses(0), _n_uses(1), _n_uses(2), _n_uses(3)
    x = jax.random.normal(next(ks), (BATCH, SEQ, D_MODEL), f32)
    mem = jax.random.normal(next(ks), (BATCH, MEM_LEN, D_MODEL), f32)
    positions = (jax.random.randint(next(ks), (BATCH, 1), 0, 1024, dtype=jnp.int32)
                 + jnp.arange(SEQ, dtype=jnp.int32)[None, :])
    rel_bias = 0.5 * jax.random.normal(next(ks), (NUM_BUCKETS, N_SWA_HEADS), f32)
    attn_norm = gain((DEPTH, D_MODEL))
    mem_norm = gain((DEPTH, D_MODEL))
    w_mem_kv = w((DEPTH, D_MODEL, 2 * MEM_W), D_MODEL)
    ffn_norm = gain((DEPTH, D_MODEL))
    ffn_w_up = w((DEPTH, D_MODEL, 2 * D_FF), D_MODEL)
    ffn_conv_w = w((DEPTH, CONV_WIDTH, 2 * D_FF), CONV_WIDTH)
    ffn_conv_b = 0.02 * jax.random.normal(next(ks), (DEPTH, 2 * D_FF), f32)
    ffn_w_down = w((DEPTH, D_FF, D_MODEL), D_FF)
    final_norm = gain((D_MODEL,))
    sb_w_in = w((na, D_MODEL, 3 * SB_W + MEM_W), D_MODEL)
    sb_w_out = w((na, SB_W + MEM_W, D_MODEL), SB_W + MEM_W)
    fox_w_in = w((nb, D_MODEL, 3 * FOX_W + N_FOX_HEADS + MEM_W), D_MODEL)
    fox_b_f = 2.0 + 0.1 * jax.random.normal(next(ks), (nb, N_FOX_HEADS), f32)
    fox_w_out = w((nb, FOX_W + MEM_W, D_MODEL), FOX_W + MEM_W)
    swa_w_in = w((nc, D_MODEL, SWA_W + 2 * SWA_KV_W + MEM_W), D_MODEL)
    swa_sinks = 0.5 * jax.random.normal(next(ks), (nc, N_SWA_HEADS), f32)
    swa_w_out = w((nc, SWA_W + MEM_W, D_MODEL), SWA_W + MEM_W)
    mla_w_in = w((nd, D_MODEL, Q_LORA + KV_LORA + QK_ROPE + MEM_W), D_MODEL)
    mla_q_norm = gain((nd, Q_LORA))
    mla_w_uq = w((nd, Q_LORA, MLA_HEADS * (QK_NOPE + QK_ROPE)), Q_LORA)
    mla_kv_norm = gain((nd, KV_LORA))
    mla_w_ukv = w((nd, KV_LORA, MLA_HEADS * (QK_NOPE + V_HEAD)), KV_LORA)
    mla_w_out = w((nd, MLA_W + MEM_W, D_MODEL), MLA_W + MEM_W)
    return {'x': x, 'mem': mem, 'positions': positions, 'rel_bias': rel_bias,
            'attn_norm': attn_norm, 'mem_norm': mem_norm, 'w_mem_kv': w_mem_kv,
            'ffn_norm': ffn_norm, 'ffn_w_up': ffn_w_up, 'ffn_conv_w': ffn_conv_w,
            'ffn_conv_b': ffn_conv_b, 'ffn_w_down': ffn_w_down, 'final_norm': final_norm,
            'sb_w_in': sb_w_in, 'sb_w_out': sb_w_out,
            'fox_w_in': fox_w_in, 'fox_b_f': fox_b_f, 'fox_w_out': fox_w_out,
            'swa_w_in': swa_w_in, 'swa_sinks': swa_sinks, 'swa_w_out': swa_w_out,
            'mla_w_in': mla_w_in, 'mla_q_norm': mla_q_norm, 'mla_w_uq': mla_w_uq,
            'mla_kv_norm': mla_kv_norm, 'mla_w_ukv': mla_w_ukv, 'mla_w_out': mla_w_out}


def reference(x, mem, positions, rel_bias, attn_norm, mem_norm, w_mem_kv, ffn_norm, ffn_w_up,
              ffn_conv_w, ffn_conv_b, ffn_w_down, final_norm, sb_w_in, sb_w_out,
              fox_w_in, fox_b_f, fox_w_out, swa_w_in, swa_sinks, swa_w_out,
              mla_w_in, mla_q_norm, mla_w_uq, mla_kv_norm, mla_w_ukv, mla_w_out):
    for i in range(DEPTH):
        kind, j = i % N_MIXERS, i // N_MIXERS
        h = _rmsnorm(x, attn_norm[i])
        mem_h = _rmsnorm(mem, mem_norm[i])
        if kind == 0:
            y = _sb_mixer(h, mem_h, sb_w_in[j], w_mem_kv[i], sb_w_out[j])
        elif kind == 1:
            y = _fox_mixer(h, mem_h, fox_w_in[j], fox_b_f[j], w_mem_kv[i], fox_w_out[j])
        elif kind == 2:
            y = _swa_mixer(h, mem_h, rel_bias, swa_w_in[j], swa_sinks[j], w_mem_kv[i], swa_w_out[j])
        else:
            y = _mla_mixer(h, mem_h, positions, mla_w_in[j], mla_q_norm[j], mla_w_uq[j],
                           mla_kv_norm[j], mla_w_ukv[j], w_mem_kv[i], mla_w_out[j])
        x = x + y
        x = x + _conv_ffn(_rmsnorm(x, ffn_norm[i]), ffn_w_up[i], ffn_conv_w[i], ffn_conv_b[i], ffn_w_down[i])
    return _rmsnorm(x, final_norm)
```

```cpp
#include <hip/hip_runtime.h>
#include <hip/hip_cooperative_groups.h>
#include <cstdio>
#include <cstdint>
namespace cg = cooperative_groups;

#ifndef N_LAUNCH_MODE
#define N_LAUNCH_MODE 1
#endif

#ifndef RESCALE_ALWAYS
#define RESCALE_ALWAYS 1
#endif
#ifndef PROBE_GEMM_REPS
#define PROBE_GEMM_REPS 1
#endif
#ifndef PROBE_SYNC_EXTRA
#define PROBE_SYNC_EXTRA 0
#endif
#ifndef PROBE_ATT_REPS
#define PROBE_ATT_REPS 1
#endif
#define LAS __attribute__((address_space(3)))
typedef unsigned short bf16_t;
typedef short bf16x8 __attribute__((ext_vector_type(8)));
typedef float f32x4 __attribute__((ext_vector_type(4)));
typedef float f32x2 __attribute__((ext_vector_type(2)));
typedef unsigned u32x4 __attribute__((ext_vector_type(4)));
typedef unsigned u32x2 __attribute__((ext_vector_type(2)));

constexpr int T = 8192, D = 2048, SEQ = 4096, DFF = 5632, ATTW = 2560;
constexpr float LOG2E = 1.4426950408889634f;
constexpr int NTHR = 512, NWAVE = 8;
constexpr int LDS_BYTES = 140288;

constexpr size_t OFF_XR = 0;
constexpr size_t OFF_H = OFF_XR + (size_t)T * D * 4;
constexpr size_t OFF_PROJ = OFF_H + (size_t)T * D * 2;
constexpr size_t OFF_VT = OFF_PROJ + (size_t)T * 4608 * 2;
constexpr size_t OFF_ATT = OFF_VT + (size_t)2048 * T * 2;
constexpr size_t OFF_U = OFF_ATT + (size_t)T * ATTW * 2;
constexpr size_t OFF_G = OFF_U + (size_t)T * 11264 * 2;
constexpr size_t OFF_MEMH = OFF_G + (size_t)T * DFF * 2;
constexpr size_t OFF_MEMK = OFF_MEMH + (size_t)2048 * 2048 * 2;
constexpr size_t OFF_MEMVT = OFF_MEMK + (size_t)2048 * 2048 * 2;
constexpr size_t OFF_LF = OFF_MEMVT + (size_t)2048 * 2048 * 2;
constexpr size_t OFF_LFC = OFF_LF + (size_t)T * 16 * 4;
constexpr size_t OFF_BIAST = OFF_LFC + (size_t)32 * 4096 * 4;
constexpr size_t OFF_WF = OFF_BIAST + (size_t)32 * 128 * 4;
constexpr size_t OFF_CQN = OFF_WF + (size_t)16 * 2048 * 4;
constexpr size_t OFF_CKVN = OFF_CQN + (size_t)T * 512 * 2;
constexpr size_t OFF_KPE = OFF_CKVN + (size_t)T * 256 * 2;
constexpr size_t OFF_Q3 = OFF_KPE + (size_t)T * 64 * 2;
constexpr size_t OFF_KN = OFF_Q3 + (size_t)T * 3072 * 2;
constexpr size_t OFF_W = OFF_KN + (size_t)T * 2048 * 2;
constexpr size_t W_SB_IN1 = OFF_W;
constexpr size_t W_SB_V = W_SB_IN1 + (size_t)4608 * 2048 * 2;
constexpr size_t W_SB_OUT = W_SB_V + (size_t)2048 * 2048 * 2;
constexpr size_t W_FOX_IN1 = W_SB_OUT + (size_t)2048 * 2560 * 2;
constexpr size_t W_FOX_V = W_FOX_IN1 + (size_t)4608 * 2048 * 2;
constexpr size_t W_FOX_OUT = W_FOX_V + (size_t)2048 * 2048 * 2;
constexpr size_t W_SWA_IN1 = W_FOX_OUT + (size_t)2048 * 2560 * 2;
constexpr size_t W_SWA_V = W_SWA_IN1 + (size_t)2816 * 2048 * 2;
constexpr size_t W_SWA_OUT = W_SWA_V + (size_t)256 * 2048 * 2;
constexpr size_t W_MLA_IN = W_SWA_OUT + (size_t)2048 * 2560 * 2;
constexpr size_t W_MLA_UQ = W_MLA_IN + (size_t)1536 * 2048 * 2;
constexpr size_t W_MLA_KN = W_MLA_UQ + (size_t)3072 * 512 * 2;
constexpr size_t W_MLA_V = W_MLA_KN + (size_t)2048 * 256 * 2;
constexpr size_t W_MLA_OUT = W_MLA_V + (size_t)2048 * 256 * 2;
constexpr size_t W_MEMK = W_MLA_OUT + (size_t)2048 * 2560 * 2;
constexpr size_t W_MEMV = W_MEMK + (size_t)2048 * 2048 * 2;
constexpr size_t W_UP = W_MEMV + (size_t)2048 * 2048 * 2;
constexpr size_t W_DOWN = W_UP + (size_t)4 * 11264 * 2048 * 2;
constexpr size_t OFF_BAR = W_DOWN + (size_t)4 * 2048 * 5632 * 2;
constexpr size_t BAR_BYTES = 16384;
constexpr size_t OFF_SSQ = OFF_BAR + BAR_BYTES;
constexpr size_t WS_END = OFF_SSQ + (size_t)T * 32 * 4;

enum { I_X = 0, I_MEM, I_POS, I_RELB, I_ATTN_NORM, I_MEM_NORM, I_WMEMKV, I_FFN_NORM, I_WUP, I_CONVW, I_CONVB, I_WDOWN, I_FINAL_NORM,
       I_SB_IN, I_SB_OUT, I_FOX_IN, I_FOX_BF, I_FOX_OUT, I_SWA_IN, I_SWA_SINKS, I_SWA_OUT, I_MLA_IN, I_MLA_QN, I_MLA_UQ, I_MLA_KVN, I_MLA_UKV, I_MLA_OUT, N_IN };

struct Params {
    const float* in[N_IN];
    float* out;
    unsigned char* ws;
    int ph_lo, ph_hi;
};

__device__ __forceinline__ unsigned cvt_pk_bf16(float lo, float hi) { unsigned r; asm volatile("v_cvt_pk_bf16_f32 %0, %1, %2" : "=v"(r) : "v"(lo), "v"(hi)); return r; }
__device__ __forceinline__ int otid() { int t = threadIdx.x; asm volatile("" : "+v"(t)); return t; }
__device__ __forceinline__ float bf_lo(unsigned u) { return __uint_as_float(u << 16); }
__device__ __forceinline__ float bf_hi(unsigned u) { return __uint_as_float(u & 0xffff0000u); }
__device__ __forceinline__ float wave_sum(float v) {
#pragma unroll
    for (int o = 1; o < 64; o <<= 1) v += __shfl_xor(v, o);
    return v;
}
__device__ __forceinline__ float fast_exp2(float x) { return __builtin_amdgcn_exp2f(x); }
__device__ __forceinline__ void sincos_big(float ang, float& s, float& c) {
    const double a = (double)ang; const double n = rint(a * 0.15915494309189535); const float rf = (float)(a - n * 6.283185307179586);
    s = __sinf(rf); c = __cosf(rf);
}
__device__ __forceinline__ float rope_inv_freq(int i) { return exp2f(-(float)i * 0.41524101186092029f); }


#define XB_TMO      128
#define XB_XCNT(j)  (256  + 64 * (j))
#define XB_XSUB(j)  (1280 + 64 * (j))
#define XB_XGEN(j)  (2304 + 64 * (j))
#define XB_TOP      3328
#define XB_TOPGEN   3392
#define XCD_BAR_WORDS 3456
#define XB_SPIN_CAP (1u << 18)
__device__ __forceinline__ unsigned xb_ld(unsigned* p)              { return __hip_atomic_load(p, __ATOMIC_RELAXED, __HIP_MEMORY_SCOPE_AGENT); }
__device__ __forceinline__ unsigned xb_add(unsigned* p, unsigned v) { return __hip_atomic_fetch_add(p, v, __ATOMIC_RELAXED, __HIP_MEMORY_SCOPE_AGENT); }
__device__ __forceinline__ unsigned xb_xcc_id() { return (unsigned)__builtin_amdgcn_s_getreg((3 << 11) | 20) & 0xFu; }
#define XB_SPIN(cond, bar) do { unsigned _sp = 0; while (cond) { __builtin_amdgcn_s_sleep(1); \
    if ((++_sp & 255u) == 0u) { if (xb_ld(&(bar)[XB_TMO])) break; if (_sp > XB_SPIN_CAP) { atomicAdd(&(bar)[XB_TMO], 1u); break; } } } } while (0)
struct XcdBarrier { unsigned* bar; unsigned x; volatile LAS unsigned* st; };
__device__ __forceinline__ XcdBarrier xcd_barrier_post(unsigned* bar, volatile LAS unsigned* st) {
    XcdBarrier b; b.bar = bar; b.x = xb_xcc_id(); b.st = st;
    if (threadIdx.x == 0) (void)xb_add(&bar[XB_XCNT(b.x)], 1u);
    return b;
}
__device__ __forceinline__ void xcd_barrier_complete(unsigned* bar, unsigned x, unsigned& nloc, unsigned& nx) {
    const unsigned G = gridDim.x * gridDim.y * gridDim.z;
    unsigned sum, cnt, mine, sp = 0u;
    for (;;) {
        sum = 0u; cnt = 0u; mine = 0u;
#pragma unroll
        for (unsigned j = 0; j < 16; ++j) { const unsigned c = xb_ld(&bar[XB_XCNT(j)]); sum += c; cnt += (c > 0u) ? 1u : 0u; mine = (j == x) ? c : mine; }
        if (sum == G) break;
        __builtin_amdgcn_s_sleep(1);
        if ((++sp & 255u) == 0u) { if (xb_ld(&bar[XB_TMO])) break; if (sp > XB_SPIN_CAP) { atomicAdd(&bar[XB_TMO], 1u); break; } }
    }
    nloc = mine > 0u ? mine : 1u; nx = cnt > 0u ? cnt : 1u;
}
__device__ __forceinline__ void xcd_barrier(const XcdBarrier& b) {
    asm volatile("s_waitcnt vmcnt(0)" ::: "memory");
    __syncthreads();
    if (threadIdx.x == 0) {
        unsigned* bar = b.bar;
        __builtin_amdgcn_s_waitcnt(0);
        unsigned nloc = b.st[0], nx = b.st[1];
        if (nloc == 0u) { xcd_barrier_complete(bar, b.x, nloc, nx); b.st[0] = nloc; b.st[1] = nx; }
        const unsigned old = xb_add(&bar[XB_XSUB(b.x)], 1u);
        const unsigned gen = old / nloc;
        if (old + 1u == (gen + 1u) * nloc) {
            __builtin_amdgcn_fence(__ATOMIC_RELEASE, "agent");
            asm volatile("s_waitcnt vmcnt(0)" ::: "memory");
            const unsigned og = xb_add(&bar[XB_TOP], 1u);
            const unsigned tg = og / nx;
            if (og + 1u == (tg + 1u) * nx) xb_add(&bar[XB_TOPGEN], 1u);
            else XB_SPIN(xb_ld(&bar[XB_TOPGEN]) == tg, bar);
            __builtin_amdgcn_fence(__ATOMIC_ACQUIRE, "agent");
            xb_add(&bar[XB_XGEN(b.x)], 1u);
            asm volatile("s_waitcnt vmcnt(0)" ::: "memory");
        } else {
            XB_SPIN(xb_ld(&bar[XB_XGEN(b.x)]) == gen, bar);
            __builtin_amdgcn_fence(__ATOMIC_ACQUIRE, "agent");
            asm volatile("s_waitcnt vmcnt(0)" ::: "memory");
        }
    }
    __syncthreads();
}

namespace pg8 {
constexpr int BM = 256, BK = 64, HALF = 128, HTB = HALF * BK * 2, STAGE_BYTES = 8 * HTB, NXCD = 8, WGM = 8;
__device__ __forceinline__ int lds_byte(int r, int c) { const int st = (r >> 4) * 2 + (c >> 5), rr = r & 15, cc = c & 31, ob = rr * 64 + cc * 2; return st * 1024 + (ob ^ (((ob >> 9) & 1) << 5)); }
__device__ __forceinline__ void stage_rc(int b, int& R, int& C) { const int st = b / 1024, sb = b % 1024, swz = sb ^ (((sb >> 9) & 1) << 5); R = (st >> 1) * 16 + swz / 64; C = (st & 1) * 32 + (swz % 64) / 2; }
__device__ __forceinline__ int perm32(int rho) { const int n = rho >> 4, i = rho & 15; return 8 * (i >> 2) + 4 * n + (i & 3); }
struct Unit { int pm, pn, which; };
struct Gemm { const bf16_t* A; const bf16_t* Bt; int M, N, K; const bf16_t* A2; const bf16_t* Bt2; };

struct Order {
    int nM, nN, nwg, G, c, diag, nM2, nN2, nwg2;
    __device__ void init(int M, int N, int G_, int c_, int diag_, int M2 = 0, int N2 = 0) { nM = M / BM; nN = N / BM; nwg = nM * nN; G = G_; c = c_; diag = diag_; nM2 = M2 / BM; nN2 = N2 / BM; nwg2 = nM2 * nN2; }
    static __device__ void tile_map(int wgid, int nM_, int nN_, int nwg_, Unit& u) {
        { const int q = nwg_ / NXCD, r = nwg_ % NXCD, xcd = wgid % NXCD, off = wgid / NXCD; wgid = (xcd < r ? xcd * (q + 1) : r * (q + 1) + (xcd - r) * q) + off; }
        const int nig = WGM * nN_, gid = wgid / nig, fm = gid * WGM, gsz = (nM_ - fm) < WGM ? (nM_ - fm) : WGM;
        u.pm = fm + ((wgid % nig) % gsz); u.pn = (wgid % nig) / gsz;
    }
    __device__ bool next(int i, Unit& u) const {
        u.which = 0;
        if (diag) { const int L = i * G + c; if (L >= 16) return false; const int l = L >> 2; u.pm = 2 * l + (L & 1); u.pn = 2 * l + ((L >> 1) & 1); return true; }
        const long L = (long)i * G + c; if (L >= nwg + nwg2) return false;
        if (L < nwg) tile_map((int)L, nM, nN, nwg, u); else { u.which = 1; tile_map((int)L - nwg, nM2, nN2, nwg2, u); }
        return true;
    }
};

struct Epi {
    int kind, smode; bf16_t* O; float* X; bf16_t* XB; float* ssq; int ldc; LAS unsigned char* lds;
    bf16_t* O2; int ldc2, smode2;
    const float* cw; const float* cb; bf16_t* G; bf16_t* US;
    __device__ __forceinline__ float row_rs(int row, int fq) const {
        const f32x4 a = *(const f32x4*)(ssq + (size_t)row * 32 + fq * 8), b = *(const f32x4*)(ssq + (size_t)row * 32 + fq * 8 + 4);
        float t = ((a[0] + a[1]) + (a[2] + a[3])) + ((b[0] + b[1]) + (b[2] + b[3]));
        t += __shfl_xor(t, 16); t += __shfl_xor(t, 32);
        return rsqrtf(t * (1.f / 2048.f) + 1e-6f);
    }
    static __device__ __forceinline__ unsigned ror1(unsigned x) { return (unsigned)__builtin_amdgcn_update_dpp(0, (int)x, 0x121, 0xf, 0xf, false); }
    static __device__ __forceinline__ unsigned ror2(unsigned x) { return (unsigned)__builtin_amdgcn_update_dpp(0, (int)x, 0x122, 0xf, 0xf, false); }
    __device__ __forceinline__ void ffn_gate(const f32x4 (&acc)[2][2][4][2], const Unit& u, int wr, int wc, int fr, int fq) const {
        unsigned row0 = (unsigned)(u.pm * BM + wr * 64 + fr), ch0 = (unsigned)(u.pn * HALF + wc * 32 + 8 * fq);
        asm volatile("" : "+v"(row0), "+v"(ch0));
        u32x2 pk[2][2][4][2];
#pragma unroll
        for (int h = 0; h < 2; ++h) {
            f32x4 pa[4], pb[4];
#pragma unroll
            for (int i = 0; i < 4; ++i) { const unsigned qo = (row0 + h * HALF + i * 16) * 32u + fq * 8u; pa[i] = *(const f32x4*)(ssq + qo); pb[i] = *(const f32x4*)(ssq + qo + 4u); }
#pragma unroll
            for (int i = 0; i < 4; ++i) { float t = ((pa[i][0] + pa[i][1]) + (pa[i][2] + pa[i][3])) + ((pb[i][0] + pb[i][1]) + (pb[i][2] + pb[i][3]));
                t += __shfl_xor(t, 16); t += __shfl_xor(t, 32); const float rsr = rsqrtf(t * (1.f / 2048.f) + 1e-6f);
#pragma unroll
                for (int bj = 0; bj < 2; ++bj)
#pragma unroll
                    for (int n = 0; n < 2; ++n) { const f32x4 v = acc[h][bj][i][n] * rsr; pk[h][bj][i][n].x = cvt_pk_bf16(v[0], v[1]); pk[h][bj][i][n].y = cvt_pk_bf16(v[2], v[3]); } }
            __builtin_amdgcn_sched_barrier(0);
        }
#pragma unroll
        for (int n = 0; n < 2; ++n) {
            __builtin_amdgcn_sched_barrier(0);
            const unsigned ch = ch0 + 4u * n;
            const f32x4 wg0 = *(const f32x4*)(cw + ch), wg1 = *(const f32x4*)(cw + (11264u + ch)), wg2 = *(const f32x4*)(cw + (22528u + ch)), bg = *(const f32x4*)(cb + ch);
            const f32x4 wv0 = *(const f32x4*)(cw + (5632u + ch)), wv1 = *(const f32x4*)(cw + (16896u + ch)), wv2 = *(const f32x4*)(cw + (28160u + ch)), bv = *(const f32x4*)(cb + (5632u + ch));
#pragma unroll
            for (int ai = 0; ai < 2; ++ai) {
                u32x2 gp = (u32x2){0u, 0u}, vp = gp;
#pragma unroll
                for (int m = 0; m < 4; ++m) {
                    const unsigned row = row0 + ai * HALF + m * 16;
                    const u32x2 gc = pk[ai][0][m][n], vc = pk[ai][1][m][n];
                    u32x2 g1, g2, v1, v2;
#pragma unroll
                    for (int q = 0; q < 2; ++q) {
                        const unsigned a1 = ror1(gc[q]), b1 = ror1(gp[q]), a2 = ror2(gc[q]), b2 = ror2(gp[q]);
                        const unsigned c1 = ror1(vc[q]), d1 = ror1(vp[q]), c2 = ror2(vc[q]), d2 = ror2(vp[q]);
                        g1[q] = fr >= 1 ? a1 : b1; g2[q] = fr >= 2 ? a2 : b2; v1[q] = fr >= 1 ? c1 : d1; v2[q] = fr >= 2 ? c2 : d2;
                    }
                    float o[4];
#pragma unroll
                    for (int j = 0; j < 4; ++j) {
                        const int q = j >> 1; const bool hi = j & 1;
                        const float g0f = hi ? bf_hi(gc[q]) : bf_lo(gc[q]), g1f = hi ? bf_hi(g1[q]) : bf_lo(g1[q]), g2f = hi ? bf_hi(g2[q]) : bf_lo(g2[q]);
                        const float v0f = hi ? bf_hi(vc[q]) : bf_lo(vc[q]), v1f = hi ? bf_hi(v1[q]) : bf_lo(v1[q]), v2f = hi ? bf_hi(v2[q]) : bf_lo(v2[q]);
                        const float cg = bg[j] + wg0[j] * g2f + wg1[j] * g1f + wg2[j] * g0f;
                        const float cv = bv[j] + wv0[j] * v2f + wv1[j] * v1f + wv2[j] * v0f;
                        o[j] = __fdividef(cg, 1.f + __expf(-cg)) * cv;
                    }
                    { u32x2 w; w.x = cvt_pk_bf16(o[0], o[1]); w.y = cvt_pk_bf16(o[2], o[3]); *(u32x2*)(G + (row * 5632u + ch)) = w; }
                    if ((m == 0 && fr < 2) || (m == 3 && fr >= 14)) {
                        const unsigned slot = (m == 0) ? (unsigned)fr : (unsigned)(fr - 12), uo = ((row >> 6) * 4u + slot) * 11264u + ch;
                        *(u32x2*)(US + uo) = gc; *(u32x2*)(US + (uo + 5632u)) = vc;
                    }
                    gp = gc; vp = vc;
                    __builtin_amdgcn_sched_barrier(0);
                }
            }
        }
    }
    template <int KIND> __device__ __forceinline__ void run(const f32x4 (&acc)[2][2][4][2], const Unit& u, int wr, int wc, int fr, int fq) const {
        const int row0 = u.pm * BM + wr * 64 + fr, col0 = u.pn * BM + wc * 32 + 8 * fq;
        if (KIND == 2) { ffn_gate(acc, u, wr, wc, fr, fq); return; }
        if (KIND == 0) {
            const int sm = u.which ? smode2 : smode, ld = u.which ? ldc2 : ldc; bf16_t* Oo = u.which ? O2 : O;
            LAS float* wsc = (LAS float*)(lds + 131072) + (wr * 4 + wc) * 64;
            if (sm == 2) {
                const int i = fq * 16 + fr, tok = u.pn * BM + wc * 32 + (i & 31) + (i >> 5) * HALF;
                float t = 0.f;
#pragma unroll
                for (int j = 0; j < 8; ++j) { const f32x4 a = *(const f32x4*)(ssq + (size_t)tok * 32 + 4 * j); t += (a[0] + a[1]) + (a[2] + a[3]); }
                wsc[i] = rsqrtf(t * (1.f / 2048.f) + 1e-6f);
                asm volatile("s_waitcnt lgkmcnt(0)" ::: "memory");
            }
            float rs8[8];
            if (sm == 1) {
                f32x4 pa[8], pb[8];
#pragma unroll
                for (int i = 0; i < 8; ++i) { const float* q = ssq + (size_t)(row0 + (i >> 2) * HALF + (i & 3) * 16) * 32 + fq * 8; pa[i] = *(const f32x4*)q; pb[i] = *(const f32x4*)(q + 4); }
#pragma unroll
                for (int i = 0; i < 8; ++i) { float t = ((pa[i][0] + pa[i][1]) + (pa[i][2] + pa[i][3])) + ((pb[i][0] + pb[i][1]) + (pb[i][2] + pb[i][3]));
                    t += __shfl_xor(t, 16); t += __shfl_xor(t, 32); rs8[i] = rsqrtf(t * (1.f / 2048.f) + 1e-6f); }
            } else {
#pragma unroll
                for (int i = 0; i < 8; ++i) rs8[i] = 1.f;
            }
#pragma unroll
            for (int ai = 0; ai < 2; ++ai)
#pragma unroll
                for (int m = 0; m < 4; ++m) { const int row = row0 + ai * HALF + m * 16; bf16_t* rowp = Oo + (size_t)row * ld + col0;
                    const float rsr = rs8[ai * 4 + m];
#pragma unroll
                    for (int bj = 0; bj < 2; ++bj) { f32x4 v0 = acc[ai][bj][m][0] * rsr, v1 = acc[ai][bj][m][1] * rsr;
                        if (sm == 2) { const f32x4 q0 = *(const LAS f32x4*)(wsc + bj * 32 + 8 * fq), q1 = *(const LAS f32x4*)(wsc + bj * 32 + 8 * fq + 4); v0 = v0 * q0; v1 = v1 * q1; }
                        u32x4 w; w.x = cvt_pk_bf16(v0[0], v0[1]); w.y = cvt_pk_bf16(v0[2], v0[3]); w.z = cvt_pk_bf16(v1[0], v1[1]); w.w = cvt_pk_bf16(v1[2], v1[3]);
                        *(u32x4*)(rowp + bj * HALF) = w; } }
            if (sm == 2) asm volatile("s_waitcnt lgkmcnt(0)" ::: "memory");
        } else {
#pragma unroll
            for (int ai = 0; ai < 2; ++ai)
#pragma unroll
                for (int m = 0; m < 4; ++m) { const int row = row0 + ai * HALF + m * 16; float* rowp = X + (size_t)row * ldc + col0; bf16_t* bp = XB + (size_t)row * ldc + col0;
                    float ss = 0.f;
#pragma unroll
                    for (int bj = 0; bj < 2; ++bj) {
                        f32x4* p0 = (f32x4*)(rowp + bj * HALF); f32x4* p1 = (f32x4*)(rowp + bj * HALF + 4);
                        const f32x4 v0 = *p0 + acc[ai][bj][m][0], v1 = *p1 + acc[ai][bj][m][1];
                        *p0 = v0; *p1 = v1;
                        ss += (v0[0] * v0[0] + v0[1] * v0[1]) + (v0[2] * v0[2] + v0[3] * v0[3]) + (v1[0] * v1[0] + v1[1] * v1[1]) + (v1[2] * v1[2] + v1[3] * v1[3]);
                        u32x4 w; w.x = cvt_pk_bf16(v0[0], v0[1]); w.y = cvt_pk_bf16(v0[2], v0[3]); w.z = cvt_pk_bf16(v1[0], v1[1]); w.w = cvt_pk_bf16(v1[2], v1[3]);
                        *(u32x4*)(bp + bj * HALF) = w;
                    }
                    ss += __shfl_xor(ss, 16); ss += __shfl_xor(ss, 32);
                    if (fq == 0) ssq[(size_t)row * 32 + u.pn * 4 + wc] = ss;
                }
        }
    }
};

template <int KIND> __device__ __forceinline__ void gemm_phase(LAS unsigned char* lds, const Gemm g, const Order& S, const Epi& E) {
    const int tid = otid(), wid = __builtin_amdgcn_readfirstlane(tid >> 6), lane = tid & 63, wr = wid >> 2, wc = wid & 3, fr = lane & 15, fq = lane >> 4;
    const int K = g.K, nt = K / BK;
    unsigned voffA[2], voffB[2];
#pragma unroll
    for (int i = 0; i < 2; ++i) { int R, C; stage_rc(tid * 16 + i * 8192, R, C); const int Rb = (R & ~31) + perm32(R & 31);
        voffA[i] = (unsigned)(R * K + C) * 2u; voffB[i] = (unsigned)(Rb * K + C) * 2u; }
    const size_t kstep = (size_t)(BK * 2);
    const size_t hstep = (size_t)HALF * K * 2;
    const size_t tstep = 2 * hstep;
    const unsigned ldsw = (unsigned)wid * 1024u;
    const int aoff = lds_byte(wr * 64 + fr, fq * 8), boff = lds_byte(wc * 32 + fr, fq * 8);
#define PG8_SA(b, h) (((b) * 2 + (h)) * HTB)
#define PG8_SB(b, h) ((4 + (b) * 2 + (h)) * HTB)
#define PG8_STAGE(bufoff, gbase, voff) do { _Pragma("unroll") for (int _i = 0; _i < 2; ++_i) \
        __builtin_amdgcn_global_load_lds((const unsigned*)((const char*)(gbase) + (voff)[_i]), (LAS unsigned*)(lds + (bufoff) + ldsw + _i * 8192), 16, 0, 0); } while (0)
#define PG8_LDA(dst, b, h) do { _Pragma("unroll") for (int m = 0; m < 4; ++m) _Pragma("unroll") for (int k = 0; k < 2; ++k) dst[m][k] = *(const LAS bf16x8*)(lds + PG8_SA(b, h) + aoff + m * 2048 + k * 1024); } while (0)
#define PG8_LDB(dst, b, h) do { _Pragma("unroll") for (int n = 0; n < 2; ++n) _Pragma("unroll") for (int k = 0; k < 2; ++k) dst[n][k] = *(const LAS bf16x8*)(lds + PG8_SB(b, h) + boff + n * 2048 + k * 1024); } while (0)
#define PG8_MMA(ai, bj, At, Bt) do { __builtin_amdgcn_s_setprio(1); _Pragma("unroll") for (int m = 0; m < 4; ++m) _Pragma("unroll") for (int n = 0; n < 2; ++n) _Pragma("unroll") for (int k = 0; k < 2; ++k) \
        acc[ai][bj][m][n] = __builtin_amdgcn_mfma_f32_16x16x32_bf16(Bt[n][k], At[m][k], acc[ai][bj][m][n], 0, 0, 0); __builtin_amdgcn_s_setprio(0); } while (0)
#define PG8_WAIT_V(n) asm volatile("s_waitcnt vmcnt(" #n ")" ::: "memory")
#define PG8_WAIT_L(n) asm volatile("s_waitcnt lgkmcnt(" #n ")" ::: "memory")
#define PG8_BAR __builtin_amdgcn_s_barrier()
#define PG8_SCHED __builtin_amdgcn_sched_barrier(0)
    Unit cur, nxt; int ui = 0;
    if (!S.next(0, cur)) return;
    f32x4 acc[2][2][4][2];
#pragma unroll
    for (int a = 0; a < 2; ++a)
#pragma unroll
        for (int b = 0; b < 2; ++b)
#pragma unroll
            for (int m = 0; m < 4; ++m)
#pragma unroll
                for (int n = 0; n < 2; ++n) acc[a][b][m][n] = (f32x4){0.f, 0.f, 0.f, 0.f};
    bf16x8 At[4][2], B0[2][2], B1[2][2];
    const char* cA = (const char*)(cur.which ? g.A2 : g.A) + (size_t)cur.pm * tstep; const char* cB = (const char*)(cur.which ? g.Bt2 : g.Bt) + (size_t)cur.pn * tstep;
    PG8_STAGE(PG8_SB(0, 0), cB, voffB); PG8_STAGE(PG8_SA(0, 0), cA, voffA); PG8_STAGE(PG8_SB(0, 1), cB + hstep, voffB); PG8_STAGE(PG8_SA(0, 1), cA + hstep, voffA);
    if (wr == 1) PG8_BAR;
    PG8_WAIT_V(4); PG8_BAR;
    PG8_STAGE(PG8_SB(1, 0), cB + kstep, voffB); PG8_STAGE(PG8_SA(1, 0), cA + kstep, voffA); PG8_STAGE(PG8_SB(1, 1), cB + hstep + kstep, voffB);
    PG8_WAIT_V(6); PG8_BAR;
    for (;;) {
        const bool has_next = S.next(ui + 1, nxt);
        const char* nA = has_next ? (const char*)(nxt.which ? g.A2 : g.A) + (size_t)nxt.pm * tstep : cA; const char* nB = has_next ? (const char*)(nxt.which ? g.Bt2 : g.Bt) + (size_t)nxt.pn * tstep : cB;
        for (int t = 0; t < nt; t += 2) {
            const bool last = (t == nt - 2);
            const char* a1 = cA + (size_t)(t + 1) * kstep;
            const char* a2 = last ? nA : cA + (size_t)(t + 2) * kstep; const char* b2 = last ? nB : cB + (size_t)(t + 2) * kstep;
            const char* a3 = a2 + kstep; const char* b3 = b2 + kstep;
            PG8_LDB(B0, 0, 0); PG8_SCHED; PG8_LDA(At, 0, 0); PG8_STAGE(PG8_SA(1, 1), a1 + hstep, voffA);
            PG8_WAIT_L(8); PG8_BAR; PG8_WAIT_L(0); PG8_MMA(0, 0, At, B0); PG8_BAR; PG8_SCHED;
            PG8_LDB(B1, 0, 1); PG8_STAGE(PG8_SB(0, 0), b2, voffB);
            PG8_BAR; PG8_WAIT_L(0); PG8_MMA(0, 1, At, B1); PG8_BAR;
            PG8_LDA(At, 0, 1); PG8_STAGE(PG8_SA(0, 0), a2, voffA);
            PG8_BAR; PG8_WAIT_L(0); PG8_MMA(1, 0, At, B0); PG8_BAR; PG8_SCHED;
            PG8_STAGE(PG8_SB(0, 1), b2 + hstep, voffB);
            PG8_WAIT_V(6); PG8_BAR; PG8_MMA(1, 1, At, B1); PG8_BAR;
            PG8_LDB(B0, 1, 0); PG8_SCHED; PG8_LDA(At, 1, 0); PG8_STAGE(PG8_SA(0, 1), a2 + hstep, voffA);
            PG8_WAIT_L(8); PG8_BAR; PG8_WAIT_L(0); PG8_MMA(0, 0, At, B0); PG8_BAR; PG8_SCHED;
            PG8_LDB(B1, 1, 1); PG8_STAGE(PG8_SB(1, 0), b3, voffB);
            PG8_BAR; PG8_WAIT_L(0); PG8_MMA(0, 1, At, B1); PG8_BAR;
            PG8_LDA(At, 1, 1); PG8_STAGE(PG8_SA(1, 0), a3, voffA);
            PG8_BAR; PG8_WAIT_L(0); PG8_MMA(1, 0, At, B0); PG8_BAR; PG8_SCHED;
            PG8_STAGE(PG8_SB(1, 1), b3 + hstep, voffB);
            PG8_WAIT_V(6); PG8_BAR; PG8_MMA(1, 1, At, B1); PG8_BAR;
        }
        E.template run<KIND>(acc, cur, wr, wc, fr, fq);
        if (!has_next) break;
#pragma unroll
        for (int a = 0; a < 2; ++a)
#pragma unroll
            for (int b = 0; b < 2; ++b)
#pragma unroll
                for (int m = 0; m < 4; ++m)
#pragma unroll
                    for (int n = 0; n < 2; ++n) acc[a][b][m][n] = (f32x4){0.f, 0.f, 0.f, 0.f};
        cur = nxt; cA = nA; cB = nB; ++ui;
    }
    PG8_WAIT_V(0);
    if (wr == 0) PG8_BAR;
    PG8_BAR;
#undef PG8_SA
#undef PG8_SB
#undef PG8_STAGE
#undef PG8_LDA
#undef PG8_LDB
#undef PG8_MMA
#undef PG8_WAIT_V
#undef PG8_WAIT_L
#undef PG8_BAR
#undef PG8_SCHED
}
}

struct GemmDesc { const bf16_t* A; const bf16_t* Bt; int M, N, K; int kind; bf16_t* O; float* X; int ldc; int diag; int smode; };

struct Seg { const float* src; bf16_t* dst; const float* gain; int K, ldw, c0, ncols, rep, cstride, dstride, nitems; };
constexpr int NSEG = 37;

__device__ __forceinline__ void set_seg(LAS Seg* s, const float* src, bf16_t* dst, int K, int ldw, int c0, int ncols, int rep = 1, int cstride = 0, int dstride = 0, const float* gain = nullptr) {
    { int z = 0; asm volatile("" : "+v"(z)); K += z; ldw += z; c0 += z; ncols += z; rep += z; cstride += z; dstride += z; }
    { unsigned long long u0 = (unsigned long long)src, u1 = (unsigned long long)dst, u2 = (unsigned long long)gain; asm volatile("" : "+v"(u0), "+v"(u1), "+v"(u2));
      src = (const float*)u0; dst = (bf16_t*)u1; gain = (const float*)u2; }
    s->src = src; s->dst = dst; s->gain = gain; s->K = K; s->ldw = ldw; s->c0 = c0; s->ncols = ncols; s->rep = rep; s->cstride = cstride; s->dstride = dstride; s->nitems = (K / 64) * (ncols / 64) * rep;
}
__device__ void build_segs(const Params& p, LAS Seg* sg) {
    unsigned char* ws = p.ws; int n = 0;
    for (int i = 0; i < 4; ++i) {
        set_seg(sg + n++, p.in[I_WUP] + (size_t)i * 2048 * 11264, (bf16_t*)(ws + W_UP) + (size_t)i * 11264 * 2048, 2048, 11264, 0, 128, 44, 128, 256, p.in[I_FFN_NORM] + i * 2048);
        set_seg(sg + n++, p.in[I_WUP] + (size_t)i * 2048 * 11264, (bf16_t*)(ws + W_UP) + (size_t)i * 11264 * 2048 + (size_t)128 * 2048, 2048, 11264, 5632, 128, 44, 128, 256, p.in[I_FFN_NORM] + i * 2048);
        set_seg(sg + n++, p.in[I_WDOWN] + (size_t)i * 5632 * 2048, (bf16_t*)(ws + W_DOWN) + (size_t)i * 2048 * 5632, 5632, 2048, 0, 2048);
    }
    set_seg(sg + n++, p.in[I_SB_IN], (bf16_t*)(ws + W_SB_IN1), 2048, 6656, 0, 4096, 1, 0, 0, p.in[I_ATTN_NORM] + 0 * 2048);
    set_seg(sg + n++, p.in[I_SB_IN], (bf16_t*)(ws + W_SB_IN1) + (size_t)4096 * 2048, 2048, 6656, 6144, 512, 1, 0, 0, p.in[I_ATTN_NORM] + 0 * 2048);
    set_seg(sg + n++, p.in[I_SB_IN], (bf16_t*)(ws + W_SB_V), 2048, 6656, 4096, 2048, 1, 0, 0, p.in[I_ATTN_NORM] + 0 * 2048);
    set_seg(sg + n++, p.in[I_SB_OUT], (bf16_t*)(ws + W_SB_OUT), 2560, 2048, 0, 2048);
    set_seg(sg + n++, p.in[I_FOX_IN], (bf16_t*)(ws + W_FOX_IN1), 2048, 6672, 0, 4096, 1, 0, 0, p.in[I_ATTN_NORM] + 1 * 2048);
    set_seg(sg + n++, p.in[I_FOX_IN], (bf16_t*)(ws + W_FOX_IN1) + (size_t)4096 * 2048, 2048, 6672, 6160, 512, 1, 0, 0, p.in[I_ATTN_NORM] + 1 * 2048);
    set_seg(sg + n++, p.in[I_FOX_IN], (bf16_t*)(ws + W_FOX_V), 2048, 6672, 4096, 2048, 1, 0, 0, p.in[I_ATTN_NORM] + 1 * 2048);
    set_seg(sg + n++, p.in[I_FOX_OUT], (bf16_t*)(ws + W_FOX_OUT), 2560, 2048, 0, 2048);
    set_seg(sg + n++, p.in[I_SWA_IN], (bf16_t*)(ws + W_SWA_IN1), 2048, 3072, 0, 2304, 1, 0, 0, p.in[I_ATTN_NORM] + 2 * 2048);
    set_seg(sg + n++, p.in[I_SWA_IN], (bf16_t*)(ws + W_SWA_IN1) + (size_t)2304 * 2048, 2048, 3072, 2560, 512, 1, 0, 0, p.in[I_ATTN_NORM] + 2 * 2048);
    set_seg(sg + n++, p.in[I_SWA_IN], (bf16_t*)(ws + W_SWA_V), 2048, 3072, 2304, 256, 1, 0, 0, p.in[I_ATTN_NORM] + 2 * 2048);
    set_seg(sg + n++, p.in[I_SWA_OUT], (bf16_t*)(ws + W_SWA_OUT), 2560, 2048, 0, 2048);
    set_seg(sg + n++, p.in[I_MLA_IN], (bf16_t*)(ws + W_MLA_IN), 2048, 1344, 0, 1344, 1, 0, 0, p.in[I_ATTN_NORM] + 3 * 2048);
    set_seg(sg + n++, p.in[I_MLA_UQ], (bf16_t*)(ws + W_MLA_UQ), 512, 3072, 0, 3072);
    set_seg(sg + n++, p.in[I_MLA_UKV], (bf16_t*)(ws + W_MLA_KN), 256, 4096, 0, 128, 16, 256, 128);
    set_seg(sg + n++, p.in[I_MLA_UKV], (bf16_t*)(ws + W_MLA_V), 256, 4096, 128, 128, 16, 256, 128);
    set_seg(sg + n++, p.in[I_MLA_OUT], (bf16_t*)(ws + W_MLA_OUT), 2560, 2048, 0, 2048);
    for (int i = 0; i < 4; ++i) {
        set_seg(sg + n++, p.in[I_WMEMKV] + (size_t)i * 2048 * 1024, (bf16_t*)(ws + W_MEMK) + (size_t)i * 512 * 2048, 2048, 1024, 0, 512);
        set_seg(sg + n++, p.in[I_WMEMKV] + (size_t)i * 2048 * 1024, (bf16_t*)(ws + W_MEMV) + (size_t)i * 512 * 2048, 2048, 1024, 512, 512);
    }
}

__device__ __forceinline__ void transpose_item(const float* W, int ldw, int K, int c0, bf16_t* WT, int item, int nblk, LAS float* scr, int lane, const float* gain, bool nt) {
    const int kb = item / nblk, nb = item % nblk, k0 = 64 * kb, n0 = 64 * nb;
    const float* src = W + (size_t)(k0 + (lane >> 4)) * ldw + c0 + n0 + (lane & 15) * 4;
    f32x4 v[16];
#pragma unroll
    for (int j = 0; j < 16; ++j) v[j] = __builtin_nontemporal_load((const f32x4*)(src + (size_t)(4 * j) * ldw));
    if (gain) {
#pragma unroll
        for (int j = 0; j < 16; ++j) v[j] = v[j] * gain[k0 + 4 * j + (lane >> 4)];
    }
#pragma unroll
    for (int j = 0; j < 16; ++j) { LAS float* d = scr + (4 * j + (lane >> 4)) * 65 + (lane & 15) * 4; d[0] = v[j].x; d[1] = v[j].y; d[2] = v[j].z; d[3] = v[j].w; }
    asm volatile("s_waitcnt lgkmcnt(0)" ::: "memory");
    const int c = lane & 7;
#pragma unroll
    for (int j = 0; j < 8; ++j) { const int n = (lane >> 3) + 8 * j; const LAS float* sp = scr + (8 * c) * 65 + n;
        u32x4 o; o.x = cvt_pk_bf16(sp[0 * 65], sp[1 * 65]); o.y = cvt_pk_bf16(sp[2 * 65], sp[3 * 65]); o.z = cvt_pk_bf16(sp[4 * 65], sp[5 * 65]); o.w = cvt_pk_bf16(sp[6 * 65], sp[7 * 65]);
        u32x4* dp = (u32x4*)(WT + (size_t)(n0 + n) * K + k0 + 8 * c);
        if (nt) __builtin_nontemporal_store(o, dp); else *dp = o; }
    asm volatile("s_waitcnt lgkmcnt(0)" ::: "memory");
}

__device__ __forceinline__ void rms_row_bf16(const float* xrow, const float* g, bf16_t* orow, float* xcopy, int lane, f32x4 (&y)[8]) {
    const f32x4* xr = (const f32x4*)xrow + lane; float ss = 0.f;
#pragma unroll
    for (int j = 0; j < 8; ++j) { y[j] = xr[64 * j]; ss += (y[j].x * y[j].x + y[j].y * y[j].y) + (y[j].z * y[j].z + y[j].w * y[j].w); }
    if (xcopy) {
#pragma unroll
        for (int j = 0; j < 8; ++j) ((f32x4*)xcopy + lane)[64 * j] = y[j];
    }
    const float rs = rsqrtf(wave_sum(ss) * (1.f / 2048.f) + 1e-6f);
    const f32x4* gr = (const f32x4*)g + lane; u32x2* o8 = (u32x2*)orow + lane;
#pragma unroll
    for (int j = 0; j < 8; ++j) { const f32x4 gg = gr[64 * j]; y[j] = (y[j] * rs) * gg; u32x2 w; w.x = cvt_pk_bf16(y[j].x, y[j].y); w.y = cvt_pk_bf16(y[j].z, y[j].w); o8[64 * j] = w; }
}

__device__ void phase_conv(const Params& p, LAS unsigned char* lds) {
    LAS Seg* sg = (LAS Seg*)lds;
    const int tid = otid(), wave = tid >> 6, lane = tid & 63;
    if (tid == 0) build_segs(p, sg);
    __syncthreads();
    LAS float* scr = (LAS float*)(lds + 4096 + wave * 16640);
    const int gw = blockIdx.x * NWAVE + wave, NGW = gridDim.x * NWAVE;
    int total = 0;
    for (int s = 0; s < NSEG; ++s) total += sg[s].nitems;
    for (int it = gw; it < total; it += NGW) {
        int r = it, s = 0;
        while (r >= sg[s].nitems) { r -= sg[s].nitems; ++s; }
        const int K = sg[s].K, nblk = sg[s].ncols / 64, per = (K / 64) * nblk, ri = r / per, within = r - ri * per;
        const size_t doff = (size_t)((const unsigned char*)sg[s].dst - p.ws);
        const bool keep = (doff >= W_SB_IN1 && doff < W_FOX_IN1) || (doff >= W_MEMK && doff < W_UP + (size_t)11264 * 2048 * 2) || (doff >= W_DOWN && doff < W_DOWN + (size_t)2048 * 5632 * 2);
        transpose_item(sg[s].src, sg[s].ldw, K, sg[s].c0 + ri * sg[s].cstride, sg[s].dst + (size_t)ri * sg[s].dstride * K, within, nblk, scr, lane, sg[s].gain, !keep);
    }
    for (int rt = gw; rt < 2048; rt += NGW) {
        const int l = rt >> 9, r = rt & 511; f32x4 y[8];
        rms_row_bf16(p.in[I_MEM] + (size_t)r * 2048, p.in[I_MEM_NORM] + l * 2048, (bf16_t*)(p.ws + OFF_MEMH) + (size_t)rt * 2048, nullptr, lane, y);
    }
    const int gt = blockIdx.x * NTHR + tid, NT = gridDim.x * NTHR;
    for (int i = gt; i < 32 * 128; i += NT) {
        const int h = i >> 7, dist = i & 127; int bucket;
        if (dist < 16) bucket = dist;
        else { const float d = (float)dist; int large = 16 + (int)(logf(d / 16.f) / 2.0794415416798357f * 16.f); bucket = large < 31 ? large : 31; }
        ((float*)(p.ws + OFF_BIAST))[i] = p.in[I_RELB][bucket * 32 + h];
    }
    for (int i = gt; i < 16 * 2048; i += NT) { const int j = i >> 11, k = i & 2047; ((float*)(p.ws + OFF_WF))[i] = p.in[I_FOX_IN][(size_t)k * 6672 + 6144 + j]; }
    for (int i = gt; i < 192 * 2048 / 8; i += NT) ((u32x4*)((bf16_t*)(p.ws + W_MLA_IN) + (size_t)1344 * 2048))[i] = (u32x4){0u, 0u, 0u, 0u};
}

__device__ void phase_norm(const Params& p, const float* xin, const float* g, int mode) {
    const int tid = otid(), wave = tid >> 6, lane = tid & 63;
    const int gw = blockIdx.x * NWAVE + wave, NGW = gridDim.x * NWAVE;
    for (int row = gw; row < T; row += NGW) {
        const f32x4* xr = (const f32x4*)(xin + (size_t)row * 2048) + lane; f32x4 y[8]; float ss = 0.f;
#pragma unroll
        for (int j = 0; j < 8; ++j) { y[j] = xr[64 * j]; ss += (y[j].x * y[j].x + y[j].y * y[j].y) + (y[j].z * y[j].z + y[j].w * y[j].w); }
        ss = wave_sum(ss);
        if (mode == 1) {
            f32x4* xc = (f32x4*)((float*)(p.ws + OFF_XR) + (size_t)row * 2048) + lane; u32x2* o8 = (u32x2*)((bf16_t*)(p.ws + OFF_H) + (size_t)row * 2048) + lane;
#pragma unroll
            for (int j = 0; j < 8; ++j) { xc[64 * j] = y[j]; u32x2 w; w.x = cvt_pk_bf16(y[j].x, y[j].y); w.y = cvt_pk_bf16(y[j].z, y[j].w); o8[64 * j] = w; }
            if (lane < 32) ((float*)(p.ws + OFF_SSQ))[(size_t)row * 32 + lane] = lane == 0 ? ss : 0.f;
            continue;
        }
        const float rs = rsqrtf(ss * (1.f / 2048.f) + 1e-6f);
        const f32x4* gr = (const f32x4*)g + lane;
        if (mode == 3) {
            f32x4* o = (f32x4*)(p.out + (size_t)row * 2048) + lane;
#pragma unroll
            for (int j = 0; j < 8; ++j) o[64 * j] = (y[j] * rs) * gr[64 * j];
            continue;
        }
#pragma unroll
        for (int j = 0; j < 8; ++j) y[j] = (y[j] * rs) * gr[64 * j];
        const float* wf = (const float*)(p.ws + OFF_WF);
        float mine = 0.f;
#pragma unroll 1
        for (int jf = 0; jf < 16; ++jf) {
            const f32x4* wr_ = (const f32x4*)(wf + jf * 2048) + lane; float d = 0.f;
#pragma unroll
            for (int j = 0; j < 8; ++j) { const f32x4 w = wr_[64 * j]; d += (y[j].x * w.x + y[j].y * w.y) + (y[j].z * w.z + y[j].w * w.w); }
            d = wave_sum(d);
            if (lane == jf) mine = d;
        }
        if (lane < 16) { const float xv = mine + p.in[I_FOX_BF][lane]; const float ls = fminf(xv, 0.f) - __logf(1.f + __expf(-fabsf(xv))); ((float*)(p.ws + OFF_LF))[(size_t)row * 16 + lane] = ls; }
    }
}

__device__ void fox_scan(const Params& p, LAS unsigned char* lds) {
    LAS float* sh = (LAS float*)lds; const int tid = otid();
    for (int bh = blockIdx.x; bh < 32; bh += gridDim.x) {
        const int bb = bh >> 4, head = bh & 15; const float* lf = (const float*)(p.ws + OFF_LF); float* lfc = (float*)(p.ws + OFF_LFC) + (size_t)bh * 4096;
        float v[8]; float run = 0.f;
#pragma unroll
        for (int e = 0; e < 8; ++e) { run += lf[(size_t)(bb * 4096 + tid * 8 + e) * 16 + head]; v[e] = run; }
        sh[tid] = run; __syncthreads();
        for (int off = 1; off < 512; off <<= 1) { float x = sh[tid]; if (tid >= off) x += sh[tid - off]; __syncthreads(); sh[tid] = x; __syncthreads(); }
        const float excl = sh[tid] - run;
#pragma unroll
        for (int e = 0; e < 8; ++e) lfc[tid * 8 + e] = excl + v[e];
        __syncthreads();
    }
}

__device__ void ffn_fixup(const Params& p, int layer, int pm) {
    const bf16_t* us = (const bf16_t*)(p.ws + OFF_U); bf16_t* g = (bf16_t*)(p.ws + OFF_G);
    const float* cw = p.in[I_CONVW] + (size_t)layer * 3 * 11264; const float* cb = p.in[I_CONVB] + (size_t)layer * 11264;
    constexpr int NCH = DFF / 8;
    for (int item = otid(); item < 8 * NCH; item += NTHR) {
        const int ri = item / NCH, chunk = item - ri * NCH, c = chunk * 8, w = ri & 1, t = pm * 256 + (ri >> 1) * 64 + w, blk = t >> 6, tl = t & (SEQ - 1);
        const bf16_t* r0 = us + ((size_t)blk * 4 + w) * 11264 + c;
        const bf16_t* r1 = w == 1 ? us + ((size_t)blk * 4 + 0) * 11264 + c : us + ((size_t)(blk - 1) * 4 + 3) * 11264 + c;
        const bf16_t* r2 = w == 1 ? us + ((size_t)(blk - 1) * 4 + 3) * 11264 + c : us + ((size_t)(blk - 1) * 4 + 2) * 11264 + c;
        const bool has1 = tl >= 1, has2 = tl >= 2;
        const u32x4 z4 = (u32x4){0u, 0u, 0u, 0u};
        const u32x4 a0 = *(const u32x4*)r0, b0 = *(const u32x4*)(r0 + DFF);
        const u32x4 a1 = has1 ? *(const u32x4*)r1 : z4, b1 = has1 ? *(const u32x4*)(r1 + DFF) : z4;
        const u32x4 a2 = has2 ? *(const u32x4*)r2 : z4, b2 = has2 ? *(const u32x4*)(r2 + DFF) : z4;
        float o[8];
#pragma unroll
        for (int e = 0; e < 8; ++e) {
            const int q = e >> 1; const bool hi = e & 1;
            const float g0 = hi ? bf_hi(a0[q]) : bf_lo(a0[q]), g1 = hi ? bf_hi(a1[q]) : bf_lo(a1[q]), g2 = hi ? bf_hi(a2[q]) : bf_lo(a2[q]);
            const float v0 = hi ? bf_hi(b0[q]) : bf_lo(b0[q]), v1 = hi ? bf_hi(b1[q]) : bf_lo(b1[q]), v2 = hi ? bf_hi(b2[q]) : bf_lo(b2[q]);
            const float cg = cb[c + e] + cw[c + e] * g2 + cw[11264 + c + e] * g1 + cw[22528 + c + e] * g0;
            const float cv = cb[DFF + c + e] + cw[DFF + c + e] * v2 + cw[11264 + DFF + c + e] * v1 + cw[22528 + DFF + c + e] * v0;
            o[e] = cg / (1.f + __expf(-cg)) * cv;
        }
        u32x4 wv; wv.x = cvt_pk_bf16(o[0], o[1]); wv.y = cvt_pk_bf16(o[2], o[3]); wv.z = cvt_pk_bf16(o[4], o[5]); wv.w = cvt_pk_bf16(o[6], o[7]);
        *(u32x4*)(g + (size_t)t * DFF + c) = wv;
    }
}

__device__ void phase_mla_mid(const Params& p) {
    const int tid = otid(), wave = tid >> 6, lane = tid & 63;
    const int gw = blockIdx.x * NWAVE + wave, NGW = gridDim.x * NWAVE;
    const bf16_t* pr = (const bf16_t*)(p.ws + OFF_PROJ);
    for (int row = gw; row < T; row += NGW) {
        const bf16_t* rp = pr + (size_t)row * 1536;
        { const u32x4 a = *(const u32x4*)(rp + lane * 8); float v[8];
#pragma unroll
          for (int e = 0; e < 4; ++e) { v[2 * e] = bf_lo(a[e]); v[2 * e + 1] = bf_hi(a[e]); }
          float ss = 0.f;
#pragma unroll
          for (int e = 0; e < 8; ++e) ss += v[e] * v[e];
          const float rs = rsqrtf(wave_sum(ss) * (1.f / 512.f) + 1e-6f);
          const f32x4 g0 = *(const f32x4*)(p.in[I_MLA_QN] + lane * 8), g1 = *(const f32x4*)(p.in[I_MLA_QN] + lane * 8 + 4);
          u32x4 w; w.x = cvt_pk_bf16(v[0] * rs * g0[0], v[1] * rs * g0[1]); w.y = cvt_pk_bf16(v[2] * rs * g0[2], v[3] * rs * g0[3]);
          w.z = cvt_pk_bf16(v[4] * rs * g1[0], v[5] * rs * g1[1]); w.w = cvt_pk_bf16(v[6] * rs * g1[2], v[7] * rs * g1[3]);
          *(u32x4*)((bf16_t*)(p.ws + OFF_CQN) + (size_t)row * 512 + lane * 8) = w; }
        { const u32x2 a = *(const u32x2*)(rp + 512 + lane * 4); float v[4] = {bf_lo(a.x), bf_hi(a.x), bf_lo(a.y), bf_hi(a.y)};
          const float ss = v[0] * v[0] + v[1] * v[1] + v[2] * v[2] + v[3] * v[3];
          const float rs = rsqrtf(wave_sum(ss) * (1.f / 256.f) + 1e-6f);
          const f32x4 g0 = *(const f32x4*)(p.in[I_MLA_KVN] + lane * 4);
          u32x2 w; w.x = cvt_pk_bf16(v[0] * rs * g0[0], v[1] * rs * g0[1]); w.y = cvt_pk_bf16(v[2] * rs * g0[2], v[3] * rs * g0[3]);
          *(u32x2*)((bf16_t*)(p.ws + OFF_CKVN) + (size_t)row * 256 + lane * 4) = w; }
        if (lane < 32) {
            const float x1 = __uint_as_float((unsigned)rp[768 + lane] << 16), x2 = __uint_as_float((unsigned)rp[800 + lane] << 16);
            const float pos = (float)((const int*)p.in[I_POS])[row]; float s, c; sincos_big(pos * rope_inv_freq(lane), s, c);
            bf16_t* ko = (bf16_t*)(p.ws + OFF_KPE) + (size_t)row * 64;
            const unsigned w = cvt_pk_bf16(x1 * c - x2 * s, x2 * c + x1 * s);
            ko[lane] = (bf16_t)(w & 0xffffu); ko[32 + lane] = (bf16_t)(w >> 16);
        }
    }
}

struct AttnArgs {
    const bf16_t* q; int ldq, qoff;
    const bf16_t* k; int ldk, koff;
    const bf16_t* k2;
    const bf16_t* vt; int ldvt, vrow0, vcol_base;
    int qrow_base, krow_base;
    bf16_t* o; int ocol;
    int q0;
    const float* lfc; const float* biasrow; float sink; const int* pos;
    float scale;
};

#ifndef NQB_SB
#define NQB_SB 2
#endif
#ifndef NQB_FOX
#define NQB_FOX 2
#endif
#ifndef NQB_SWA
#define NQB_SWA 2
#endif
#ifndef NQB_MLA
#define NQB_MLA 1
#endif
#ifndef NQB_MEM
#define NQB_MEM 1
#endif
template <int MODE, int NQB, int NNB, bool MASKED>
__device__ __forceinline__ void att_scores(f32x4 (&st)[4][NQB], f32x4 (&oacc)[NNB][NQB], float (&mrun)[NQB], float (&lsum)[NQB], float (&carry)[NQB], const float (&ct)[NQB],
                                           int wr0, int r, int quad, int kt, float scale2, LAS unsigned char* tbl) {
    const int key0 = kt * 64 + quad * 16;
#pragma unroll
    for (int qb = 0; qb < NQB; ++qb) {
        const int t = wr0 + qb * 16 + r;
        if (MODE == 0) {
            float pe = 1.f;
#pragma unroll
            for (int kb = 3; kb >= 0; --kb)
#pragma unroll
                for (int j = 3; j >= 0; --j) {
                    const float u = __builtin_amdgcn_fmed3f(st[kb][qb][j] * scale2, -115.f, 115.f);
                    const float e = fast_exp2(u);
                    float beta = __builtin_amdgcn_rcpf(1.f + e), omb = e * beta;
                    if (MASKED) { const bool valid = (key0 + kb * 4 + j) < t; beta = valid ? beta : 0.f; omb = valid ? omb : 1.f; }
                    st[kb][qb][j] = beta * pe;
                    pe *= omb;
                }
            const float g0 = pe, g1 = __shfl_xor(g0, 16), g2 = __shfl_xor(g0, 32), g3 = __shfl_xor(g0, 48);
            const float Tt = (g0 * g1) * (g2 * g3);
            const float Hh = (((quad ^ 1) > quad) ? g1 : 1.f) * (((quad ^ 2) > quad) ? g2 : 1.f) * (((quad ^ 3) > quad) ? g3 : 1.f);
            const float mul = Hh * carry[qb];
#pragma unroll
            for (int kb = 0; kb < 4; ++kb)
#pragma unroll
                for (int j = 0; j < 4; ++j) st[kb][qb][j] *= mul;
            carry[qb] *= Tt;
        } else {
            float mx = -INFINITY;
#pragma unroll
            for (int kb = 0; kb < 4; ++kb) {
                f32x4 cs = (f32x4){0.f, 0.f, 0.f, 0.f};
                if (MODE == 1) cs = *(const LAS f32x4*)(tbl + (kt * 64 + quad * 16 + kb * 4) * 4);
#pragma unroll
                for (int j = 0; j < 4; ++j) {
                    const int key = key0 + kb * 4 + j;
                    float v = st[kb][qb][j] * scale2;
                    if (MODE == 1) v += ct[qb] - cs[j];
                    if (MODE == 2) { const int dist = t - key; const bool valid = dist >= 0 && dist < 128; const int di = dist < 0 ? 0 : (dist > 127 ? 127 : dist); v += ((const LAS float*)tbl)[di]; v = valid ? v : -INFINITY; }
                    else if (MASKED) v = (key <= t) ? v : -INFINITY;
                    st[kb][qb][j] = v; mx = fmaxf(mx, v);
                }
            }
            mx = fmaxf(mx, __shfl_xor(mx, 16)); mx = fmaxf(mx, __shfl_xor(mx, 32));
            const float m_old = mrun[qb], m_new = fmaxf(m_old, mx), m_use = (m_new == -INFINITY) ? 0.f : m_new;
            const float alpha = fast_exp2(m_old - m_use);
            mrun[qb] = m_new;
            float ps = 0.f;
#pragma unroll
            for (int kb = 0; kb < 4; ++kb)
#pragma unroll
                for (int j = 0; j < 4; ++j) { const float pv = fast_exp2(st[kb][qb][j] - m_use); st[kb][qb][j] = pv; ps += pv; }
            lsum[qb] = lsum[qb] * alpha + ps;
            if (RESCALE_ALWAYS || __builtin_amdgcn_ballot_w64(m_new != m_old) != 0ull) {
#pragma unroll
                for (int nb = 0; nb < NNB; ++nb) oacc[nb][qb] = oacc[nb][qb] * alpha;
            }
        }
    }
}

template <int MODE, int NQB>
__device__ __forceinline__ void attn_item(LAS unsigned char* lds, const AttnArgs& a) {
    constexpr int WROWS = 16 * NQB, QR = 128 * NQB;
    constexpr int DK = (MODE == 2) ? 64 : (MODE == 3 ? 192 : 128);
    constexpr int DV = (MODE == 2) ? 64 : 128;
    constexpr int NKK = DK / 32, NNB = DV / 16;
    constexpr int K128_BYTES = (MODE == 2) ? 0 : 16384;
    constexpr int K64_BYTES = (MODE == 2 || MODE == 3) ? 8192 : 0;
    constexpr int KT_BYTES = K128_BYTES + K64_BYTES, VT_BYTES = DV * 128, BUF_BYTES = KT_BYTES + VT_BYTES + 256;
    constexpr int NP128 = K128_BYTES / 8192, NPV = VT_BYTES / 8192;
    constexpr int NBUF = 3, TBL_OFF = NBUF * BUF_BYTES;
    constexpr int NDMA = NP128 + (K64_BYTES ? 1 : 0) + NPV;
    const int tid = otid(), wave = __builtin_amdgcn_readfirstlane(tid >> 6), lane = tid & 63, r = lane & 15, quad = lane >> 4;
    const int wr0 = a.q0 + wave * WROWS;
    int kt_hi, kt_lo, wkt_hi, wkt_lo;
    if (MODE == 4) { kt_lo = 0; kt_hi = 3; wkt_lo = 0; wkt_hi = 3; }
    else if (MODE == 2) { kt_hi = (a.q0 + QR - 1) >> 6; kt_lo = a.q0 >= 128 ? (a.q0 - 128) >> 6 : 0; wkt_hi = (wr0 + WROWS - 1) >> 6; wkt_lo = wr0 >= 127 ? (wr0 - 127) >> 6 : 0; }
    else { kt_hi = (a.q0 + QR - 1) >> 6; kt_lo = 0; wkt_hi = (wr0 + WROWS - 1) >> 6; wkt_lo = 0; }

    unsigned ko128[NP128 > 0 ? NP128 : 1], ko64 = 0, vo[NPV];
#pragma unroll
    for (int i = 0; i < NP128; ++i) { const int s = (wave + 8 * i) * 64 + lane, row = s >> 4, cp = s & 15, c = cp ^ (row & 15), krow = ((row >> 2) & 3) * 16 + (row >> 4) * 4 + (row & 3); ko128[i] = (unsigned)(krow * a.ldk + c * 8) * 2u; }
    if (K64_BYTES) { const int s = wave * 64 + lane, row = s >> 3, cp = s & 7, c = cp ^ ((row >> 1) & 7), krow = ((row >> 2) & 3) * 16 + (row >> 4) * 4 + (row & 3); ko64 = (unsigned)(krow * (MODE == 3 ? 64 : a.ldk) + c * 8) * 2u; }
#pragma unroll
    for (int i = 0; i < NPV; ++i) { const int s = (wave + 8 * i) * 64 + lane, row = s >> 3, cp = s & 7, c = cp ^ ((row >> 1) & 7); vo[i] = (unsigned)(row * a.ldvt + c * 8) * 2u; }
    const int x128 = quad ^ r, x64 = quad ^ (r >> 1), y0 = (quad * 2) ^ (r >> 1);
    const int krd128 = r * 256, krd64 = r * 128, vrd = r * 128;

    bf16x8 qf[NQB][NKK];
#pragma unroll
    for (int qb = 0; qb < NQB; ++qb) {
        const int t = wr0 + qb * 16 + r;
        const bf16_t* qp = a.q + (size_t)(a.qrow_base + t) * a.ldq + a.qoff;
#pragma unroll
        for (int kk = 0; kk < (MODE == 3 ? 4 : NKK); ++kk) qf[qb][kk] = *(const bf16x8*)(qp + kk * 32 + quad * 8);
        if (MODE == 3) {
            const bf16x8 c1 = *(const bf16x8*)(qp + 128 + quad * 8), c2 = *(const bf16x8*)(qp + 160 + quad * 8);
            const float pos = (float)a.pos[t];
            bf16x8 o1, o2;
#pragma unroll
            for (int e = 0; e < 8; e += 2) {
                float s0, c0, s1, cc1; sincos_big(pos * rope_inv_freq(quad * 8 + e), s0, c0); sincos_big(pos * rope_inv_freq(quad * 8 + e + 1), s1, cc1);
                const float x10 = __uint_as_float((unsigned)(unsigned short)c1[e] << 16), x20 = __uint_as_float((unsigned)(unsigned short)c2[e] << 16);
                const float x11 = __uint_as_float((unsigned)(unsigned short)c1[e + 1] << 16), x21 = __uint_as_float((unsigned)(unsigned short)c2[e + 1] << 16);
                const unsigned wa = cvt_pk_bf16(x10 * c0 - x20 * s0, x11 * cc1 - x21 * s1), wb = cvt_pk_bf16(x20 * c0 + x10 * s0, x21 * cc1 + x11 * s1);
                o1[e] = (short)(wa & 0xffffu); o1[e + 1] = (short)(wa >> 16); o2[e] = (short)(wb & 0xffffu); o2[e + 1] = (short)(wb >> 16);
            }
            qf[qb][NKK - 2] = o1; qf[qb][NKK - 1] = o2;
        }
    }
    f32x4 oacc[NNB][NQB];
#pragma unroll
    for (int nb = 0; nb < NNB; ++nb)
#pragma unroll
        for (int qb = 0; qb < NQB; ++qb) oacc[nb][qb] = (f32x4){0.f, 0.f, 0.f, 0.f};
    float mrun[NQB], lsum[NQB], carry[NQB], ct[NQB];
#pragma unroll
    for (int qb = 0; qb < NQB; ++qb) {
        mrun[qb] = (MODE == 2) ? a.sink * LOG2E : -INFINITY; lsum[qb] = (MODE == 2 && quad == 0) ? 1.f : 0.f; carry[qb] = 1.f;
        ct[qb] = (MODE == 1) ? a.lfc[wr0 + qb * 16 + r] * LOG2E : 0.f;
    }
    if (MODE == 2) { if (tid < 128) ((LAS float*)(lds + TBL_OFF))[tid] = a.biasrow[tid] * LOG2E; }
    const float scale2 = (MODE == 0) ? -a.scale * LOG2E : a.scale * LOG2E;

    const char* kbase = (const char*)(a.k + (size_t)a.krow_base * a.ldk + a.koff);
    const char* k2base = (MODE == 3) ? (const char*)(a.k2 + (size_t)a.krow_base * 64) : kbase;
    const char* vbase = (const char*)(a.vt + (size_t)a.vrow0 * a.ldvt + a.vcol_base);
#define ATT_DMA(kt_, buf_) do { LAS unsigned char* bp = lds + (buf_) * BUF_BYTES + wave * 1024; \
        const char* kg = kbase + (size_t)(kt_) * 64 * a.ldk * 2; \
        _Pragma("unroll") for (int i = 0; i < NP128; ++i) __builtin_amdgcn_global_load_lds((const unsigned*)(kg + ko128[i]), (LAS unsigned*)(bp + i * 8192), 16, 0, 0); \
        if (K64_BYTES) { const char* k2g = (MODE == 3) ? k2base + (size_t)(kt_) * 64 * 64 * 2 : kg; \
            __builtin_amdgcn_global_load_lds((const unsigned*)(k2g + ko64), (LAS unsigned*)(bp + K128_BYTES), 16, 0, 0); } \
        const char* vg = vbase + (size_t)(kt_) * 64 * 2; \
        _Pragma("unroll") for (int i = 0; i < NPV; ++i) __builtin_amdgcn_global_load_lds((const unsigned*)(vg + vo[i]), (LAS unsigned*)(bp + KT_BYTES + i * 8192), 16, 0, 0); \
    } while (0)
#define ATT_WAIT_TILE(more_) do { if (more_) { if (NDMA == 2) asm volatile("s_waitcnt vmcnt(2) lgkmcnt(0)" ::: "memory"); else if (NDMA == 4) asm volatile("s_waitcnt vmcnt(4) lgkmcnt(0)" ::: "memory"); \
            else asm volatile("s_waitcnt vmcnt(5) lgkmcnt(0)" ::: "memory"); } else asm volatile("s_waitcnt vmcnt(0) lgkmcnt(0)" ::: "memory"); \
        __builtin_amdgcn_s_barrier(); asm volatile("" ::: "memory"); } while (0)

    const int n_tiles = kt_hi - kt_lo + 1;
    if (MODE == 1) { const int n4 = (a.q0 + QR) >> 2; for (int i = tid; i < n4; i += NTHR) *(LAS f32x4*)(lds + TBL_OFF + i * 16) = *(const f32x4*)(a.lfc + i * 4) * LOG2E; }
    asm volatile("s_waitcnt vmcnt(0)" ::: "memory");
    ATT_DMA(kt_hi, 0);
    if (n_tiles > 1) ATT_DMA(kt_hi - 1, 1);
    ATT_WAIT_TILE(n_tiles > 1);
    int cur = 0;
    for (int it = 0; it < n_tiles; ++it) {
        const int kt = kt_hi - it;
        if (it + 2 < n_tiles) { const int b2 = cur + 2 >= NBUF ? cur + 2 - NBUF : cur + 2; ATT_DMA(kt - 2, b2); }
        if (kt >= wkt_lo && kt <= wkt_hi) {
            LAS unsigned char* kbuf = lds + cur * BUF_BYTES; LAS unsigned char* vbuf = kbuf + KT_BYTES;
            f32x4 st[4][NQB];
#pragma unroll
            for (int kb = 0; kb < 4; ++kb)
#pragma unroll
                for (int qb = 0; qb < NQB; ++qb) st[kb][qb] = (f32x4){0.f, 0.f, 0.f, 0.f};
#pragma unroll
            for (int kb = 0; kb < 4; ++kb) {
#pragma unroll
                for (int kk = 0; kk < NKK; ++kk) {
                    bf16x8 af;
                    if (MODE == 2) af = *(const LAS bf16x8*)(kbuf + kb * 2048 + krd64 + ((x64 ^ (kk * 4)) * 16));
                    else if (MODE == 3 && kk >= 4) af = *(const LAS bf16x8*)(kbuf + K128_BYTES + kb * 2048 + krd64 + ((x64 ^ ((kk - 4) * 4)) * 16));
                    else af = *(const LAS bf16x8*)(kbuf + kb * 4096 + krd128 + ((x128 ^ (kk * 4)) * 16));
#pragma unroll
                    for (int qb = 0; qb < NQB; ++qb) st[kb][qb] = __builtin_amdgcn_mfma_f32_16x16x32_bf16(af, qf[qb][kk], st[kb][qb], 0, 0, 0);
                }
            }
            const bool need_mask = (MODE == 2) ? true : (MODE == 4) ? false : (kt * 64 + 63 >= wr0);
            if (need_mask) att_scores<MODE, NQB, NNB, true>(st, oacc, mrun, lsum, carry, ct, wr0, r, quad, kt, scale2, lds + TBL_OFF);
            else att_scores<MODE, NQB, NNB, false>(st, oacc, mrun, lsum, carry, ct, wr0, r, quad, kt, scale2, lds + TBL_OFF);
#pragma unroll
            for (int k2 = 0; k2 < 2; ++k2) {
                bf16x8 pf[NQB];
#pragma unroll
                for (int qb = 0; qb < NQB; ++qb) {
                    u32x4 w; w.x = cvt_pk_bf16(st[2 * k2][qb][0], st[2 * k2][qb][1]); w.y = cvt_pk_bf16(st[2 * k2][qb][2], st[2 * k2][qb][3]);
                    w.z = cvt_pk_bf16(st[2 * k2 + 1][qb][0], st[2 * k2 + 1][qb][1]); w.w = cvt_pk_bf16(st[2 * k2 + 1][qb][2], st[2 * k2 + 1][qb][3]);
                    pf[qb] = __builtin_bit_cast(bf16x8, w);
                }
                const int vof = vrd + ((y0 ^ k2) * 16);
#pragma unroll
                for (int nb = 0; nb < NNB; ++nb) {
                    const bf16x8 vf = *(const LAS bf16x8*)(vbuf + nb * 2048 + vof);
#pragma unroll
                    for (int qb = 0; qb < NQB; ++qb) oacc[nb][qb] = __builtin_amdgcn_mfma_f32_16x16x32_bf16(vf, pf[qb], oacc[nb][qb], 0, 0, 0);
                }
            }
        }
        ATT_WAIT_TILE(it + 2 < n_tiles);
        cur = cur + 1 == NBUF ? 0 : cur + 1;
    }
#undef ATT_DMA
#undef ATT_WAIT_TILE
#pragma unroll
    for (int qb = 0; qb < NQB; ++qb) {
        float inv = 1.f;
        if (MODE != 0) { float l = lsum[qb]; l += __shfl_xor(l, 16); l += __shfl_xor(l, 32); inv = 1.f / l; }
        const int t = wr0 + qb * 16 + r;
        bf16_t* op = a.o + (size_t)(a.qrow_base + t) * ATTW + a.ocol + quad * 4;
#pragma unroll
        for (int nb = 0; nb < NNB; ++nb) { const f32x4 v = oacc[nb][qb] * inv; u32x2 w; w.x = cvt_pk_bf16(v[0], v[1]); w.y = cvt_pk_bf16(v[2], v[3]); *(u32x2*)(op + nb * 16) = w; }
    }
}

__device__ __forceinline__ void mem_attn_item(const Params& p, LAS unsigned char* lds, int layer, int idx, const bf16_t* q, int ldq, int qoff) {
    constexpr int NQBLK = SEQ / (128 * NQB_MEM);
    const int qblk = idx % NQBLK, mh = (idx / NQBLK) & 3, b = idx / (4 * NQBLK);
    AttnArgs a;
    a.q = q; a.ldq = ldq; a.qoff = qoff + mh * 128;
    a.k = (const bf16_t*)(p.ws + OFF_MEMK); a.ldk = 2048; a.koff = layer * 512 + mh * 128; a.k2 = nullptr;
    a.vt = (const bf16_t*)(p.ws + OFF_MEMVT); a.ldvt = 2048; a.vrow0 = layer * 512 + mh * 128; a.vcol_base = layer * 512 + b * 256;
    a.qrow_base = b * SEQ; a.krow_base = layer * 512 + b * 256;
    a.o = (bf16_t*)(p.ws + OFF_ATT); a.ocol = 2048 + mh * 128; a.q0 = qblk * 128 * NQB_MEM;
    a.lfc = nullptr; a.biasrow = nullptr; a.sink = 0.f; a.pos = nullptr; a.scale = 0.08838834764831845f;
    attn_item<4, NQB_MEM>(lds, a);
}

__device__ void phase_attn(const Params& p, LAS unsigned char* lds, int layer) {
    const bf16_t* proj = (const bf16_t*)(p.ws + OFF_PROJ);
    if (layer == 2) {
        constexpr int NQBLK = SEQ / (128 * NQB_SWA);
        for (int idx = blockIdx.x; idx < 64 * NQBLK; idx += gridDim.x) {
            const int qblk = idx % NQBLK, head = (idx / NQBLK) & 31, b = idx / (32 * NQBLK), kvh = head >> 3;
            AttnArgs a;
            a.q = proj; a.ldq = 2816; a.qoff = head * 64;
            a.k = proj; a.ldk = 2816; a.koff = 2048 + kvh * 64; a.k2 = nullptr;
            a.vt = (const bf16_t*)(p.ws + OFF_VT); a.ldvt = T; a.vrow0 = kvh * 64; a.vcol_base = b * SEQ;
            a.qrow_base = b * SEQ; a.krow_base = b * SEQ;
            a.o = (bf16_t*)(p.ws + OFF_ATT); a.ocol = head * 64; a.q0 = qblk * 128 * NQB_SWA;
            a.lfc = nullptr; a.biasrow = (const float*)(p.ws + OFF_BIAST) + head * 128; a.sink = p.in[I_SWA_SINKS][head]; a.pos = nullptr; a.scale = 0.125f;
            attn_item<2, NQB_SWA>(lds, a);
        }
    } else {
        const int nqb = layer == 0 ? NQB_SB : layer == 1 ? NQB_FOX : NQB_MLA, NQBLK = SEQ / (128 * nqb);
        for (int ps = blockIdx.x; ps < 32 * (NQBLK / 2); ps += gridDim.x) {
            const int xcd = ps & 7, j = ps >> 3, combo = xcd * 4 + (j & 3), pair = j >> 2, b = combo >> 4, head = combo & 15;
            for (int s = 0; s < 2; ++s) {
                const int qblk = s == 0 ? NQBLK - 1 - pair : pair;
                AttnArgs a;
                a.vt = (const bf16_t*)(p.ws + OFF_VT); a.ldvt = T; a.vrow0 = head * 128; a.vcol_base = b * SEQ;
                a.qrow_base = b * SEQ; a.krow_base = b * SEQ;
                a.o = (bf16_t*)(p.ws + OFF_ATT); a.ocol = head * 128; a.q0 = qblk * 128 * nqb;
                a.lfc = nullptr; a.biasrow = nullptr; a.sink = 0.f; a.pos = nullptr; a.k2 = nullptr;
                if (layer == 3) {
                    a.q = (const bf16_t*)(p.ws + OFF_Q3); a.ldq = 3072; a.qoff = head * 192;
                    a.k = (const bf16_t*)(p.ws + OFF_KN); a.ldk = 2048; a.koff = head * 128; a.k2 = (const bf16_t*)(p.ws + OFF_KPE);
                    a.pos = (const int*)p.in[I_POS] + b * SEQ; a.scale = 0.07216878364870322f;
                    attn_item<3, NQB_MLA>(lds, a);
                } else {
                    a.q = proj; a.ldq = 4608; a.qoff = head * 128;
                    a.k = proj; a.ldk = 4608; a.koff = 2048 + head * 128; a.scale = 0.08838834764831845f;
                    if (layer == 1) { a.lfc = (const float*)(p.ws + OFF_LFC) + (size_t)(b * 16 + head) * 4096; attn_item<1, NQB_FOX>(lds, a); }
                    else attn_item<0, NQB_SB>(lds, a);
                }
            }
        }
    }
    for (int idx = blockIdx.x; idx < 8 * (SEQ / (128 * NQB_MEM)); idx += gridDim.x) {
        if (layer == 2) mem_attn_item(p, lds, layer, idx, proj, 2816, 2304);
        else if (layer == 3) mem_attn_item(p, lds, layer, idx, proj, 1536, 832);
        else mem_attn_item(p, lds, layer, idx, proj, 4608, 4096);
    }
}

enum { K_GIN = 0, K_ATT, K_GOUT, K_NORMF, K_GUP, K_CONVG, K_GDOWN, K_NORMA, K_MID, K_G2, K_FINAL, K_CONV, K_NORM0 };

__device__ __forceinline__ bool get_gemm(const Params& p, int kind, int layer, int gi, GemmDesc& d) {
    unsigned char* ws = p.ws;
    d.kind = 0; d.O = nullptr; d.X = nullptr; d.diag = 0; d.smode = 0;
    const bf16_t* h = (const bf16_t*)(ws + OFF_H);
    if (kind == K_GIN && layer == 0 && gi >= 2) {
        gi -= 2;
        if (gi == 0) { d.A = (const bf16_t*)(ws + OFF_MEMH); d.Bt = (const bf16_t*)(ws + W_MEMK); d.M = 2048; d.N = 2048; d.K = 2048; d.O = (bf16_t*)(ws + OFF_MEMK); d.ldc = 2048; d.diag = 1; return true; }
        if (gi == 1) { d.A = (const bf16_t*)(ws + W_MEMV); d.Bt = (const bf16_t*)(ws + OFF_MEMH); d.M = 2048; d.N = 2048; d.K = 2048; d.O = (bf16_t*)(ws + OFF_MEMVT); d.ldc = 2048; d.diag = 1; return true; }
        return false;
    }
    if (kind == K_GIN) {
        const size_t w1 = layer == 0 ? W_SB_IN1 : layer == 1 ? W_FOX_IN1 : layer == 2 ? W_SWA_IN1 : W_MLA_IN;
        const size_t wv = layer == 0 ? W_SB_V : layer == 1 ? W_FOX_V : W_SWA_V;
        const int n1 = layer < 2 ? 4608 : layer == 2 ? 2816 : 1536; const int mv = layer < 2 ? 2048 : layer == 2 ? 256 : 0;
        if (gi == 0) { d.A = h; d.Bt = (const bf16_t*)(ws + w1); d.M = T; d.N = n1; d.K = 2048; d.O = (bf16_t*)(ws + OFF_PROJ); d.ldc = n1; d.smode = 1; return true; }
        if (gi == 1 && mv) { d.A = (const bf16_t*)(ws + wv); d.Bt = h; d.M = mv; d.N = T; d.K = 2048; d.O = (bf16_t*)(ws + OFF_VT); d.ldc = T; d.smode = 2; return true; }
        return false;
    }
    if (kind == K_G2) {
        if (gi == 0) { d.A = (const bf16_t*)(ws + OFF_CQN); d.Bt = (const bf16_t*)(ws + W_MLA_UQ); d.M = T; d.N = 3072; d.K = 512; d.O = (bf16_t*)(ws + OFF_Q3); d.ldc = 3072; return true; }
        if (gi == 1) { d.A = (const bf16_t*)(ws + OFF_CKVN); d.Bt = (const bf16_t*)(ws + W_MLA_KN); d.M = T; d.N = 2048; d.K = 256; d.O = (bf16_t*)(ws + OFF_KN); d.ldc = 2048; return true; }
        if (gi == 2) { d.A = (const bf16_t*)(ws + W_MLA_V); d.Bt = (const bf16_t*)(ws + OFF_CKVN); d.M = 2048; d.N = T; d.K = 256; d.O = (bf16_t*)(ws + OFF_VT); d.ldc = T; return true; }
        return false;
    }
    if (kind == K_GOUT) {
        if (gi) return false;
        const size_t wo = layer == 0 ? W_SB_OUT : layer == 1 ? W_FOX_OUT : layer == 2 ? W_SWA_OUT : W_MLA_OUT;
        d.A = (const bf16_t*)(ws + OFF_ATT); d.Bt = (const bf16_t*)(ws + wo); d.M = T; d.N = 2048; d.K = 2560; d.kind = 1; d.X = (float*)(ws + OFF_XR); d.ldc = 2048; return true;
    }
    if (kind == K_GUP) {
        if (gi) return false;
        d.A = h; d.Bt = (const bf16_t*)(ws + W_UP) + (size_t)layer * 11264 * 2048; d.M = T; d.N = 11264; d.K = 2048; d.kind = 2; d.ldc = 11264; d.smode = 1; return true;
    }
    if (kind == K_GDOWN) {
        if (gi) return false;
        d.A = (const bf16_t*)(ws + OFF_G); d.Bt = (const bf16_t*)(ws + W_DOWN) + (size_t)layer * 2048 * 5632; d.M = T; d.N = 2048; d.K = 5632; d.kind = 1; d.X = (float*)(ws + OFF_XR); d.ldc = 2048; return true;
    }
    return false;
}

constexpr int N_PHASES = 1 + 6 + 5 + 5 + 8;
__device__ __forceinline__ void decode_phase(int ph, int& kind, int& layer) {
    if (ph == 0) { kind = K_CONV; layer = 0; return; }
    const int q = ph - 1;
    if (q < 16) {
        int k;
        if (q < 6) { layer = 0; k = q; } else if (q < 11) { layer = 1; k = q - 6; } else { layer = 2; k = q - 11; }
        kind = k == 0 ? K_GIN : k == 1 ? K_ATT : k == 2 ? K_GOUT : k == 3 ? K_GUP : k == 4 ? K_GDOWN : K_NORMA;
        return;
    }
    layer = 3; const int k = q - 16;
    kind = k == 0 ? K_GIN : k == 1 ? K_MID : k == 2 ? K_G2 : k == 3 ? K_ATT : k == 4 ? K_GOUT : k == 5 ? K_GUP : k == 6 ? K_GDOWN : K_FINAL;
}

__global__ void __launch_bounds__(NTHR, 2) fwd_megakernel(Params p) {
    extern __shared__ __attribute__((aligned(16))) unsigned char shm[];
    LAS unsigned char* lds = (LAS unsigned char*)shm;
    volatile LAS unsigned* xst = (volatile LAS unsigned*)(lds + LDS_BYTES - 16);
    if (threadIdx.x == 0) { xst[0] = 0u; xst[1] = 0u; xst[2] = 0u; xst[3] = 0u; }
    __syncthreads();
    const XcdBarrier xb = xcd_barrier_post((unsigned*)(p.ws + OFF_BAR), xst);
    for (int ph = p.ph_lo; ph < p.ph_hi; ++ph) {
        if (ph != p.ph_lo) { if (ph == p.ph_lo + 1) cg::this_grid().sync(); else xcd_barrier(xb); }
        int kind, layer; decode_phase(ph, kind, layer);
        if (kind == K_CONV) { phase_conv(p, lds); phase_norm(p, p.in[I_X], p.in[I_ATTN_NORM], 1); }
        else if (kind == K_NORMA) phase_norm(p, (const float*)(p.ws + OFF_XR), p.in[I_ATTN_NORM] + 1 * 2048, 2);
        else if (kind == K_FINAL) phase_norm(p, (const float*)(p.ws + OFF_XR), p.in[I_FINAL_NORM], 3);
        else if (kind == K_MID) phase_mla_mid(p);
        else if (kind == K_ATT) { for (int rep = 0; rep < PROBE_ATT_REPS; ++rep) { if (rep) xcd_barrier(xb); phase_attn(p, lds, layer); } }
        else if (kind == K_GIN && layer == 1) fox_scan(p, lds);
        if (kind == K_GIN || kind == K_G2 || kind == K_GOUT || kind == K_GUP || kind == K_GDOWN) {
            if (kind == K_GDOWN) {
                pg8::Order S0; S0.init(T, 2048, (int)gridDim.x, (int)blockIdx.x, 0); pg8::Unit u0;
                for (int i = 0; S0.next(i, u0); ++i) ffn_fixup(p, layer, u0.pm);
                asm volatile("s_waitcnt vmcnt(0)" ::: "memory");
            }
            const int greps = (kind == K_GIN || kind == K_G2 || kind == K_GUP) ? PROBE_GEMM_REPS : 1;
            for (int grep_ = 0; grep_ < greps; ++grep_) {
            if (grep_) xcd_barrier(xb);
            __syncthreads();
            int shift = 0;
            for (int gi = 0; gi < 4; ++gi) {
                GemmDesc d, d2; d2.M = 0; d2.N = 0; d2.A = nullptr; d2.Bt = nullptr; d2.O = nullptr; d2.ldc = 0; d2.smode = 0;
                if (!get_gemm(p, kind, layer, gi, d)) break;
                const bool merged = (kind == K_GIN && gi == 0) ? get_gemm(p, kind, layer, 1, d2) : false;
                pg8::Order S; const int G = (int)gridDim.x;
                S.init(d.M, d.N, G, (int)((blockIdx.x + G - shift) % G), d.diag, merged ? d2.M : 0, merged ? d2.N : 0);
                pg8::Epi E; E.kind = d.kind; E.smode = d.smode; E.O = d.O; E.X = d.X; E.XB = (bf16_t*)(p.ws + OFF_H); E.ssq = (float*)(p.ws + OFF_SSQ); E.ldc = d.ldc; E.lds = lds;
                E.cw = p.in[I_CONVW] + (size_t)layer * 3 * 11264; E.cb = p.in[I_CONVB] + (size_t)layer * 11264; E.G = (bf16_t*)(p.ws + OFF_G); E.US = (bf16_t*)(p.ws + OFF_U);
                pg8::Gemm g; g.A = d.A; g.Bt = d.Bt; g.M = d.M; g.N = d.N; g.K = d.K; g.A2 = d2.A; g.Bt2 = d2.Bt;
                E.O2 = d2.O; E.ldc2 = d2.ldc; E.smode2 = d2.smode;
                if (d.kind == 0) pg8::gemm_phase<0>(lds, g, S, E); else if (d.kind == 1) pg8::gemm_phase<1>(lds, g, S, E); else pg8::gemm_phase<2>(lds, g, S, E);
                const int nu = (d.diag ? 16 : (d.M / 256) * (d.N / 256)) + (merged ? (d2.M / 256) * (d2.N / 256) : 0);
                shift = ((shift + nu) % G) & ~7;
                if (merged) ++gi;
            }
            }
        }
    }
}

extern "C" void kernel_launch(void* const* d_in, const int* in_sizes, int n_in, void* d_out, int out_size, void* d_ws, size_t ws_size, hipStream_t stream) {
    static int grid = 0;
    if (grid == 0) {
        if (n_in != N_IN || ws_size < WS_END) { fprintf(stderr, "kernel_launch: unexpected n_in %d or ws_size %zu (< %zu)\n", n_in, ws_size, (size_t)WS_END); grid = -1; return; }
        int dev = 0, cus = 0, per_cu = 0;
        hipGetDevice(&dev); hipDeviceGetAttribute(&cus, hipDeviceAttributeMultiprocessorCount, dev);
        if (hipFuncSetAttribute((const void*)fwd_megakernel, hipFuncAttributeMaxDynamicSharedMemorySize, LDS_BYTES) != hipSuccess) { fprintf(stderr, "kernel_launch: hipFuncSetAttribute failed\n"); grid = -1; return; }
        if (hipOccupancyMaxActiveBlocksPerMultiprocessor(&per_cu, (const void*)fwd_megakernel, NTHR, LDS_BYTES) != hipSuccess || per_cu < 1) { fprintf(stderr, "kernel_launch: occupancy query says %d\n", per_cu); per_cu = 1; }
        (void)hipGetLastError();
        grid = cus;
        fprintf(stderr, "kernel_launch: grid %d (cus %d, per_cu %d)\n", grid, cus, per_cu);
    }
    if (grid < 0) return;
    if (hipMemsetAsync((char*)d_ws + OFF_BAR, 0, BAR_BYTES, stream) != hipSuccess) { fprintf(stderr, "kernel_launch: memset of barrier words failed\n"); return; }
    Params p{};
    for (int i = 0; i < N_IN; ++i) p.in[i] = (const float*)d_in[i];
    p.out = (float*)d_out; p.ws = (unsigned char*)d_ws;
#if N_LAUNCH_MODE == 1
    p.ph_lo = 0; p.ph_hi = N_PHASES;
    void* args[] = {&p};
    hipError_t e = hipLaunchCooperativeKernel((const void*)fwd_megakernel, dim3(grid), dim3(NTHR), args, LDS_BYTES, stream);
    if (e != hipSuccess) fprintf(stderr, "cooperative launch failed: %s (grid %d)\n", hipGetErrorString(e), grid);
#else
    for (int ph = 0; ph < N_PHASES; ++ph) {
        p.ph_lo = ph; p.ph_hi = ph + 1;
        hipLaunchKernelGGL(fwd_megakernel, dim3(grid), dim3(NTHR), LDS_BYTES, stream, p);
    }
#endif
}
```

```cpp
#include <hip/hip_runtime.h>
#include <hip/hip_cooperative_groups.h>
#include <cstdio>
#include <cstdint>
namespace cg = cooperative_groups;

#ifndef N_LAUNCH_MODE
#define N_LAUNCH_MODE 1
#endif

#ifndef RESCALE_ALWAYS
#define RESCALE_ALWAYS 1
#endif
#ifndef PROBE_GEMM_REPS
#define PROBE_GEMM_REPS 1
#endif
#ifndef PROBE_SYNC_EXTRA
#define PROBE_SYNC_EXTRA 0
#endif
#ifndef PROBE_ATT_REPS
#define PROBE_ATT_REPS 1
#endif
#define LAS __attribute__((address_space(3)))
typedef unsigned short bf16_t;
typedef short bf16x8 __attribute__((ext_vector_type(8)));
typedef float f32x4 __attribute__((ext_vector_type(4)));
typedef float f32x2 __attribute__((ext_vector_type(2)));
typedef unsigned u32x4 __attribute__((ext_vector_type(4)));
typedef unsigned u32x2 __attribute__((ext_vector_type(2)));

constexpr int T = 8192, D = 2048, SEQ = 4096, DFF = 5632, ATTW = 2560;
constexpr float LOG2E = 1.4426950408889634f;
constexpr int NTHR = 512, NWAVE = 8;
constexpr int LDS_BYTES = 140288;

constexpr size_t OFF_XR = 0;
constexpr size_t OFF_H = OFF_XR + (size_t)T * D * 4;
constexpr size_t OFF_PROJ = OFF_H + (size_t)T * D * 2;
constexpr size_t OFF_VT = OFF_PROJ + (size_t)T * 4608 * 2;
constexpr size_t OFF_ATT = OFF_VT + (size_t)2048 * T * 2;
constexpr size_t OFF_U = OFF_ATT + (size_t)T * ATTW * 2;
constexpr size_t OFF_G = OFF_U + (size_t)T * 11264 * 2;
constexpr size_t OFF_MEMH = OFF_G + (size_t)T * DFF * 2;
constexpr size_t OFF_MEMK = OFF_MEMH + (size_t)2048 * 2048 * 2;
constexpr size_t OFF_MEMVT = OFF_MEMK + (size_t)2048 * 2048 * 2;
constexpr size_t OFF_LF = OFF_MEMVT + (size_t)2048 * 2048 * 2;
constexpr size_t OFF_LFC = OFF_LF + (size_t)T * 16 * 4;
constexpr size_t OFF_BIAST = OFF_LFC + (size_t)32 * 4096 * 4;
constexpr size_t OFF_WF = OFF_BIAST + (size_t)32 * 128 * 4;
constexpr size_t OFF_CQN = OFF_WF + (size_t)16 * 2048 * 4;
constexpr size_t OFF_CKVN = OFF_CQN + (size_t)T * 512 * 2;
constexpr size_t OFF_KPE = OFF_CKVN + (size_t)T * 256 * 2;
constexpr size_t OFF_Q3 = OFF_KPE + (size_t)T * 64 * 2;
constexpr size_t OFF_KN = OFF_Q3 + (size_t)T * 3072 * 2;
constexpr size_t OFF_W = OFF_KN + (size_t)T * 2048 * 2;
constexpr size_t W_SB_IN1 = OFF_W;
constexpr size_t W_SB_V = W_SB_IN1 + (size_t)4608 * 2048 * 2;
constexpr size_t W_SB_OUT = W_SB_V + (size_t)2048 * 2048 * 2;
constexpr size_t W_FOX_IN1 = W_SB_OUT + (size_t)2048 * 2560 * 2;
constexpr size_t W_FOX_V = W_FOX_IN1 + (size_t)4608 * 2048 * 2;
constexpr size_t W_FOX_OUT = W_FOX_V + (size_t)2048 * 2048 * 2;
constexpr size_t W_SWA_IN1 = W_FOX_OUT + (size_t)2048 * 2560 * 2;
constexpr size_t W_SWA_V = W_SWA_IN1 + (size_t)2816 * 2048 * 2;
constexpr size_t W_SWA_OUT = W_SWA_V + (size_t)256 * 2048 * 2;
constexpr size_t W_MLA_IN = W_SWA_OUT + (size_t)2048 * 2560 * 2;
constexpr size_t W_MLA_UQ = W_MLA_IN + (size_t)1536 * 2048 * 2;
constexpr size_t W_MLA_KN = W_MLA_UQ + (size_t)3072 * 512 * 2;
constexpr size_t W_MLA_V = W_MLA_KN + (size_t)2048 * 256 * 2;
constexpr size_t W_MLA_OUT = W_MLA_V + (size_t)2048 * 256 * 2;
constexpr size_t W_MEMK = W_MLA_OUT + (size_t)2048 * 2560 * 2;
constexpr size_t W_MEMV = W_MEMK + (size_t)2048 * 2048 * 2;
constexpr size_t W_UP = W_MEMV + (size_t)2048 * 2048 * 2;
constexpr size_t W_DOWN = W_UP + (size_t)4 * 11264 * 2048 * 2;
constexpr size_t OFF_BAR = W_DOWN + (size_t)4 * 2048 * 5632 * 2;
constexpr size_t BAR_BYTES = 16384;
constexpr size_t OFF_SSQ = OFF_BAR + BAR_BYTES;
constexpr size_t WS_END = OFF_SSQ + (size_t)T * 32 * 4;

enum { I_X = 0, I_MEM, I_POS, I_RELB, I_ATTN_NORM, I_MEM_NORM, I_WMEMKV, I_FFN_NORM, I_WUP, I_CONVW, I_CONVB, I_WDOWN, I_FINAL_NORM,
       I_SB_IN, I_SB_OUT, I_FOX_IN, I_FOX_BF, I_FOX_OUT, I_SWA_IN, I_SWA_SINKS, I_SWA_OUT, I_MLA_IN, I_MLA_QN, I_MLA_UQ, I_MLA_KVN, I_MLA_UKV, I_MLA_OUT, N_IN };

struct Params {
    const float* in[N_IN];
    float* out;
    unsigned char* ws;
    int ph_lo, ph_hi;
};

__device__ __forceinline__ unsigned cvt_pk_bf16(float lo, float hi) { unsigned r; asm volatile("v_cvt_pk_bf16_f32 %0, %1, %2" : "=v"(r) : "v"(lo), "v"(hi)); return r; }
__device__ __forceinline__ int otid() { int t = threadIdx.x; asm volatile("" : "+v"(t)); return t; }
__device__ __forceinline__ float bf_lo(unsigned u) { return __uint_as_float(u << 16); }
__device__ __forceinline__ float bf_hi(unsigned u) { return __uint_as_float(u & 0xffff0000u); }
__device__ __forceinline__ float wave_sum(float v) {
#pragma unroll
    for (int o = 1; o < 64; o <<= 1) v += __shfl_xor(v, o);
    return v;
}
__device__ __forceinline__ float fast_exp2(float x) { return __builtin_amdgcn_exp2f(x); }
__device__ __forceinline__ void sincos_big(float ang, float& s, float& c) {
    const double a = (double)ang; const double n = rint(a * 0.15915494309189535); const float rf = (float)(a - n * 6.283185307179586);
    s = __sinf(rf); c = __cosf(rf);
}
__device__ __forceinline__ float rope_inv_freq(int i) { return exp2f(-(float)i * 0.41524101186092029f); }


#define XB_TMO      128
#define XB_XCNT(j)  (256  + 64 * (j))
#define XB_XSUB(j)  (1280 + 64 * (j))
#define XB_XGEN(j)  (2304 + 64 * (j))
#define XB_TOP      3328
#define XB_TOPGEN   3392
#define XCD_BAR_WORDS 3456
#define XB_SPIN_CAP (1u << 18)
__device__ __forceinline__ unsigned xb_ld(unsigned* p)              { return __hip_atomic_load(p, __ATOMIC_RELAXED, __HIP_MEMORY_SCOPE_AGENT); }
__device__ __forceinline__ unsigned xb_add(unsigned* p, unsigned v) { return __hip_atomic_fetch_add(p, v, __ATOMIC_RELAXED, __HIP_MEMORY_SCOPE_AGENT); }
__device__ __forceinline__ unsigned xb_xcc_id() { return (unsigned)__builtin_amdgcn_s_getreg((3 << 11) | 20) & 0xFu; }
#define XB_SPIN(cond, bar) do { unsigned _sp = 0; while (cond) { __builtin_amdgcn_s_sleep(1); \
    if ((++_sp & 255u) == 0u) { if (xb_ld(&(bar)[XB_TMO])) break; if (_sp > XB_SPIN_CAP) { atomicAdd(&(bar)[XB_TMO], 1u); break; } } } } while (0)
struct XcdBarrier { unsigned* bar; unsigned x; volatile LAS unsigned* st; };
__device__ __forceinline__ XcdBarrier xcd_barrier_post(unsigned* bar, volatile LAS unsigned* st) {
    XcdBarrier b; b.bar = bar; b.x = xb_xcc_id(); b.st = st;
    if (threadIdx.x == 0) (void)xb_add(&bar[XB_XCNT(b.x)], 1u);
    return b;
}
__device__ __forceinline__ void xcd_barrier_complete(unsigned* bar, unsigned x, unsigned& nloc, unsigned& nx) {
    const unsigned G = gridDim.x * gridDim.y * gridDim.z;
    unsigned sum, cnt, mine, sp = 0u;
    for (;;) {
        sum = 0u; cnt = 0u; mine = 0u;
#pragma unroll
        for (unsigned j = 0; j < 16; ++j) { const unsigned c = xb_ld(&bar[XB_XCNT(j)]); sum += c; cnt += (c > 0u) ? 1u : 0u; mine = (j == x) ? c : mine; }
        if (sum == G) break;
        __builtin_amdgcn_s_sleep(1);
        if ((++sp & 255u) == 0u) { if (xb_ld(&bar[XB_TMO])) break; if (sp > XB_SPIN_CAP) { atomicAdd(&bar[XB_TMO], 1u); break; } }
    }
    nloc = mine > 0u ? mine : 1u; nx = cnt > 0u ? cnt : 1u;
}
__device__ __forceinline__ void xcd_barrier(const XcdBarrier& b) {
    asm volatile("s_waitcnt vmcnt(0)" ::: "memory");
    __syncthreads();
    if (threadIdx.x == 0) {
        unsigned* bar = b.bar;
        __builtin_amdgcn_s_waitcnt(0);
        unsigned nloc = b.st[0], nx = b.st[1];
        if (nloc == 0u) { xcd_barrier_complete(bar, b.x, nloc, nx); b.st[0] = nloc; b.st[1] = nx; }
        const unsigned old = xb_add(&bar[XB_XSUB(b.x)], 1u);
        const unsigned gen = old / nloc;
        if (old + 1u == (gen + 1u) * nloc) {
            __builtin_amdgcn_fence(__ATOMIC_RELEASE, "agent");
            asm volatile("s_waitcnt vmcnt(0)" ::: "memory");
            const unsigned og = xb_add(&bar[XB_TOP], 1u);
            const unsigned tg = og / nx;
            if (og + 1u == (tg + 1u) * nx) xb_add(&bar[XB_TOPGEN], 1u);
            else XB_SPIN(xb_ld(&bar[XB_TOPGEN]) == tg, bar);
            __builtin_amdgcn_fence(__ATOMIC_ACQUIRE, "agent");
            xb_add(&bar[XB_XGEN(b.x)], 1u);
            asm volatile("s_waitcnt vmcnt(0)" ::: "memory");
        } else {
            XB_SPIN(xb_ld(&bar[XB_XGEN(b.x)]) == gen, bar);
            __builtin_amdgcn_fence(__ATOMIC_ACQUIRE, "agent");
            asm volatile("s_waitcnt vmcnt(0)" ::: "memory");
        }
    }
    __syncthreads();
}

namespace pg8 {
constexpr int BM = 256, BK = 64, HALF = 128, HTB = HALF * BK * 2, STAGE_BYTES = 8 * HTB, NXCD = 8, WGM = 8;
__device__ __forceinline__ int lds_byte(int r, int c) { const int st = (r >> 4) * 2 + (c >> 5), rr = r & 15, cc = c & 31, ob = rr * 64 + cc * 2; return st * 1024 + (ob ^ (((ob >> 9) & 1) << 5)); }
__device__ __forceinline__ void stage_rc(int b, int& R, int& C) { const int st = b / 1024, sb = b % 1024, swz = sb ^ (((sb >> 9) & 1) << 5); R = (st >> 1) * 16 + swz / 64; C = (st & 1) * 32 + (swz % 64) / 2; }
__device__ __forceinline__ int perm32(int rho) { const int n = rho >> 4, i = rho & 15; return 8 * (i >> 2) + 4 * n + (i & 3); }
struct Unit { int pm, pn, which; };
struct Gemm { const bf16_t* A; const bf16_t* Bt; int M, N, K; const bf16_t* A2; const bf16_t* Bt2; };

struct Order {
    int nM, nN, nwg, G, c, diag, nM2, nN2, nwg2;
    __device__ void init(int M, int N, int G_, int c_, int diag_, int M2 = 0, int N2 = 0) { nM = M / BM; nN = N / BM; nwg = nM * nN; G = G_; c = c_; diag = diag_; nM2 = M2 / BM; nN2 = N2 / BM; nwg2 = nM2 * nN2; }
    static __device__ void tile_map(int wgid, int nM_, int nN_, int nwg_, Unit& u) {
        { const int q = nwg_ / NXCD, r = nwg_ % NXCD, xcd = wgid % NXCD, off = wgid / NXCD; wgid = (xcd < r ? xcd * (q + 1) : r * (q + 1) + (xcd - r) * q) + off; }
        const int nig = WGM * nN_, gid = wgid / nig, fm = gid * WGM, gsz = (nM_ - fm) < WGM ? (nM_ - fm) : WGM;
        u.pm = fm + ((wgid % nig) % gsz); u.pn = (wgid % nig) / gsz;
    }
    __device__ bool next(int i, Unit& u) const {
        u.which = 0;
        if (diag) { const int L = i * G + c; if (L >= 16) return false; const int l = L >> 2; u.pm = 2 * l + (L & 1); u.pn = 2 * l + ((L >> 1) & 1); return true; }
        const long L = (long)i * G + c; if (L >= nwg + nwg2) return false;
        if (L < nwg) tile_map((int)L, nM, nN, nwg, u); else { u.which = 1; tile_map((int)L - nwg, nM2, nN2, nwg2, u); }
        return true;
    }
};

struct Epi {
    int kind, smode; bf16_t* O; float* X; bf16_t* XB; float* ssq; int ldc; LAS unsigned char* lds;
    bf16_t* O2; int ldc2, smode2;
    const float* cw; const float* cb; bf16_t* G; bf16_t* US;
    __device__ __forceinline__ float row_rs(int row, int fq) const {
        const f32x4 a = *(const f32x4*)(ssq + (size_t)row * 32 + fq * 8), b = *(const f32x4*)(ssq + (size_t)row * 32 + fq * 8 + 4);
        float t = ((a[0] + a[1]) + (a[2] + a[3])) + ((b[0] + b[1]) + (b[2] + b[3]));
        t += __shfl_xor(t, 16); t += __shfl_xor(t, 32);
        return rsqrtf(t * (1.f / 2048.f) + 1e-6f);
    }
    static __device__ __forceinline__ unsigned ror1(unsigned x) { return (unsigned)__builtin_amdgcn_update_dpp(0, (int)x, 0x121, 0xf, 0xf, false); }
    static __device__ __forceinline__ unsigned ror2(unsigned x) { return (unsigned)__builtin_amdgcn_update_dpp(0, (int)x, 0x122, 0xf, 0xf, false); }
    __device__ __forceinline__ void ffn_gate(const f32x4 (&acc)[2][2][4][2], const Unit& u, int wr, int wc, int fr, int fq) const {
        unsigned row0 = (unsigned)(u.pm * BM + wr * 64 + fr), ch0 = (unsigned)(u.pn * HALF + wc * 32 + 8 * fq);
        asm volatile("" : "+v"(row0), "+v"(ch0));
        u32x2 pk[2][2][4][2];
#pragma unroll
        for (int h = 0; h < 2; ++h) {
            f32x4 pa[4], pb[4];
#pragma unroll
            for (int i = 0; i < 4; ++i) { const unsigned qo = (row0 + h * HALF + i * 16) * 32u + fq * 8u; pa[i] = *(const f32x4*)(ssq + qo); pb[i] = *(const f32x4*)(ssq + qo + 4u); }
#pragma unroll
            for (int i = 0; i < 4; ++i) { float t = ((pa[i][0] + pa[i][1]) + (pa[i][2] + pa[i][3])) + ((pb[i][0] + pb[i][1]) + (pb[i][2] + pb[i][3]));
                t += __shfl_xor(t, 16); t += __shfl_xor(t, 32); const float rsr = rsqrtf(t * (1.f / 2048.f) + 1e-6f);
#pragma unroll
                for (int bj = 0; bj < 2; ++bj)
#pragma unroll
                    for (int n = 0; n < 2; ++n) { const f32x4 v = acc[h][bj][i][n] * rsr; pk[h][bj][i][n].x = cvt_pk_bf16(v[0], v[1]); pk[h][bj][i][n].y = cvt_pk_bf16(v[2], v[3]); } }
            __builtin_amdgcn_sched_barrier(0);
        }
#pragma unroll
        for (int n = 0; n < 2; ++n) {
            __builtin_amdgcn_sched_barrier(0);
            const unsigned ch = ch0 + 4u * n;
            const f32x4 wg0 = *(const f32x4*)(cw + ch), wg1 = *(const f32x4*)(cw + (11264u + ch)), wg2 = *(const f32x4*)(cw + (22528u + ch)), bg = *(const f32x4*)(cb + ch);
            const f32x4 wv0 = *(const f32x4*)(cw + (5632u + ch)), wv1 = *(const f32x4*)(cw + (16896u + ch)), wv2 = *(const f32x4*)(cw + (28160u + ch)), bv = *(const f32x4*)(cb + (5632u + ch));
#pragma unroll
            for (int ai = 0; ai < 2; ++ai) {
                u32x2 gp = (u32x2){0u, 0u}, vp = gp;
#pragma unroll
                for (int m = 0; m < 4; ++m) {
                    const unsigned row = row0 + ai * HALF + m * 16;
                    const u32x2 gc = pk[ai][0][m][n], vc = pk[ai][1][m][n];
                    u32x2 g1, g2, v1, v2;
#pragma unroll
                    for (int q = 0; q < 2; ++q) {
                        const unsigned a1 = ror1(gc[q]), b1 = ror1(gp[q]), a2 = ror2(gc[q]), b2 = ror2(gp[q]);
                        const unsigned c1 = ror1(vc[q]), d1 = ror1(vp[q]), c2 = ror2(vc[q]), d2 = ror2(vp[q]);
                        g1[q] = fr >= 1 ? a1 : b1; g2[q] = fr >= 2 ? a2 : b2; v1[q] = fr >= 1 ? c1 : d1; v2[q] = fr >= 2 ? c2 : d2;
                    }
                    float o[4];
#pragma unroll
                    for (int j = 0; j < 4; ++j) {
                        const int q = j >> 1; const bool hi = j & 1;
                        const float g0f = hi ? bf_hi(gc[q]) : bf_lo(gc[q]), g1f = hi ? bf_hi(g1[q]) : bf_lo(g1[q]), g2f = hi ? bf_hi(g2[q]) : bf_lo(g2[q]);
                        const float v0f = hi ? bf_hi(vc[q]) : bf_lo(vc[q]), v1f = hi ? bf_hi(v1[q]) : bf_lo(v1[q]), v2f = hi ? bf_hi(v2[q]) : bf_lo(v2[q]);
                        const float cg = bg[j] + wg0[j] * g2f + wg1[j] * g1f + wg2[j] * g0f;
                        const float cv = bv[j] + wv0[j] * v2f + wv1[j] * v1f + wv2[j] * v0f;
                        o[j] = __fdividef(cg, 1.f + __expf(-cg)) * cv;
                    }
                    { u32x2 w; w.x = cvt_pk_bf16(o[0], o[1]); w.y = cvt_pk_bf16(o[2], o[3]); *(u32x2*)(G + (row * 5632u + ch)) = w; }
                    if ((m == 0 && fr < 2) || (m == 3 && fr >= 14)) {
                        const unsigned slot = (m == 0) ? (unsigned)fr : (unsigned)(fr - 12), uo = ((row >> 6) * 4u + slot) * 11264u + ch;
                        *(u32x2*)(US + uo) = gc; *(u32x2*)(US + (uo + 5632u)) = vc;
                    }
                    gp = gc; vp = vc;
                    __builtin_amdgcn_sched_barrier(0);
                }
            }
        }
    }
    template <int KIND> __device__ __forceinline__ void init_acc(f32x4 (&acc)[2][2][4][2], const Unit& u, int wr, int wc, int fr, int fq) const {
        const int row0 = u.pm * BM + wr * 64 + fr, col0 = u.pn * BM + wc * 32 + 8 * fq;
#pragma unroll
        for (int ai = 0; ai < 2; ++ai)
#pragma unroll
            for (int bj = 0; bj < 2; ++bj)
#pragma unroll
                for (int m = 0; m < 4; ++m)
#pragma unroll
                    for (int n = 0; n < 2; ++n) {
                        if (KIND == 1) acc[ai][bj][m][n] = *(const f32x4*)(X + (size_t)(row0 + ai * HALF + m * 16) * ldc + col0 + bj * HALF + 4 * n);
                        else acc[ai][bj][m][n] = (f32x4){0.f, 0.f, 0.f, 0.f};
                    }
    }
    template <int KIND> __device__ __forceinline__ void run(const f32x4 (&acc)[2][2][4][2], const Unit& u, int wr, int wc, int fr, int fq) const {
        const int row0 = u.pm * BM + wr * 64 + fr, col0 = u.pn * BM + wc * 32 + 8 * fq;
        if (KIND == 2) { ffn_gate(acc, u, wr, wc, fr, fq); return; }
        if (KIND == 0) {
            const int sm = u.which ? smode2 : smode, ld = u.which ? ldc2 : ldc; bf16_t* Oo = u.which ? O2 : O;
            LAS float* wsc = (LAS float*)(lds + 131072) + (wr * 4 + wc) * 64;
            if (sm == 2) {
                const int i = fq * 16 + fr, tok = u.pn * BM + wc * 32 + (i & 31) + (i >> 5) * HALF;
                float t = 0.f;
#pragma unroll
                for (int j = 0; j < 8; ++j) { const f32x4 a = *(const f32x4*)(ssq + (size_t)tok * 32 + 4 * j); t += (a[0] + a[1]) + (a[2] + a[3]); }
                wsc[i] = rsqrtf(t * (1.f / 2048.f) + 1e-6f);
                asm volatile("s_waitcnt lgkmcnt(0)" ::: "memory");
            }
            float rs8[8];
            if (sm == 1) {
                f32x4 pa[8], pb[8];
#pragma unroll
                for (int i = 0; i < 8; ++i) { const float* q = ssq + (size_t)(row0 + (i >> 2) * HALF + (i & 3) * 16) * 32 + fq * 8; pa[i] = *(const f32x4*)q; pb[i] = *(const f32x4*)(q + 4); }
#pragma unroll
                for (int i = 0; i < 8; ++i) { float t = ((pa[i][0] + pa[i][1]) + (pa[i][2] + pa[i][3])) + ((pb[i][0] + pb[i][1]) + (pb[i][2] + pb[i][3]));
                    t += __shfl_xor(t, 16); t += __shfl_xor(t, 32); rs8[i] = rsqrtf(t * (1.f / 2048.f) + 1e-6f); }
            } else {
#pragma unroll
                for (int i = 0; i < 8; ++i) rs8[i] = 1.f;
            }
#pragma unroll
            for (int ai = 0; ai < 2; ++ai)
#pragma unroll
                for (int m = 0; m < 4; ++m) { const int row = row0 + ai * HALF + m * 16; bf16_t* rowp = Oo + (size_t)row * ld + col0;
                    const float rsr = rs8[ai * 4 + m];
#pragma unroll
                    for (int bj = 0; bj < 2; ++bj) { f32x4 v0 = acc[ai][bj][m][0] * rsr, v1 = acc[ai][bj][m][1] * rsr;
                        if (sm == 2) { const f32x4 q0 = *(const LAS f32x4*)(wsc + bj * 32 + 8 * fq), q1 = *(const LAS f32x4*)(wsc + bj * 32 + 8 * fq + 4); v0 = v0 * q0; v1 = v1 * q1; }
                        u32x4 w; w.x = cvt_pk_bf16(v0[0], v0[1]); w.y = cvt_pk_bf16(v0[2], v0[3]); w.z = cvt_pk_bf16(v1[0], v1[1]); w.w = cvt_pk_bf16(v1[2], v1[3]);
                        *(u32x4*)(rowp + bj * HALF) = w; } }
            if (sm == 2) asm volatile("s_waitcnt lgkmcnt(0)" ::: "memory");
        } else {
#pragma unroll
            for (int ai = 0; ai < 2; ++ai)
#pragma unroll
                for (int m = 0; m < 4; ++m) { const int row = row0 + ai * HALF + m * 16; float* rowp = X + (size_t)row * ldc + col0; bf16_t* bp = XB + (size_t)row * ldc + col0;
                    float ss = 0.f;
#pragma unroll
                    for (int bj = 0; bj < 2; ++bj) {
                        f32x4* p0 = (f32x4*)(rowp + bj * HALF); f32x4* p1 = (f32x4*)(rowp + bj * HALF + 4);
                        const f32x4 v0 = acc[ai][bj][m][0], v1 = acc[ai][bj][m][1];
                        *p0 = v0; *p1 = v1;
                        ss += (v0[0] * v0[0] + v0[1] * v0[1]) + (v0[2] * v0[2] + v0[3] * v0[3]) + (v1[0] * v1[0] + v1[1] * v1[1]) + (v1[2] * v1[2] + v1[3] * v1[3]);
                        u32x4 w; w.x = cvt_pk_bf16(v0[0], v0[1]); w.y = cvt_pk_bf16(v0[2], v0[3]); w.z = cvt_pk_bf16(v1[0], v1[1]); w.w = cvt_pk_bf16(v1[2], v1[3]);
                        *(u32x4*)(bp + bj * HALF) = w;
                    }
                    ss += __shfl_xor(ss, 16); ss += __shfl_xor(ss, 32);
                    if (fq == 0) ssq[(size_t)row * 32 + u.pn * 4 + wc] = ss;
                }
        }
    }
};

template <int KIND> __device__ __forceinline__ void gemm_phase(LAS unsigned char* lds, const Gemm g, const Order& S, const Epi& E) {
    const int tid = otid(), wid = __builtin_amdgcn_readfirstlane(tid >> 6), lane = tid & 63, wr = wid >> 2, wc = wid & 3, fr = lane & 15, fq = lane >> 4;
    const int K = g.K, nt = K / BK;
    unsigned voffA[2], voffB[2];
#pragma unroll
    for (int i = 0; i < 2; ++i) { int R, C; stage_rc(tid * 16 + i * 8192, R, C); const int Rb = (R & ~31) + perm32(R & 31);
        voffA[i] = (unsigned)(R * K + C) * 2u; voffB[i] = (unsigned)(Rb * K + C) * 2u; }
    const size_t kstep = (size_t)(BK * 2);
    const size_t hstep = (size_t)HALF * K * 2;
    const size_t tstep = 2 * hstep;
    const unsigned ldsw = (unsigned)wid * 1024u;
    const int aoff = lds_byte(wr * 64 + fr, fq * 8), boff = lds_byte(wc * 32 + fr, fq * 8);
#define PG8_SA(b, h) (((b) * 2 + (h)) * HTB)
#define PG8_SB(b, h) ((4 + (b) * 2 + (h)) * HTB)
#define PG8_STAGE(bufoff, gbase, voff) do { _Pragma("unroll") for (int _i = 0; _i < 2; ++_i) \
        __builtin_amdgcn_global_load_lds((const unsigned*)((const char*)(gbase) + (voff)[_i]), (LAS unsigned*)(lds + (bufoff) + ldsw + _i * 8192), 16, 0, 0); } while (0)
#define PG8_LDA(dst, b, h) do { _Pragma("unroll") for (int m = 0; m < 4; ++m) _Pragma("unroll") for (int k = 0; k < 2; ++k) dst[m][k] = *(const LAS bf16x8*)(lds + PG8_SA(b, h) + aoff + m * 2048 + k * 1024); } while (0)
#define PG8_LDB(dst, b, h) do { _Pragma("unroll") for (int n = 0; n < 2; ++n) _Pragma("unroll") for (int k = 0; k < 2; ++k) dst[n][k] = *(const LAS bf16x8*)(lds + PG8_SB(b, h) + boff + n * 2048 + k * 1024); } while (0)
#define PG8_MMA(ai, bj, At, Bt) do { __builtin_amdgcn_s_setprio(1); _Pragma("unroll") for (int m = 0; m < 4; ++m) _Pragma("unroll") for (int n = 0; n < 2; ++n) _Pragma("unroll") for (int k = 0; k < 2; ++k) \
        acc[ai][bj][m][n] = __builtin_amdgcn_mfma_f32_16x16x32_bf16(Bt[n][k], At[m][k], acc[ai][bj][m][n], 0, 0, 0); __builtin_amdgcn_s_setprio(0); } while (0)
#define PG8_WAIT_V(n) asm volatile("s_waitcnt vmcnt(" #n ")" ::: "memory")
#define PG8_WAIT_L(n) asm volatile("s_waitcnt lgkmcnt(" #n ")" ::: "memory")
#define PG8_BAR __builtin_amdgcn_s_barrier()
#define PG8_SCHED __builtin_amdgcn_sched_barrier(0)
    Unit cur, nxt; int ui = 0;
    if (!S.next(0, cur)) return;
    f32x4 acc[2][2][4][2];
    E.template init_acc<KIND>(acc, cur, wr, wc, fr, fq);
    bf16x8 At[4][2], B0[2][2], B1[2][2];
    const char* cA = (const char*)(cur.which ? g.A2 : g.A) + (size_t)cur.pm * tstep; const char* cB = (const char*)(cur.which ? g.Bt2 : g.Bt) + (size_t)cur.pn * tstep;
    PG8_STAGE(PG8_SB(0, 0), cB, voffB); PG8_STAGE(PG8_SA(0, 0), cA, voffA); PG8_STAGE(PG8_SB(0, 1), cB + hstep, voffB); PG8_STAGE(PG8_SA(0, 1), cA + hstep, voffA);
    if (wr == 1) PG8_BAR;
    PG8_WAIT_V(4); PG8_BAR;
    PG8_STAGE(PG8_SB(1, 0), cB + kstep, voffB); PG8_STAGE(PG8_SA(1, 0), cA + kstep, voffA); PG8_STAGE(PG8_SB(1, 1), cB + hstep + kstep, voffB);
    PG8_WAIT_V(6); PG8_BAR;
    for (;;) {
        const bool has_next = S.next(ui + 1, nxt);
        const char* nA = has_next ? (const char*)(nxt.which ? g.A2 : g.A) + (size_t)nxt.pm * tstep : cA; const char* nB = has_next ? (const char*)(nxt.which ? g.Bt2 : g.Bt) + (size_t)nxt.pn * tstep : cB;
        for (int t = 0; t < nt; t += 2) {
            const bool last = (t == nt - 2);
            const char* a1 = cA + (size_t)(t + 1) * kstep;
            const char* a2 = last ? nA : cA + (size_t)(t + 2) * kstep; const char* b2 = last ? nB : cB + (size_t)(t + 2) * kstep;
            const char* a3 = a2 + kstep; const char* b3 = b2 + kstep;
            PG8_LDB(B0, 0, 0); PG8_SCHED; PG8_LDA(At, 0, 0); PG8_STAGE(PG8_SA(1, 1), a1 + hstep, voffA);
            PG8_WAIT_L(8); PG8_BAR; PG8_WAIT_L(0); PG8_MMA(0, 0, At, B0); PG8_BAR; PG8_SCHED;
            PG8_LDB(B1, 0, 1); PG8_STAGE(PG8_SB(0, 0), b2, voffB);
            PG8_BAR; PG8_WAIT_L(0); PG8_MMA(0, 1, At, B1); PG8_BAR;
            PG8_LDA(At, 0, 1); PG8_STAGE(PG8_SA(0, 0), a2, voffA);
            PG8_BAR; PG8_WAIT_L(0); PG8_MMA(1, 0, At, B0); PG8_BAR; PG8_SCHED;
            PG8_STAGE(PG8_SB(0, 1), b2 + hstep, voffB);
            PG8_WAIT_V(6); PG8_BAR; PG8_MMA(1, 1, At, B1); PG8_BAR;
            PG8_LDB(B0, 1, 0); PG8_SCHED; PG8_LDA(At, 1, 0); PG8_STAGE(PG8_SA(0, 1), a2 + hstep, voffA);
            PG8_WAIT_L(8); PG8_BAR; PG8_WAIT_L(0); PG8_MMA(0, 0, At, B0); PG8_BAR; PG8_SCHED;
            PG8_LDB(B1, 1, 1); PG8_STAGE(PG8_SB(1, 0), b3, voffB);
            PG8_BAR; PG8_WAIT_L(0); PG8_MMA(0, 1, At, B1); PG8_BAR;
            PG8_LDA(At, 1, 1); PG8_STAGE(PG8_SA(1, 0), a3, voffA);
            PG8_BAR; PG8_WAIT_L(0); PG8_MMA(1, 0, At, B0); PG8_BAR; PG8_SCHED;
            PG8_STAGE(PG8_SB(1, 1), b3 + hstep, voffB);
            PG8_WAIT_V(6); PG8_BAR; PG8_MMA(1, 1, At, B1); PG8_BAR;
        }
        E.template run<KIND>(acc, cur, wr, wc, fr, fq);
        if (!has_next) break;
        E.template init_acc<KIND>(acc, nxt, wr, wc, fr, fq);
        cur = nxt; cA = nA; cB = nB; ++ui;
    }
    PG8_WAIT_V(0);
    if (wr == 0) PG8_BAR;
    PG8_BAR;
#undef PG8_SA
#undef PG8_SB
#undef PG8_STAGE
#undef PG8_LDA
#undef PG8_LDB
#undef PG8_MMA
#undef PG8_WAIT_V
#undef PG8_WAIT_L
#undef PG8_BAR
#undef PG8_SCHED
}
}

struct GemmDesc { const bf16_t* A; const bf16_t* Bt; int M, N, K; int kind; bf16_t* O; float* X; int ldc; int diag; int smode; };

struct Seg { const float* src; bf16_t* dst; const float* gain; int K, ldw, c0, ncols, rep, cstride, dstride, nitems; };
constexpr int NSEG = 37;

__device__ __forceinline__ void set_seg(LAS Seg* s, const float* src, bf16_t* dst, int K, int ldw, int c0, int ncols, int rep = 1, int cstride = 0, int dstride = 0, const float* gain = nullptr) {
    { int z = 0; asm volatile("" : "+v"(z)); K += z; ldw += z; c0 += z; ncols += z; rep += z; cstride += z; dstride += z; }
    { unsigned long long u0 = (unsigned long long)src, u1 = (unsigned long long)dst, u2 = (unsigned long long)gain; asm volatile("" : "+v"(u0), "+v"(u1), "+v"(u2));
      src = (const float*)u0; dst = (bf16_t*)u1; gain = (const float*)u2; }
    s->src = src; s->dst = dst; s->gain = gain; s->K = K; s->ldw = ldw; s->c0 = c0; s->ncols = ncols; s->rep = rep; s->cstride = cstride; s->dstride = dstride; s->nitems = (K / 64) * (ncols / 64) * rep;
}
__device__ void build_segs(const Params& p, LAS Seg* sg) {
    unsigned char* ws = p.ws; int n = 0;
    for (int i = 0; i < 4; ++i) {
        set_seg(sg + n++, p.in[I_WUP] + (size_t)i * 2048 * 11264, (bf16_t*)(ws + W_UP) + (size_t)i * 11264 * 2048, 2048, 11264, 0, 128, 44, 128, 256, p.in[I_FFN_NORM] + i * 2048);
        set_seg(sg + n++, p.in[I_WUP] + (size_t)i * 2048 * 11264, (bf16_t*)(ws + W_UP) + (size_t)i * 11264 * 2048 + (size_t)128 * 2048, 2048, 11264, 5632, 128, 44, 128, 256, p.in[I_FFN_NORM] + i * 2048);
        set_seg(sg + n++, p.in[I_WDOWN] + (size_t)i * 5632 * 2048, (bf16_t*)(ws + W_DOWN) + (size_t)i * 2048 * 5632, 5632, 2048, 0, 2048);
    }
    set_seg(sg + n++, p.in[I_SB_IN], (bf16_t*)(ws + W_SB_IN1), 2048, 6656, 0, 4096, 1, 0, 0, p.in[I_ATTN_NORM] + 0 * 2048);
    set_seg(sg + n++, p.in[I_SB_IN], (bf16_t*)(ws + W_SB_IN1) + (size_t)4096 * 2048, 2048, 6656, 6144, 512, 1, 0, 0, p.in[I_ATTN_NORM] + 0 * 2048);
    set_seg(sg + n++, p.in[I_SB_IN], (bf16_t*)(ws + W_SB_V), 2048, 6656, 4096, 2048, 1, 0, 0, p.in[I_ATTN_NORM] + 0 * 2048);
    set_seg(sg + n++, p.in[I_SB_OUT], (bf16_t*)(ws + W_SB_OUT), 2560, 2048, 0, 2048);
    set_seg(sg + n++, p.in[I_FOX_IN], (bf16_t*)(ws + W_FOX_IN1), 2048, 6672, 0, 4096, 1, 0, 0, p.in[I_ATTN_NORM] + 1 * 2048);
    set_seg(sg + n++, p.in[I_FOX_IN], (bf16_t*)(ws + W_FOX_IN1) + (size_t)4096 * 2048, 2048, 6672, 6160, 512, 1, 0, 0, p.in[I_ATTN_NORM] + 1 * 2048);
    set_seg(sg + n++, p.in[I_FOX_IN], (bf16_t*)(ws + W_FOX_V), 2048, 6672, 4096, 2048, 1, 0, 0, p.in[I_ATTN_NORM] + 1 * 2048);
    set_seg(sg + n++, p.in[I_FOX_OUT], (bf16_t*)(ws + W_FOX_OUT), 2560, 2048, 0, 2048);
    set_seg(sg + n++, p.in[I_SWA_IN], (bf16_t*)(ws + W_SWA_IN1), 2048, 3072, 0, 2304, 1, 0, 0, p.in[I_ATTN_NORM] + 2 * 2048);
    set_seg(sg + n++, p.in[I_SWA_IN], (bf16_t*)(ws + W_SWA_IN1) + (size_t)2304 * 2048, 2048, 3072, 2560, 512, 1, 0, 0, p.in[I_ATTN_NORM] + 2 * 2048);
    set_seg(sg + n++, p.in[I_SWA_IN], (bf16_t*)(ws + W_SWA_V), 2048, 3072, 2304, 256, 1, 0, 0, p.in[I_ATTN_NORM] + 2 * 2048);
    set_seg(sg + n++, p.in[I_SWA_OUT], (bf16_t*)(ws + W_SWA_OUT), 2560, 2048, 0, 2048);
    set_seg(sg + n++, p.in[I_MLA_IN], (bf16_t*)(ws + W_MLA_IN), 2048, 1344, 0, 1344, 1, 0, 0, p.in[I_ATTN_NORM] + 3 * 2048);
    set_seg(sg + n++, p.in[I_MLA_UQ], (bf16_t*)(ws + W_MLA_UQ), 512, 3072, 0, 3072);
    set_seg(sg + n++, p.in[I_MLA_UKV], (bf16_t*)(ws + W_MLA_KN), 256, 4096, 0, 128, 16, 256, 128);
    set_seg(sg + n++, p.in[I_MLA_UKV], (bf16_t*)(ws + W_MLA_V), 256, 4096, 128, 128, 16, 256, 128);
    set_seg(sg + n++, p.in[I_MLA_OUT], (bf16_t*)(ws + W_MLA_OUT), 2560, 2048, 0, 2048);
    for (int i = 0; i < 4; ++i) {
        set_seg(sg + n++, p.in[I_WMEMKV] + (size_t)i * 2048 * 1024, (bf16_t*)(ws + W_MEMK) + (size_t)i * 512 * 2048, 2048, 1024, 0, 512);
        set_seg(sg + n++, p.in[I_WMEMKV] + (size_t)i * 2048 * 1024, (bf16_t*)(ws + W_MEMV) + (size_t)i * 512 * 2048, 2048, 1024, 512, 512);
    }
}

__device__ __forceinline__ void transpose_item(const float* W, int ldw, int K, int c0, bf16_t* WT, int item, int nblk, LAS float* scr, int lane, const float* gain, bool nt) {
    const int kb = item / nblk, nb = item % nblk, k0 = 64 * kb, n0 = 64 * nb;
    const float* src = W + (size_t)(k0 + (lane >> 4)) * ldw + c0 + n0 + (lane & 15) * 4;
    f32x4 v[16];
#pragma unroll
    for (int j = 0; j < 16; ++j) v[j] = __builtin_nontemporal_load((const f32x4*)(src + (size_t)(4 * j) * ldw));
    if (gain) {
#pragma unroll
        for (int j = 0; j < 16; ++j) v[j] = v[j] * gain[k0 + 4 * j + (lane >> 4)];
    }
#pragma unroll
    for (int j = 0; j < 16; ++j) { LAS float* d = scr + (4 * j + (lane >> 4)) * 65 + (lane & 15) * 4; d[0] = v[j].x; d[1] = v[j].y; d[2] = v[j].z; d[3] = v[j].w; }
    asm volatile("s_waitcnt lgkmcnt(0)" ::: "memory");
    const int c = lane & 7;
#pragma unroll
    for (int j = 0; j < 8; ++j) { const int n = (lane >> 3) + 8 * j; const LAS float* sp = scr + (8 * c) * 65 + n;
        u32x4 o; o.x = cvt_pk_bf16(sp[0 * 65], sp[1 * 65]); o.y = cvt_pk_bf16(sp[2 * 65], sp[3 * 65]); o.z = cvt_pk_bf16(sp[4 * 65], sp[5 * 65]); o.w = cvt_pk_bf16(sp[6 * 65], sp[7 * 65]);
        u32x4* dp = (u32x4*)(WT + (size_t)(n0 + n) * K + k0 + 8 * c);
        if (nt) __builtin_nontemporal_store(o, dp); else *dp = o; }
    asm volatile("s_waitcnt lgkmcnt(0)" ::: "memory");
}

__device__ __forceinline__ void rms_row_bf16(const float* xrow, const float* g, bf16_t* orow, float* xcopy, int lane, f32x4 (&y)[8]) {
    const f32x4* xr = (const f32x4*)xrow + lane; float ss = 0.f;
#pragma unroll
    for (int j = 0; j < 8; ++j) { y[j] = xr[64 * j]; ss += (y[j].x * y[j].x + y[j].y * y[j].y) + (y[j].z * y[j].z + y[j].w * y[j].w); }
    if (xcopy) {
#pragma unroll
        for (int j = 0; j < 8; ++j) ((f32x4*)xcopy + lane)[64 * j] = y[j];
    }
    const float rs = rsqrtf(wave_sum(ss) * (1.f / 2048.f) + 1e-6f);
    const f32x4* gr = (const f32x4*)g + lane; u32x2* o8 = (u32x2*)orow + lane;
#pragma unroll
    for (int j = 0; j < 8; ++j) { const f32x4 gg = gr[64 * j]; y[j] = (y[j] * rs) * gg; u32x2 w; w.x = cvt_pk_bf16(y[j].x, y[j].y); w.y = cvt_pk_bf16(y[j].z, y[j].w); o8[64 * j] = w; }
}

__device__ void phase_conv(const Params& p, LAS unsigned char* lds) {
    LAS Seg* sg = (LAS Seg*)lds;
    const int tid = otid(), wave = tid >> 6, lane = tid & 63;
    if (tid == 0) build_segs(p, sg);
    __syncthreads();
    LAS float* scr = (LAS float*)(lds + 4096 + wave * 16640);
    const int gw = blockIdx.x * NWAVE + wave, NGW = gridDim.x * NWAVE;
    int total = 0;
    for (int s = 0; s < NSEG; ++s) total += sg[s].nitems;
    for (int it = gw; it < total; it += NGW) {
        int r = it, s = 0;
        while (r >= sg[s].nitems) { r -= sg[s].nitems; ++s; }
        const int K = sg[s].K, nblk = sg[s].ncols / 64, per = (K / 64) * nblk, ri = r / per, within = r - ri * per;
        const size_t doff = (size_t)((const unsigned char*)sg[s].dst - p.ws);
        const bool keep = (doff >= W_SB_IN1 && doff < W_FOX_IN1) || (doff >= W_MEMK && doff < W_UP + (size_t)11264 * 2048 * 2) || (doff >= W_DOWN && doff < W_DOWN + (size_t)2048 * 5632 * 2);
        transpose_item(sg[s].src, sg[s].ldw, K, sg[s].c0 + ri * sg[s].cstride, sg[s].dst + (size_t)ri * sg[s].dstride * K, within, nblk, scr, lane, sg[s].gain, !keep);
    }
    for (int rt = gw; rt < 2048; rt += NGW) {
        const int l = rt >> 9, r = rt & 511; f32x4 y[8];
        rms_row_bf16(p.in[I_MEM] + (size_t)r * 2048, p.in[I_MEM_NORM] + l * 2048, (bf16_t*)(p.ws + OFF_MEMH) + (size_t)rt * 2048, nullptr, lane, y);
    }
    const int gt = blockIdx.x * NTHR + tid, NT = gridDim.x * NTHR;
    for (int i = gt; i < 32 * 128; i += NT) {
        const int h = i >> 7, dist = i & 127; int bucket;
        if (dist < 16) bucket = dist;
        else { const float d = (float)dist; int large = 16 + (int)(logf(d / 16.f) / 2.0794415416798357f * 16.f); bucket = large < 31 ? large : 31; }
        ((float*)(p.ws + OFF_BIAST))[i] = p.in[I_RELB][bucket * 32 + h];
    }
    for (int i = gt; i < 16 * 2048; i += NT) { const int j = i >> 11, k = i & 2047; ((float*)(p.ws + OFF_WF))[i] = p.in[I_FOX_IN][(size_t)k * 6672 + 6144 + j]; }
    for (int i = gt; i < 192 * 2048 / 8; i += NT) ((u32x4*)((bf16_t*)(p.ws + W_MLA_IN) + (size_t)1344 * 2048))[i] = (u32x4){0u, 0u, 0u, 0u};
}

__device__ void phase_norm(const Params& p, const float* xin, const float* g, int mode) {
    const int tid = otid(), wave = tid >> 6, lane = tid & 63;
    const int gw = blockIdx.x * NWAVE + wave, NGW = gridDim.x * NWAVE;
    for (int row = gw; row < T; row += NGW) {
        const f32x4* xr = (const f32x4*)(xin + (size_t)row * 2048) + lane; f32x4 y[8]; float ss = 0.f;
#pragma unroll
        for (int j = 0; j < 8; ++j) { y[j] = xr[64 * j]; ss += (y[j].x * y[j].x + y[j].y * y[j].y) + (y[j].z * y[j].z + y[j].w * y[j].w); }
        ss = wave_sum(ss);
        if (mode == 1) {
            f32x4* xc = (f32x4*)((float*)(p.ws + OFF_XR) + (size_t)row * 2048) + lane; u32x2* o8 = (u32x2*)((bf16_t*)(p.ws + OFF_H) + (size_t)row * 2048) + lane;
#pragma unroll
            for (int j = 0; j < 8; ++j) { xc[64 * j] = y[j]; u32x2 w; w.x = cvt_pk_bf16(y[j].x, y[j].y); w.y = cvt_pk_bf16(y[j].z, y[j].w); o8[64 * j] = w; }
            if (lane < 32) ((float*)(p.ws + OFF_SSQ))[(size_t)row * 32 + lane] = lane == 0 ? ss : 0.f;
            continue;
        }
        const float rs = rsqrtf(ss * (1.f / 2048.f) + 1e-6f);
        const f32x4* gr = (const f32x4*)g + lane;
        if (mode == 3) {
            f32x4* o = (f32x4*)(p.out + (size_t)row * 2048) + lane;
#pragma unroll
            for (int j = 0; j < 8; ++j) o[64 * j] = (y[j] * rs) * gr[64 * j];
            continue;
        }
#pragma unroll
        for (int j = 0; j < 8; ++j) y[j] = (y[j] * rs) * gr[64 * j];
        const float* wf = (const float*)(p.ws + OFF_WF);
        float mine = 0.f;
#pragma unroll 1
        for (int jf = 0; jf < 16; ++jf) {
            const f32x4* wr_ = (const f32x4*)(wf + jf * 2048) + lane; float d = 0.f;
#pragma unroll
            for (int j = 0; j < 8; ++j) { const f32x4 w = wr_[64 * j]; d += (y[j].x * w.x + y[j].y * w.y) + (y[j].z * w.z + y[j].w * w.w); }
            d = wave_sum(d);
            if (lane == jf) mine = d;
        }
        if (lane < 16) { const float xv = mine + p.in[I_FOX_BF][lane]; const float ls = fminf(xv, 0.f) - __logf(1.f + __expf(-fabsf(xv))); ((float*)(p.ws + OFF_LF))[(size_t)row * 16 + lane] = ls; }
    }
}

__device__ void fox_scan(const Params& p, LAS unsigned char* lds) {
    LAS float* sh = (LAS float*)lds; const int tid = otid();
    for (int bh = blockIdx.x; bh < 32; bh += gridDim.x) {
        const int bb = bh >> 4, head = bh & 15; const float* lf = (const float*)(p.ws + OFF_LF); float* lfc = (float*)(p.ws + OFF_LFC) + (size_t)bh * 4096;
        float v[8]; float run = 0.f;
#pragma unroll
        for (int e = 0; e < 8; ++e) { run += lf[(size_t)(bb * 4096 + tid * 8 + e) * 16 + head]; v[e] = run; }
        sh[tid] = run; __syncthreads();
        for (int off = 1; off < 512; off <<= 1) { float x = sh[tid]; if (tid >= off) x += sh[tid - off]; __syncthreads(); sh[tid] = x; __syncthreads(); }
        const float excl = sh[tid] - run;
#pragma unroll
        for (int e = 0; e < 8; ++e) lfc[tid * 8 + e] = excl + v[e];
        __syncthreads();
    }
}

__device__ void ffn_fixup(const Params& p, int layer, int pm) {
    const bf16_t* us = (const bf16_t*)(p.ws + OFF_U); bf16_t* g = (bf16_t*)(p.ws + OFF_G);
    const float* cw = p.in[I_CONVW] + (size_t)layer * 3 * 11264; const float* cb = p.in[I_CONVB] + (size_t)layer * 11264;
    constexpr int NCH = DFF / 8;
    for (int item = otid(); item < 8 * NCH; item += NTHR) {
        const int ri = item / NCH, chunk = item - ri * NCH, c = chunk * 8, w = ri & 1, t = pm * 256 + (ri >> 1) * 64 + w, blk = t >> 6, tl = t & (SEQ - 1);
        const bf16_t* r0 = us + ((size_t)blk * 4 + w) * 11264 + c;
        const bf16_t* r1 = w == 1 ? us + ((size_t)blk * 4 + 0) * 11264 + c : us + ((size_t)(blk - 1) * 4 + 3) * 11264 + c;
        const bf16_t* r2 = w == 1 ? us + ((size_t)(blk - 1) * 4 + 3) * 11264 + c : us + ((size_t)(blk - 1) * 4 + 2) * 11264 + c;
        const bool has1 = tl >= 1, has2 = tl >= 2;
        const u32x4 z4 = (u32x4){0u, 0u, 0u, 0u};
        const u32x4 a0 = *(const u32x4*)r0, b0 = *(const u32x4*)(r0 + DFF);
        const u32x4 a1 = has1 ? *(const u32x4*)r1 : z4, b1 = has1 ? *(const u32x4*)(r1 + DFF) : z4;
        const u32x4 a2 = has2 ? *(const u32x4*)r2 : z4, b2 = has2 ? *(const u32x4*)(r2 + DFF) : z4;
        float o[8];
#pragma unroll
        for (int e = 0; e < 8; ++e) {
            const int q = e >> 1; const bool hi = e & 1;
            const float g0 = hi ? bf_hi(a0[q]) : bf_lo(a0[q]), g1 = hi ? bf_hi(a1[q]) : bf_lo(a1[q]), g2 = hi ? bf_hi(a2[q]) : bf_lo(a2[q]);
            const float v0 = hi ? bf_hi(b0[q]) : bf_lo(b0[q]), v1 = hi ? bf_hi(b1[q]) : bf_lo(b1[q]), v2 = hi ? bf_hi(b2[q]) : bf_lo(b2[q]);
            const float cg = cb[c + e] + cw[c + e] * g2 + cw[11264 + c + e] * g1 + cw[22528 + c + e] * g0;
            const float cv = cb[DFF + c + e] + cw[DFF + c + e] * v2 + cw[11264 + DFF + c + e] * v1 + cw[22528 + DFF + c + e] * v0;
            o[e] = cg / (1.f + __expf(-cg)) * cv;
        }
        u32x4 wv; wv.x = cvt_pk_bf16(o[0], o[1]); wv.y = cvt_pk_bf16(o[2], o[3]); wv.z = cvt_pk_bf16(o[4], o[5]); wv.w = cvt_pk_bf16(o[6], o[7]);
        *(u32x4*)(g + (size_t)t * DFF + c) = wv;
    }
}

__device__ void phase_mla_mid(const Params& p) {
    const int tid = otid(), wave = tid >> 6, lane = tid & 63;
    const int gw = blockIdx.x * NWAVE + wave, NGW = gridDim.x * NWAVE;
    const bf16_t* pr = (const bf16_t*)(p.ws + OFF_PROJ);
    for (int row = gw; row < T; row += NGW) {
        const bf16_t* rp = pr + (size_t)row * 1536;
        { const u32x4 a = *(const u32x4*)(rp + lane * 8); float v[8];
#pragma unroll
          for (int e = 0; e < 4; ++e) { v[2 * e] = bf_lo(a[e]); v[2 * e + 1] = bf_hi(a[e]); }
          float ss = 0.f;
#pragma unroll
          for (int e = 0; e < 8; ++e) ss += v[e] * v[e];
          const float rs = rsqrtf(wave_sum(ss) * (1.f / 512.f) + 1e-6f);
          const f32x4 g0 = *(const f32x4*)(p.in[I_MLA_QN] + lane * 8), g1 = *(const f32x4*)(p.in[I_MLA_QN] + lane * 8 + 4);
          u32x4 w; w.x = cvt_pk_bf16(v[0] * rs * g0[0], v[1] * rs * g0[1]); w.y = cvt_pk_bf16(v[2] * rs * g0[2], v[3] * rs * g0[3]);
          w.z = cvt_pk_bf16(v[4] * rs * g1[0], v[5] * rs * g1[1]); w.w = cvt_pk_bf16(v[6] * rs * g1[2], v[7] * rs * g1[3]);
          *(u32x4*)((bf16_t*)(p.ws + OFF_CQN) + (size_t)row * 512 + lane * 8) = w; }
        { const u32x2 a = *(const u32x2*)(rp + 512 + lane * 4); float v[4] = {bf_lo(a.x), bf_hi(a.x), bf_lo(a.y), bf_hi(a.y)};
          const float ss = v[0] * v[0] + v[1] * v[1] + v[2] * v[2] + v[3] * v[3];
          const float rs = rsqrtf(wave_sum(ss) * (1.f / 256.f) + 1e-6f);
          const f32x4 g0 = *(const f32x4*)(p.in[I_MLA_KVN] + lane * 4);
          u32x2 w; w.x = cvt_pk_bf16(v[0] * rs * g0[0], v[1] * rs * g0[1]); w.y = cvt_pk_bf16(v[2] * rs * g0[2], v[3] * rs * g0[3]);
          *(u32x2*)((bf16_t*)(p.ws + OFF_CKVN) + (size_t)row * 256 + lane * 4) = w; }
        if (lane < 32) {
            const float x1 = __uint_as_float((unsigned)rp[768 + lane] << 16), x2 = __uint_as_float((unsigned)rp[800 + lane] << 16);
            const float pos = (float)((const int*)p.in[I_POS])[row]; float s, c; sincos_big(pos * rope_inv_freq(lane), s, c);
            bf16_t* ko = (bf16_t*)(p.ws + OFF_KPE) + (size_t)row * 64;
            const unsigned w = cvt_pk_bf16(x1 * c - x2 * s, x2 * c + x1 * s);
            ko[lane] = (bf16_t)(w & 0xffffu); ko[32 + lane] = (bf16_t)(w >> 16);
        }
    }
}

struct AttnArgs {
    const bf16_t* q; int ldq, qoff;
    const bf16_t* k; int ldk, koff;
    const bf16_t* k2;
    const bf16_t* vt; int ldvt, vrow0, vcol_base;
    int qrow_base, krow_base;
    bf16_t* o; int ocol;
    int q0;
    const float* lfc; const float* biasrow; float sink; const int* pos;
    float scale;
};

#ifndef NQB_SB
#define NQB_SB 2
#endif
#ifndef NQB_FOX
#define NQB_FOX 2
#endif
#ifndef NQB_SWA
#define NQB_SWA 2
#endif
#ifndef NQB_MLA
#define NQB_MLA 2
#endif
#ifndef NQB_MEM
#define NQB_MEM 1
#endif
template <int MODE, int NQB, int NNB, bool MASKED>
__device__ __forceinline__ void att_scores(f32x4 (&st)[4][NQB], f32x4 (&oacc)[NNB][NQB], float (&mrun)[NQB], float (&lsum)[NQB], float (&carry)[NQB], const float (&ct)[NQB],
                                           int wr0, int r, int quad, int kt, float scale2, LAS unsigned char* tbl) {
    const int key0 = kt * 64 + quad * 4;
#pragma unroll
    for (int qb = 0; qb < NQB; ++qb) {
        const int t = wr0 + qb * 16 + r;
        if (MODE == 0) {
            float gprod[4];
#pragma unroll
            for (int kb = 0; kb < 4; ++kb) {
                float pe = 1.f;
#pragma unroll
                for (int j = 3; j >= 0; --j) {
                    const float u = __builtin_amdgcn_fmed3f(st[kb][qb][j] * scale2, -115.f, 115.f);
                    const float e = fast_exp2(u);
                    float beta = __builtin_amdgcn_rcpf(1.f + e), omb = e * beta;
                    if (MASKED) { const bool valid = (key0 + kb * 16 + j) < t; beta = valid ? beta : 0.f; omb = valid ? omb : 1.f; }
                    st[kb][qb][j] = beta * pe;
                    pe *= omb;
                }
                gprod[kb] = pe;
            }
            float Hh[4], Tt[4];
#pragma unroll
            for (int kb = 0; kb < 4; ++kb) {
                const float g0 = gprod[kb], g1 = __shfl_xor(g0, 16), g2 = __shfl_xor(g0, 32), g3 = __shfl_xor(g0, 48);
                Tt[kb] = (g0 * g1) * (g2 * g3);
                Hh[kb] = (((quad ^ 1) > quad) ? g1 : 1.f) * (((quad ^ 2) > quad) ? g2 : 1.f) * (((quad ^ 3) > quad) ? g3 : 1.f);
            }
            float Bs = carry[qb];
#pragma unroll
            for (int kb = 3; kb >= 0; --kb) {
                const float mul = Hh[kb] * Bs;
#pragma unroll
                for (int j = 0; j < 4; ++j) st[kb][qb][j] *= mul;
                Bs *= Tt[kb];
            }
            carry[qb] = Bs;
        } else {
            float mx = -INFINITY;
#pragma unroll
            for (int kb = 0; kb < 4; ++kb) {
                f32x4 cs = (f32x4){0.f, 0.f, 0.f, 0.f};
                if (MODE == 1) cs = *(const LAS f32x4*)(tbl + (kt * 64 + kb * 16 + quad * 4) * 4);
#pragma unroll
                for (int j = 0; j < 4; ++j) {
                    const int key = key0 + kb * 16 + j;
                    float v = st[kb][qb][j] * scale2;
                    if (MODE == 1) v += ct[qb] - cs[j];
                    if (MODE == 2) { const int dist = t - key; const bool valid = dist >= 0 && dist < 128; const int di = dist < 0 ? 0 : (dist > 127 ? 127 : dist); v += ((const LAS float*)tbl)[di]; v = valid ? v : -INFINITY; }
                    else if (MASKED) v = (key <= t) ? v : -INFINITY;
                    st[kb][qb][j] = v; mx = fmaxf(mx, v);
                }
            }
            mx = fmaxf(mx, __shfl_xor(mx, 16)); mx = fmaxf(mx, __shfl_xor(mx, 32));
            const float m_old = mrun[qb], m_new = fmaxf(m_old, mx), m_use = (m_new == -INFINITY) ? 0.f : m_new;
            const float alpha = fast_exp2(m_old - m_use);
            mrun[qb] = m_new;
            float ps = 0.f;
#pragma unroll
            for (int kb = 0; kb < 4; ++kb)
#pragma unroll
                for (int j = 0; j < 4; ++j) { const float pv = fast_exp2(st[kb][qb][j] - m_use); st[kb][qb][j] = pv; ps += pv; }
            lsum[qb] = lsum[qb] * alpha + ps;
            if (RESCALE_ALWAYS || __builtin_amdgcn_ballot_w64(m_new != m_old) != 0ull) {
#pragma unroll
                for (int nb = 0; nb < NNB; ++nb) oacc[nb][qb] = oacc[nb][qb] * alpha;
            }
        }
    }
}

template <int MODE, int NQB>
__device__ __forceinline__ void attn_item(LAS unsigned char* lds, const AttnArgs& a) {
    constexpr int WROWS = 16 * NQB, QR = 128 * NQB;
    constexpr int DK = (MODE == 2) ? 64 : (MODE == 3 ? 192 : 128);
    constexpr int DV = (MODE == 2) ? 64 : 128;
    constexpr int NKK = DK / 32, NNB = DV / 16;
    constexpr int K128_BYTES = (MODE == 2) ? 0 : 16384;
    constexpr int K64_BYTES = (MODE == 2 || MODE == 3) ? 8192 : 0;
    constexpr int KT_BYTES = K128_BYTES + K64_BYTES, VT_BYTES = DV * 128, BUF_BYTES = KT_BYTES + VT_BYTES + 256;
    constexpr int NP128 = K128_BYTES / 8192, NPV = VT_BYTES / 8192;
    constexpr int NBUF = 3, TBL_OFF = NBUF * BUF_BYTES;
    constexpr int NDMA = NP128 + (K64_BYTES ? 1 : 0) + NPV;
    const int tid = otid(), wave = __builtin_amdgcn_readfirstlane(tid >> 6), lane = tid & 63, r = lane & 15, quad = lane >> 4;
    const int wr0 = a.q0 + wave * WROWS;
    int kt_hi, kt_lo, wkt_hi, wkt_lo;
    if (MODE == 4) { kt_lo = 0; kt_hi = 3; wkt_lo = 0; wkt_hi = 3; }
    else if (MODE == 2) { kt_hi = (a.q0 + QR - 1) >> 6; kt_lo = a.q0 >= 128 ? (a.q0 - 128) >> 6 : 0; wkt_hi = (wr0 + WROWS - 1) >> 6; wkt_lo = wr0 >= 127 ? (wr0 - 127) >> 6 : 0; }
    else { kt_hi = (a.q0 + QR - 1) >> 6; kt_lo = 0; wkt_hi = (wr0 + WROWS - 1) >> 6; wkt_lo = 0; }

    unsigned ko128[NP128 > 0 ? NP128 : 1], ko64 = 0, vo[NPV];
#pragma unroll
    for (int i = 0; i < NP128; ++i) { const int s = (wave + 8 * i) * 64 + lane, row = s >> 4, cp = s & 15, c = cp ^ (row & 15); ko128[i] = (unsigned)(row * a.ldk + c * 8) * 2u; }
    if (K64_BYTES) { const int s = wave * 64 + lane, row = s >> 3, cp = s & 7, c = cp ^ ((row >> 1) & 7); ko64 = (unsigned)(row * (MODE == 3 ? 64 : a.ldk) + c * 8) * 2u; }
#pragma unroll
    for (int i = 0; i < NPV; ++i) { const int s = (wave + 8 * i) * 64 + lane, row = s >> 3, cp = s & 7, c = cp ^ ((row >> 1) & 7); vo[i] = (unsigned)(row * a.ldvt + c * 8) * 2u; }
    const int x128 = quad ^ r, x64 = quad ^ (r >> 1), y0 = (quad >> 1) ^ (r >> 1);
    const int krd128 = r * 256, krd64 = r * 128, vrd = r * 128 + (quad & 1) * 8;

    bf16x8 qf[NQB][NKK];
#pragma unroll
    for (int qb = 0; qb < NQB; ++qb) {
        const int t = wr0 + qb * 16 + r;
        const bf16_t* qp = a.q + (size_t)(a.qrow_base + t) * a.ldq + a.qoff;
#pragma unroll
        for (int kk = 0; kk < (MODE == 3 ? 4 : NKK); ++kk) qf[qb][kk] = *(const bf16x8*)(qp + kk * 32 + quad * 8);
        if (MODE == 3) {
            const bf16x8 c1 = *(const bf16x8*)(qp + 128 + quad * 8), c2 = *(const bf16x8*)(qp + 160 + quad * 8);
            const float pos = (float)a.pos[t];
            bf16x8 o1, o2;
#pragma unroll
            for (int e = 0; e < 8; e += 2) {
                float s0, c0, s1, cc1; sincos_big(pos * rope_inv_freq(quad * 8 + e), s0, c0); sincos_big(pos * rope_inv_freq(quad * 8 + e + 1), s1, cc1);
                const float x10 = __uint_as_float((unsigned)(unsigned short)c1[e] << 16), x20 = __uint_as_float((unsigned)(unsigned short)c2[e] << 16);
                const float x11 = __uint_as_float((unsigned)(unsigned short)c1[e + 1] << 16), x21 = __uint_as_float((unsigned)(unsigned short)c2[e + 1] << 16);
                const unsigned wa = cvt_pk_bf16(x10 * c0 - x20 * s0, x11 * cc1 - x21 * s1), wb = cvt_pk_bf16(x20 * c0 + x10 * s0, x21 * cc1 + x11 * s1);
                o1[e] = (short)(wa & 0xffffu); o1[e + 1] = (short)(wa >> 16); o2[e] = (short)(wb & 0xffffu); o2[e + 1] = (short)(wb >> 16);
            }
            qf[qb][NKK - 2] = o1; qf[qb][NKK - 1] = o2;
        }
    }
    f32x4 oacc[NNB][NQB];
#pragma unroll
    for (int nb = 0; nb < NNB; ++nb)
#pragma unroll
        for (int qb = 0; qb < NQB; ++qb) oacc[nb][qb] = (f32x4){0.f, 0.f, 0.f, 0.f};
    float mrun[NQB], lsum[NQB], carry[NQB], ct[NQB];
#pragma unroll
    for (int qb = 0; qb < NQB; ++qb) {
        mrun[qb] = (MODE == 2) ? a.sink * LOG2E : -INFINITY; lsum[qb] = (MODE == 2 && quad == 0) ? 1.f : 0.f; carry[qb] = 1.f;
        ct[qb] = (MODE == 1) ? a.lfc[wr0 + qb * 16 + r] * LOG2E : 0.f;
    }
    if (MODE == 2) { if (tid < 128) ((LAS float*)(lds + TBL_OFF))[tid] = a.biasrow[tid] * LOG2E; }
    const float scale2 = (MODE == 0) ? -a.scale * LOG2E : a.scale * LOG2E;

    const char* kbase = (const char*)(a.k + (size_t)a.krow_base * a.ldk + a.koff);
    const char* k2base = (MODE == 3) ? (const char*)(a.k2 + (size_t)a.krow_base * 64) : kbase;
    const char* vbase = (const char*)(a.vt + (size_t)a.vrow0 * a.ldvt + a.vcol_base);
#define ATT_DMA(kt_, buf_) do { LAS unsigned char* bp = lds + (buf_) * BUF_BYTES + wave * 1024; \
        const char* kg = kbase + (size_t)(kt_) * 64 * a.ldk * 2; \
        _Pragma("unroll") for (int i = 0; i < NP128; ++i) __builtin_amdgcn_global_load_lds((const unsigned*)(kg + ko128[i]), (LAS unsigned*)(bp + i * 8192), 16, 0, 0); \
        if (K64_BYTES) { const char* k2g = (MODE == 3) ? k2base + (size_t)(kt_) * 64 * 64 * 2 : kg; \
            __builtin_amdgcn_global_load_lds((const unsigned*)(k2g + ko64), (LAS unsigned*)(bp + K128_BYTES), 16, 0, 0); } \
        const char* vg = vbase + (size_t)(kt_) * 64 * 2; \
        _Pragma("unroll") for (int i = 0; i < NPV; ++i) __builtin_amdgcn_global_load_lds((const unsigned*)(vg + vo[i]), (LAS unsigned*)(bp + KT_BYTES + i * 8192), 16, 0, 0); \
    } while (0)
#define ATT_WAIT_TILE(more_) do { if (more_) { if (NDMA == 2) asm volatile("s_waitcnt vmcnt(2) lgkmcnt(0)" ::: "memory"); else if (NDMA == 4) asm volatile("s_waitcnt vmcnt(4) lgkmcnt(0)" ::: "memory"); \
            else asm volatile("s_waitcnt vmcnt(5) lgkmcnt(0)" ::: "memory"); } else asm volatile("s_waitcnt vmcnt(0) lgkmcnt(0)" ::: "memory"); \
        __builtin_amdgcn_s_barrier(); asm volatile("" ::: "memory"); } while (0)

    const int n_tiles = kt_hi - kt_lo + 1;
    if (MODE == 1) { const int n4 = (a.q0 + QR) >> 2; for (int i = tid; i < n4; i += NTHR) *(LAS f32x4*)(lds + TBL_OFF + i * 16) = *(const f32x4*)(a.lfc + i * 4) * LOG2E; }
    asm volatile("s_waitcnt vmcnt(0)" ::: "memory");
    ATT_DMA(kt_hi, 0);
    if (n_tiles > 1) ATT_DMA(kt_hi - 1, 1);
    ATT_WAIT_TILE(n_tiles > 1);
    int cur = 0;
    for (int it = 0; it < n_tiles; ++it) {
        const int kt = kt_hi - it;
        if (it + 2 < n_tiles) { const int b2 = cur + 2 >= NBUF ? cur + 2 - NBUF : cur + 2; ATT_DMA(kt - 2, b2); }
        if (kt >= wkt_lo && kt <= wkt_hi) {
            LAS unsigned char* kbuf = lds + cur * BUF_BYTES; LAS unsigned char* vbuf = kbuf + KT_BYTES;
            f32x4 st[4][NQB];
#pragma unroll
            for (int kb = 0; kb < 4; ++kb)
#pragma unroll
                for (int qb = 0; qb < NQB; ++qb) st[kb][qb] = (f32x4){0.f, 0.f, 0.f, 0.f};
#pragma unroll
            for (int kb = 0; kb < 4; ++kb) {
#pragma unroll
                for (int kk = 0; kk < NKK; ++kk) {
                    bf16x8 af;
                    if (MODE == 2) af = *(const LAS bf16x8*)(kbuf + kb * 2048 + krd64 + ((x64 ^ (kk * 4)) * 16));
                    else if (MODE == 3 && kk >= 4) af = *(const LAS bf16x8*)(kbuf + K128_BYTES + kb * 2048 + krd64 + ((x64 ^ ((kk - 4) * 4)) * 16));
                    else af = *(const LAS bf16x8*)(kbuf + kb * 4096 + krd128 + ((x128 ^ (kk * 4)) * 16));
#pragma unroll
                    for (int qb = 0; qb < NQB; ++qb) st[kb][qb] = __builtin_amdgcn_mfma_f32_16x16x32_bf16(af, qf[qb][kk], st[kb][qb], 0, 0, 0);
                }
            }
            const bool need_mask = (MODE == 2) ? true : (MODE == 4) ? false : (kt * 64 + 63 >= wr0);
            if (need_mask) att_scores<MODE, NQB, NNB, true>(st, oacc, mrun, lsum, carry, ct, wr0, r, quad, kt, scale2, lds + TBL_OFF);
            else att_scores<MODE, NQB, NNB, false>(st, oacc, mrun, lsum, carry, ct, wr0, r, quad, kt, scale2, lds + TBL_OFF);
#pragma unroll
            for (int k2 = 0; k2 < 2; ++k2) {
                bf16x8 pf[NQB];
#pragma unroll
                for (int qb = 0; qb < NQB; ++qb) {
                    u32x4 w; w.x = cvt_pk_bf16(st[2 * k2][qb][0], st[2 * k2][qb][1]); w.y = cvt_pk_bf16(st[2 * k2][qb][2], st[2 * k2][qb][3]);
                    w.z = cvt_pk_bf16(st[2 * k2 + 1][qb][0], st[2 * k2 + 1][qb][1]); w.w = cvt_pk_bf16(st[2 * k2 + 1][qb][2], st[2 * k2 + 1][qb][3]);
                    pf[qb] = __builtin_bit_cast(bf16x8, w);
                }
                const int vlo = vrd + ((y0 ^ (k2 * 4)) * 16), vhi = vrd + (((y0 ^ 2) ^ (k2 * 4)) * 16);
#pragma unroll
                for (int nb = 0; nb < NNB; ++nb) {
                    const u32x2 lo = *(const LAS u32x2*)(vbuf + nb * 2048 + vlo), hi = *(const LAS u32x2*)(vbuf + nb * 2048 + vhi);
                    const bf16x8 vf = __builtin_bit_cast(bf16x8, (u32x4){lo.x, lo.y, hi.x, hi.y});
#pragma unroll
                    for (int qb = 0; qb < NQB; ++qb) oacc[nb][qb] = __builtin_amdgcn_mfma_f32_16x16x32_bf16(vf, pf[qb], oacc[nb][qb], 0, 0, 0);
                }
            }
        }
        ATT_WAIT_TILE(it + 2 < n_tiles);
        cur = cur + 1 == NBUF ? 0 : cur + 1;
    }
#undef ATT_DMA
#undef ATT_WAIT_TILE
#pragma unroll
    for (int qb = 0; qb < NQB; ++qb) {
        float inv = 1.f;
        if (MODE != 0) { float l = lsum[qb]; l += __shfl_xor(l, 16); l += __shfl_xor(l, 32); inv = 1.f / l; }
        const int t = wr0 + qb * 16 + r;
        bf16_t* op = a.o + (size_t)(a.qrow_base + t) * ATTW + a.ocol + quad * 4;
#pragma unroll
        for (int nb = 0; nb < NNB; ++nb) { const f32x4 v = oacc[nb][qb] * inv; u32x2 w; w.x = cvt_pk_bf16(v[0], v[1]); w.y = cvt_pk_bf16(v[2], v[3]); *(u32x2*)(op + nb * 16) = w; }
    }
}

__device__ __forceinline__ void mem_attn_item(const Params& p, LAS unsigned char* lds, int layer, int idx, const bf16_t* q, int ldq, int qoff) {
    constexpr int NQBLK = SEQ / (128 * NQB_MEM);
    const int qblk = idx % NQBLK, mh = (idx / NQBLK) & 3, b = idx / (4 * NQBLK);
    AttnArgs a;
    a.q = q; a.ldq = ldq; a.qoff = qoff + mh * 128;
    a.k = (const bf16_t*)(p.ws + OFF_MEMK); a.ldk = 2048; a.koff = layer * 512 + mh * 128; a.k2 = nullptr;
    a.vt = (const bf16_t*)(p.ws + OFF_MEMVT); a.ldvt = 2048; a.vrow0 = layer * 512 + mh * 128; a.vcol_base = layer * 512 + b * 256;
    a.qrow_base = b * SEQ; a.krow_base = layer * 512 + b * 256;
    a.o = (bf16_t*)(p.ws + OFF_ATT); a.ocol = 2048 + mh * 128; a.q0 = qblk * 128 * NQB_MEM;
    a.lfc = nullptr; a.biasrow = nullptr; a.sink = 0.f; a.pos = nullptr; a.scale = 0.08838834764831845f;
    attn_item<4, NQB_MEM>(lds, a);
}

__device__ void phase_attn(const Params& p, LAS unsigned char* lds, int layer) {
    const bf16_t* proj = (const bf16_t*)(p.ws + OFF_PROJ);
    if (layer == 2) {
        constexpr int NQBLK = SEQ / (128 * NQB_SWA);
        for (int idx = blockIdx.x; idx < 64 * NQBLK; idx += gridDim.x) {
            const int qblk = idx % NQBLK, head = (idx / NQBLK) & 31, b = idx / (32 * NQBLK), kvh = head >> 3;
            AttnArgs a;
            a.q = proj; a.ldq = 2816; a.qoff = head * 64;
            a.k = proj; a.ldk = 2816; a.koff = 2048 + kvh * 64; a.k2 = nullptr;
            a.vt = (const bf16_t*)(p.ws + OFF_VT); a.ldvt = T; a.vrow0 = kvh * 64; a.vcol_base = b * SEQ;
            a.qrow_base = b * SEQ; a.krow_base = b * SEQ;
            a.o = (bf16_t*)(p.ws + OFF_ATT); a.ocol = head * 64; a.q0 = qblk * 128 * NQB_SWA;
            a.lfc = nullptr; a.biasrow = (const float*)(p.ws + OFF_BIAST) + head * 128; a.sink = p.in[I_SWA_SINKS][head]; a.pos = nullptr; a.scale = 0.125f;
            attn_item<2, NQB_SWA>(lds, a);
        }
    } else {
        const int nqb = layer == 0 ? NQB_SB : layer == 1 ? NQB_FOX : NQB_MLA, NQBLK = SEQ / (128 * nqb);
        for (int ps = blockIdx.x; ps < 32 * (NQBLK / 2); ps += gridDim.x) {
            const int xcd = ps & 7, j = ps >> 3, combo = xcd * 4 + (j & 3), pair = j >> 2, b = combo >> 4, head = combo & 15;
            for (int s = 0; s < 2; ++s) {
                const int qblk = s == 0 ? NQBLK - 1 - pair : pair;
                AttnArgs a;
                a.vt = (const bf16_t*)(p.ws + OFF_VT); a.ldvt = T; a.vrow0 = head * 128; a.vcol_base = b * SEQ;
                a.qrow_base = b * SEQ; a.krow_base = b * SEQ;
                a.o = (bf16_t*)(p.ws + OFF_ATT); a.ocol = head * 128; a.q0 = qblk * 128 * nqb;
                a.lfc = nullptr; a.biasrow = nullptr; a.sink = 0.f; a.pos = nullptr; a.k2 = nullptr;
                if (layer == 3) {
                    a.q = (const bf16_t*)(p.ws + OFF_Q3); a.ldq = 3072; a.qoff = head * 192;
                    a.k = (const bf16_t*)(p.ws + OFF_KN); a.ldk = 2048; a.koff = head * 128; a.k2 = (const bf16_t*)(p.ws + OFF_KPE);
                    a.pos = (const int*)p.in[I_POS] + b * SEQ; a.scale = 0.07216878364870322f;
                    attn_item<3, NQB_MLA>(lds, a);
                } else {
                    a.q = proj; a.ldq = 4608; a.qoff = head * 128;
                    a.k = proj; a.ldk = 4608; a.koff = 2048 + head * 128; a.scale = 0.08838834764831845f;
                    if (layer == 1) { a.lfc = (const float*)(p.ws + OFF_LFC) + (size_t)(b * 16 + head) * 4096; attn_item<1, NQB_FOX>(lds, a); }
                    else attn_item<0, NQB_SB>(lds, a);
                }
            }
        }
    }
    for (int idx = blockIdx.x; idx < 8 * (SEQ / (128 * NQB_MEM)); idx += gridDim.x) {
        if (layer == 2) mem_attn_item(p, lds, layer, idx, proj, 2816, 2304);
        else if (layer == 3) mem_attn_item(p, lds, layer, idx, proj, 1536, 832);
        else mem_attn_item(p, lds, layer, idx, proj, 4608, 4096);
    }
}

enum { K_GIN = 0, K_ATT, K_GOUT, K_NORMF, K_GUP, K_CONVG, K_GDOWN, K_NORMA, K_MID, K_G2, K_FINAL, K_CONV, K_NORM0 };

__device__ __forceinline__ bool get_gemm(const Params& p, int kind, int layer, int gi, GemmDesc& d) {
    unsigned char* ws = p.ws;
    d.kind = 0; d.O = nullptr; d.X = nullptr; d.diag = 0; d.smode = 0;
    const bf16_t* h = (const bf16_t*)(ws + OFF_H);
    if (kind == K_GIN && layer == 0 && gi >= 2) {
        gi -= 2;
        if (gi == 0) { d.A = (const bf16_t*)(ws + OFF_MEMH); d.Bt = (const bf16_t*)(ws + W_MEMK); d.M = 2048; d.N = 2048; d.K = 2048; d.O = (bf16_t*)(ws + OFF_MEMK); d.ldc = 2048; d.diag = 1; return true; }
        if (gi == 1) { d.A = (const bf16_t*)(ws + W_MEMV); d.Bt = (const bf16_t*)(ws + OFF_MEMH); d.M = 2048; d.N = 2048; d.K = 2048; d.O = (bf16_t*)(ws + OFF_MEMVT); d.ldc = 2048; d.diag = 1; return true; }
        return false;
    }
    if (kind == K_GIN) {
        const size_t w1 = layer == 0 ? W_SB_IN1 : layer == 1 ? W_FOX_IN1 : layer == 2 ? W_SWA_IN1 : W_MLA_IN;
        const size_t wv = layer == 0 ? W_SB_V : layer == 1 ? W_FOX_V : W_SWA_V;
        const int n1 = layer < 2 ? 4608 : layer == 2 ? 2816 : 1536; const int mv = layer < 2 ? 2048 : layer == 2 ? 256 : 0;
        if (gi == 0) { d.A = h; d.Bt = (const bf16_t*)(ws + w1); d.M = T; d.N = n1; d.K = 2048; d.O = (bf16_t*)(ws + OFF_PROJ); d.ldc = n1; d.smode = 1; return true; }
        if (gi == 1 && mv) { d.A = (const bf16_t*)(ws + wv); d.Bt = h; d.M = mv; d.N = T; d.K = 2048; d.O = (bf16_t*)(ws + OFF_VT); d.ldc = T; d.smode = 2; return true; }
        return false;
    }
    if (kind == K_G2) {
        if (gi == 0) { d.A = (const bf16_t*)(ws + OFF_CQN); d.Bt = (const bf16_t*)(ws + W_MLA_UQ); d.M = T; d.N = 3072; d.K = 512; d.O = (bf16_t*)(ws + OFF_Q3); d.ldc = 3072; return true; }
        if (gi == 1) { d.A = (const bf16_t*)(ws + OFF_CKVN); d.Bt = (const bf16_t*)(ws + W_MLA_KN); d.M = T; d.N = 2048; d.K = 256; d.O = (bf16_t*)(ws + OFF_KN); d.ldc = 2048; return true; }
        if (gi == 2) { d.A = (const bf16_t*)(ws + W_MLA_V); d.Bt = (const bf16_t*)(ws + OFF_CKVN); d.M = 2048; d.N = T; d.K = 256; d.O = (bf16_t*)(ws + OFF_VT); d.ldc = T; return true; }
        return false;
    }
    if (kind == K_GOUT) {
        if (gi) return false;
        const size_t wo = layer == 0 ? W_SB_OUT : layer == 1 ? W_FOX_OUT : layer == 2 ? W_SWA_OUT : W_MLA_OUT;
        d.A = (const bf16_t*)(ws + OFF_ATT); d.Bt = (const bf16_t*)(ws + wo); d.M = T; d.N = 2048; d.K = 2560; d.kind = 1; d.X = (float*)(ws + OFF_XR); d.ldc = 2048; return true;
    }
    if (kind == K_GUP) {
        if (gi) return false;
        d.A = h; d.Bt = (const bf16_t*)(ws + W_UP) + (size_t)layer * 11264 * 2048; d.M = T; d.N = 11264; d.K = 2048; d.kind = 2; d.ldc = 11264; d.smode = 1; return true;
    }
    if (kind == K_GDOWN) {
        if (gi) return false;
        d.A = (const bf16_t*)(ws + OFF_G); d.Bt = (const bf16_t*)(ws + W_DOWN) + (size_t)layer * 2048 * 5632; d.M = T; d.N = 2048; d.K = 5632; d.kind = 1; d.X = (float*)(ws + OFF_XR); d.ldc = 2048; return true;
    }
    return false;
}

constexpr int N_PHASES = 1 + 6 + 5 + 5 + 8;
__device__ __forceinline__ void decode_phase(int ph, int& kind, int& layer) {
    if (ph == 0) { kind = K_CONV; layer = 0; return; }
    const int q = ph - 1;
    if (q < 16) {
        int k;
        if (q < 6) { layer = 0; k = q; } else if (q < 11) { layer = 1; k = q - 6; } else { layer = 2; k = q - 11; }
        kind = k == 0 ? K_GIN : k == 1 ? K_ATT : k == 2 ? K_GOUT : k == 3 ? K_GUP : k == 4 ? K_GDOWN : K_NORMA;
        return;
    }
    layer = 3; const int k = q - 16;
    kind = k == 0 ? K_GIN : k == 1 ? K_MID : k == 2 ? K_G2 : k == 3 ? K_ATT : k == 4 ? K_GOUT : k == 5 ? K_GUP : k == 6 ? K_GDOWN : K_FINAL;
}

__global__ void __launch_bounds__(NTHR, 2) fwd_megakernel(Params p) {
    extern __shared__ __attribute__((aligned(16))) unsigned char shm[];
    LAS unsigned char* lds = (LAS unsigned char*)shm;
    volatile LAS unsigned* xst = (volatile LAS unsigned*)(lds + LDS_BYTES - 16);
    if (threadIdx.x == 0) { xst[0] = 0u; xst[1] = 0u; xst[2] = 0u; xst[3] = 0u; }
    __syncthreads();
    const XcdBarrier xb = xcd_barrier_post((unsigned*)(p.ws + OFF_BAR), xst);
    for (int ph = p.ph_lo; ph < p.ph_hi; ++ph) {
        if (ph != p.ph_lo) { if (ph == p.ph_lo + 1) cg::this_grid().sync(); else xcd_barrier(xb); }
        int kind, layer; decode_phase(ph, kind, layer);
        if (kind == K_CONV) { phase_conv(p, lds); phase_norm(p, p.in[I_X], p.in[I_ATTN_NORM], 1); }
        else if (kind == K_NORMA) phase_norm(p, (const float*)(p.ws + OFF_XR), p.in[I_ATTN_NORM] + 1 * 2048, 2);
        else if (kind == K_FINAL) phase_norm(p, (const float*)(p.ws + OFF_XR), p.in[I_FINAL_NORM], 3);
        else if (kind == K_MID) phase_mla_mid(p);
        else if (kind == K_ATT) { for (int rep = 0; rep < PROBE_ATT_REPS; ++rep) { if (rep) xcd_barrier(xb); phase_attn(p, lds, layer); } }
        else if (kind == K_GIN && layer == 1) fox_scan(p, lds);
        if (kind == K_GIN || kind == K_G2 || kind == K_GOUT || kind == K_GUP || kind == K_GDOWN) {
            if (kind == K_GDOWN) {
                pg8::Order S0; S0.init(T, 2048, (int)gridDim.x, (int)blockIdx.x, 0); pg8::Unit u0;
                for (int i = 0; S0.next(i, u0); ++i) ffn_fixup(p, layer, u0.pm);
                asm volatile("s_waitcnt vmcnt(0)" ::: "memory");
            }
            const int greps = (kind == K_GIN || kind == K_G2 || kind == K_GUP) ? PROBE_GEMM_REPS : 1;
            for (int grep_ = 0; grep_ < greps; ++grep_) {
            if (grep_) xcd_barrier(xb);
            __syncthreads();
            int shift = 0;
            for (int gi = 0; gi < 4; ++gi) {
                GemmDesc d, d2; d2.M = 0; d2.N = 0; d2.A = nullptr; d2.Bt = nullptr; d2.O = nullptr; d2.ldc = 0; d2.smode = 0;
                if (!get_gemm(p, kind, layer, gi, d)) break;
                const bool merged = (kind == K_GIN && gi == 0) ? get_gemm(p, kind, layer, 1, d2) : false;
                pg8::Order S; const int G = (int)gridDim.x;
                S.init(d.M, d.N, G, (int)((blockIdx.x + G - shift) % G), d.diag, merged ? d2.M : 0, merged ? d2.N : 0);
                pg8::Epi E; E.kind = d.kind; E.smode = d.smode; E.O = d.O; E.X = d.X; E.XB = (bf16_t*)(p.ws + OFF_H); E.ssq = (float*)(p.ws + OFF_SSQ); E.ldc = d.ldc; E.lds = lds;
                E.cw = p.in[I_CONVW] + (size_t)layer * 3 * 11264; E.cb = p.in[I_CONVB] + (size_t)layer * 11264; E.G = (bf16_t*)(p.ws + OFF_G); E.US = (bf16_t*)(p.ws + OFF_U);
                pg8::Gemm g; g.A = d.A; g.Bt = d.Bt; g.M = d.M; g.N = d.N; g.K = d.K; g.A2 = d2.A; g.Bt2 = d2.Bt;
                E.O2 = d2.O; E.ldc2 = d2.ldc; E.smode2 = d2.smode;
                if (d.kind == 0) pg8::gemm_phase<0>(lds, g, S, E); else if (d.kind == 1) pg8::gemm_phase<1>(lds, g, S, E); else pg8::gemm_phase<2>(lds, g, S, E);
                const int nu = (d.diag ? 16 : (d.M / 256) * (d.N / 256)) + (merged ? (d2.M / 256) * (d2.N / 256) : 0);
                shift = ((shift + nu) % G) & ~7;
                if (merged) ++gi;
            }
            }
        }
    }
}

extern "C" void kernel_launch(void* const* d_in, const int* in_sizes, int n_in, void* d_out, int out_size, void* d_ws, size_t ws_size, hipStream_t stream) {
    static int grid = 0;
    if (grid == 0) {
        if (n_in != N_IN || ws_size < WS_END) { fprintf(stderr, "kernel_launch: unexpected n_in %d or ws_size %zu (< %zu)\n", n_in, ws_size, (size_t)WS_END); grid = -1; return; }
        int dev = 0, cus = 0, per_cu = 0;
        hipGetDevice(&dev); hipDeviceGetAttribute(&cus, hipDeviceAttributeMultiprocessorCount, dev);
        if (hipFuncSetAttribute((const void*)fwd_megakernel, hipFuncAttributeMaxDynamicSharedMemorySize, LDS_BYTES) != hipSuccess) { fprintf(stderr, "kernel_launch: hipFuncSetAttribute failed\n"); grid = -1; return; }
        if (hipOccupancyMaxActiveBlocksPerMultiprocessor(&per_cu, (const void*)fwd_megakernel, NTHR, LDS_BYTES) != hipSuccess || per_cu < 1) { fprintf(stderr, "kernel_launch: occupancy query says %d\n", per_cu); per_cu = 1; }
        (void)hipGetLastError();
        grid = cus;
        fprintf(stderr, "kernel_launch: grid %d (cus %d, per_cu %d)\n", grid, cus, per_cu);
    }
    if (grid < 0) return;
    if (hipMemsetAsync((char*)d_ws + OFF_BAR, 0, BAR_BYTES, stream) != hipSuccess) { fprintf(stderr, "kernel_launch: memset of barrier words failed\n"); return; }
    Params p{};
    for (int i = 0; i < N_IN; ++i) p.in[i] = (const float*)d_in[i];
    p.out = (float*)d_out; p.ws = (unsigned char*)d_ws;
#if N_LAUNCH_MODE == 1
    p.ph_lo = 0; p.ph_hi = N_PHASES;
    void* args[] = {&p};
    hipError_t e = hipLaunchCooperativeKernel((const void*)fwd_megakernel, dim3(grid), dim3(NTHR), args, LDS_BYTES, stream);
    if (e != hipSuccess) fprintf(stderr, "cooperative launch failed: %s (grid %d)\n", hipGetErrorString(e), grid);
#else
    for (int ph = 0; ph < N_PHASES; ++ph) {
        p.ph_lo = ph; p.ph_hi = ph + 1;
        hipLaunchKernelGGL(fwd_megakernel, dim3(grid), dim3(NTHR), LDS_BYTES, stream, p);
    }
#endif
}
```

```cpp
#include <hip/hip_runtime.h>
#include <hip/hip_cooperative_groups.h>
#include <cstdio>
#include <cstdint>
namespace cg = cooperative_groups;

#ifndef N_LAUNCH_MODE
#define N_LAUNCH_MODE 1
#endif

#ifndef RESCALE_ALWAYS
#define RESCALE_ALWAYS 1
#endif
#ifndef PROBE_GEMM_REPS
#define PROBE_GEMM_REPS 1
#endif
#ifndef PROBE_SYNC_EXTRA
#define PROBE_SYNC_EXTRA 0
#endif
#ifndef PROBE_ATT_REPS
#define PROBE_ATT_REPS 1
#endif
#define LAS __attribute__((address_space(3)))
typedef unsigned short bf16_t;
typedef short bf16x8 __attribute__((ext_vector_type(8)));
typedef float f32x4 __attribute__((ext_vector_type(4)));
typedef float f32x2 __attribute__((ext_vector_type(2)));
typedef unsigned u32x4 __attribute__((ext_vector_type(4)));
typedef unsigned u32x2 __attribute__((ext_vector_type(2)));

constexpr int T = 8192, D = 2048, SEQ = 4096, DFF = 5632, ATTW = 2560;
constexpr float LOG2E = 1.4426950408889634f;
constexpr int NTHR = 512, NWAVE = 8;
constexpr int LDS_BYTES = 140288;

constexpr size_t OFF_XR = 0;
constexpr size_t OFF_H = OFF_XR + (size_t)T * D * 4;
constexpr size_t OFF_PROJ = OFF_H + (size_t)T * D * 2;
constexpr size_t OFF_VT = OFF_PROJ + (size_t)T * 4608 * 2;
constexpr size_t OFF_ATT = OFF_VT + (size_t)2048 * T * 2;
constexpr size_t OFF_U = OFF_ATT + (size_t)T * ATTW * 2;
constexpr size_t OFF_G = OFF_U + (size_t)T * 11264 * 2;
constexpr size_t OFF_MEMH = OFF_G + (size_t)T * DFF * 2;
constexpr size_t OFF_MEMK = OFF_MEMH + (size_t)2048 * 2048 * 2;
constexpr size_t OFF_MEMVT = OFF_MEMK + (size_t)2048 * 2048 * 2;
constexpr size_t OFF_LF = OFF_MEMVT + (size_t)2048 * 2048 * 2;
constexpr size_t OFF_LFC = OFF_LF + (size_t)T * 16 * 4;
constexpr size_t OFF_BIAST = OFF_LFC + (size_t)32 * 4096 * 4;
constexpr size_t OFF_WF = OFF_BIAST + (size_t)32 * 128 * 4;
constexpr size_t OFF_CQN = OFF_WF + (size_t)16 * 2048 * 4;
constexpr size_t OFF_CKVN = OFF_CQN + (size_t)T * 512 * 2;
constexpr size_t OFF_KPE = OFF_CKVN + (size_t)T * 256 * 2;
constexpr size_t OFF_Q3 = OFF_KPE + (size_t)T * 64 * 2;
constexpr size_t OFF_KN = OFF_Q3 + (size_t)T * 3072 * 2;
constexpr size_t OFF_W = OFF_KN + (size_t)T * 2048 * 2;
constexpr size_t W_SB_IN1 = OFF_W;
constexpr size_t W_SB_V = W_SB_IN1 + (size_t)4608 * 2048 * 2;
constexpr size_t W_SB_OUT = W_SB_V + (size_t)2048 * 2048 * 2;
constexpr size_t W_FOX_IN1 = W_SB_OUT + (size_t)2048 * 2560 * 2;
constexpr size_t W_FOX_V = W_FOX_IN1 + (size_t)4608 * 2048 * 2;
constexpr size_t W_FOX_OUT = W_FOX_V + (size_t)2048 * 2048 * 2;
constexpr size_t W_SWA_IN1 = W_FOX_OUT + (size_t)2048 * 2560 * 2;
constexpr size_t W_SWA_V = W_SWA_IN1 + (size_t)2816 * 2048 * 2;
constexpr size_t W_SWA_OUT = W_SWA_V + (size_t)256 * 2048 * 2;
constexpr size_t W_MLA_IN = W_SWA_OUT + (size_t)2048 * 2560 * 2;
constexpr size_t W_MLA_UQ = W_MLA_IN + (size_t)1536 * 2048 * 2;
constexpr size_t W_MLA_KN = W_MLA_UQ + (size_t)3072 * 512 * 2;
constexpr size_t W_MLA_V = W_MLA_KN + (size_t)2048 * 256 * 2;
constexpr size_t W_MLA_OUT = W_MLA_V + (size_t)2048 * 256 * 2;
constexpr size_t W_MEMK = W_MLA_OUT + (size_t)2048 * 2560 * 2;
constexpr size_t W_MEMV = W_MEMK + (size_t)2048 * 2048 * 2;
constexpr size_t W_UP = W_MEMV + (size_t)2048 * 2048 * 2;
constexpr size_t W_DOWN = W_UP + (size_t)4 * 11264 * 2048 * 2;
constexpr size_t OFF_BAR = W_DOWN + (size_t)4 * 2048 * 5632 * 2;
constexpr size_t BAR_BYTES = 16384;
constexpr size_t OFF_SSQ = OFF_BAR + BAR_BYTES;
constexpr size_t WS_END = OFF_SSQ + (size_t)T * 32 * 4;

enum { I_X = 0, I_MEM, I_POS, I_RELB, I_ATTN_NORM, I_MEM_NORM, I_WMEMKV, I_FFN_NORM, I_WUP, I_CONVW, I_CONVB, I_WDOWN, I_FINAL_NORM,
       I_SB_IN, I_SB_OUT, I_FOX_IN, I_FOX_BF, I_FOX_OUT, I_SWA_IN, I_SWA_SINKS, I_SWA_OUT, I_MLA_IN, I_MLA_QN, I_MLA_UQ, I_MLA_KVN, I_MLA_UKV, I_MLA_OUT, N_IN };

struct Params {
    const float* in[N_IN];
    float* out;
    unsigned char* ws;
    int ph_lo, ph_hi;
};

__device__ __forceinline__ unsigned cvt_pk_bf16(float lo, float hi) { unsigned r; asm volatile("v_cvt_pk_bf16_f32 %0, %1, %2" : "=v"(r) : "v"(lo), "v"(hi)); return r; }
__device__ __forceinline__ int otid() { int t = threadIdx.x; asm volatile("" : "+v"(t)); return t; }
__device__ __forceinline__ float bf_lo(unsigned u) { return __uint_as_float(u << 16); }
__device__ __forceinline__ float bf_hi(unsigned u) { return __uint_as_float(u & 0xffff0000u); }
__device__ __forceinline__ float wave_sum(float v) {
#pragma unroll
    for (int o = 1; o < 64; o <<= 1) v += __shfl_xor(v, o);
    return v;
}
__device__ __forceinline__ float fast_exp2(float x) { return __builtin_amdgcn_exp2f(x); }
__device__ __forceinline__ void sincos_big(float ang, float& s, float& c) {
    const double a = (double)ang; const double n = rint(a * 0.15915494309189535); const float rf = (float)(a - n * 6.283185307179586);
    s = __sinf(rf); c = __cosf(rf);
}
__device__ __forceinline__ float rope_inv_freq(int i) { return exp2f(-(float)i * 0.41524101186092029f); }


#define XB_TMO      128
#define XB_XCNT(j)  (256  + 64 * (j))
#define XB_XSUB(j)  (1280 + 64 * (j))
#define XB_XGEN(j)  (2304 + 64 * (j))
#define XB_TOP      3328
#define XB_TOPGEN   3392
#define XCD_BAR_WORDS 3456
#define XB_SPIN_CAP (1u << 18)
__device__ __forceinline__ unsigned xb_ld(unsigned* p)              { return __hip_atomic_load(p, __ATOMIC_RELAXED, __HIP_MEMORY_SCOPE_AGENT); }
__device__ __forceinline__ unsigned xb_add(unsigned* p, unsigned v) { return __hip_atomic_fetch_add(p, v, __ATOMIC_RELAXED, __HIP_MEMORY_SCOPE_AGENT); }
__device__ __forceinline__ unsigned xb_xcc_id() { return (unsigned)__builtin_amdgcn_s_getreg((3 << 11) | 20) & 0xFu; }
#define XB_SPIN(cond, bar) do { unsigned _sp = 0; while (cond) { __builtin_amdgcn_s_sleep(1); \
    if ((++_sp & 255u) == 0u) { if (xb_ld(&(bar)[XB_TMO])) break; if (_sp > XB_SPIN_CAP) { atomicAdd(&(bar)[XB_TMO], 1u); break; } } } } while (0)
struct XcdBarrier { unsigned* bar; unsigned x; volatile LAS unsigned* st; };
__device__ __forceinline__ XcdBarrier xcd_barrier_post(unsigned* bar, volatile LAS unsigned* st) {
    XcdBarrier b; b.bar = bar; b.x = xb_xcc_id(); b.st = st;
    if (threadIdx.x == 0) (void)xb_add(&bar[XB_XCNT(b.x)], 1u);
    return b;
}
__device__ __forceinline__ void xcd_barrier_complete(unsigned* bar, unsigned x, unsigned& nloc, unsigned& nx) {
    const unsigned G = gridDim.x * gridDim.y * gridDim.z;
    unsigned sum, cnt, mine, sp = 0u;
    for (;;) {
        sum = 0u; cnt = 0u; mine = 0u;
#pragma unroll
        for (unsigned j = 0; j < 16; ++j) { const unsigned c = xb_ld(&bar[XB_XCNT(j)]); sum += c; cnt += (c > 0u) ? 1u : 0u; mine = (j == x) ? c : mine; }
        if (sum == G) break;
        __builtin_amdgcn_s_sleep(1);
        if ((++sp & 255u) == 0u) { if (xb_ld(&bar[XB_TMO])) break; if (sp > XB_SPIN_CAP) { atomicAdd(&bar[XB_TMO], 1u); break; } }
    }
    nloc = mine > 0u ? mine : 1u; nx = cnt > 0u ? cnt : 1u;
}
__device__ __forceinline__ void xcd_barrier(const XcdBarrier& b) {
    asm volatile("s_waitcnt vmcnt(0)" ::: "memory");
    __syncthreads();
    if (threadIdx.x == 0) {
        unsigned* bar = b.bar;
        __builtin_amdgcn_s_waitcnt(0);
        unsigned nloc = b.st[0], nx = b.st[1];
        if (nloc == 0u) { xcd_barrier_complete(bar, b.x, nloc, nx); b.st[0] = nloc; b.st[1] = nx; }
        const unsigned old = xb_add(&bar[XB_XSUB(b.x)], 1u);
        const unsigned gen = old / nloc;
        if (old + 1u == (gen + 1u) * nloc) {
            __builtin_amdgcn_fence(__ATOMIC_RELEASE, "agent");
            asm volatile("s_waitcnt vmcnt(0)" ::: "memory");
            const unsigned og = xb_add(&bar[XB_TOP], 1u);
            const unsigned tg = og / nx;
            if (og + 1u == (tg + 1u) * nx) xb_add(&bar[XB_TOPGEN], 1u);
            else XB_SPIN(xb_ld(&bar[XB_TOPGEN]) == tg, bar);
            __builtin_amdgcn_fence(__ATOMIC_ACQUIRE, "agent");
            xb_add(&bar[XB_XGEN(b.x)], 1u);
            asm volatile("s_waitcnt vmcnt(0)" ::: "memory");
        } else {
            XB_SPIN(xb_ld(&bar[XB_XGEN(b.x)]) == gen, bar);
            __builtin_amdgcn_fence(__ATOMIC_ACQUIRE, "agent");
            asm volatile("s_waitcnt vmcnt(0)" ::: "memory");
        }
    }
    __syncthreads();
}

namespace pg8 {
constexpr int BM = 256, BK = 64, HALF = 128, HTB = HALF * BK * 2, STAGE_BYTES = 8 * HTB, NXCD = 8, WGM = 8;
__device__ __forceinline__ int lds_byte(int r, int c) { const int st = (r >> 4) * 2 + (c >> 5), rr = r & 15, cc = c & 31, ob = rr * 64 + cc * 2; return st * 1024 + (ob ^ (((ob >> 9) & 1) << 5)); }
__device__ __forceinline__ void stage_rc(int b, int& R, int& C) { const int st = b / 1024, sb = b % 1024, swz = sb ^ (((sb >> 9) & 1) << 5); R = (st >> 1) * 16 + swz / 64; C = (st & 1) * 32 + (swz % 64) / 2; }
__device__ __forceinline__ int perm32(int rho) { const int n = rho >> 4, i = rho & 15; return 8 * (i >> 2) + 4 * n + (i & 3); }
struct Unit { int pm, pn, which; };
struct Gemm { const bf16_t* A; const bf16_t* Bt; int M, N, K; const bf16_t* A2; const bf16_t* Bt2; };

struct Order {
    int nM, nN, nwg, G, c, diag, nM2, nN2, nwg2;
    __device__ void init(int M, int N, int G_, int c_, int diag_, int M2 = 0, int N2 = 0) { nM = M / BM; nN = N / BM; nwg = nM * nN; G = G_; c = c_; diag = diag_; nM2 = M2 / BM; nN2 = N2 / BM; nwg2 = nM2 * nN2; }
    static __device__ void tile_map(int wgid, int nM_, int nN_, int nwg_, Unit& u) {
        { const int q = nwg_ / NXCD, r = nwg_ % NXCD, xcd = wgid % NXCD, off = wgid / NXCD; wgid = (xcd < r ? xcd * (q + 1) : r * (q + 1) + (xcd - r) * q) + off; }
        const int nig = WGM * nN_, gid = wgid / nig, fm = gid * WGM, gsz = (nM_ - fm) < WGM ? (nM_ - fm) : WGM;
        u.pm = fm + ((wgid % nig) % gsz); u.pn = (wgid % nig) / gsz;
    }
    __device__ bool next(int i, Unit& u) const {
        u.which = 0;
        if (diag) { const int L = i * G + c; if (L >= 16) return false; const int l = L >> 2; u.pm = 2 * l + (L & 1); u.pn = 2 * l + ((L >> 1) & 1); return true; }
        const long L = (long)i * G + c; if (L >= nwg + nwg2) return false;
        if (L < nwg) tile_map((int)L, nM, nN, nwg, u); else { u.which = 1; tile_map((int)L - nwg, nM2, nN2, nwg2, u); }
        return true;
    }
};

struct Epi {
    int kind, smode; bf16_t* O; float* X; bf16_t* XB; float* ssq; int ldc; LAS unsigned char* lds;
    bf16_t* O2; int ldc2, smode2;
    const float* cw; const float* cb; bf16_t* G; bf16_t* US;
    __device__ __forceinline__ float row_rs(int row, int fq) const {
        const f32x4 a = *(const f32x4*)(ssq + (size_t)row * 32 + fq * 8), b = *(const f32x4*)(ssq + (size_t)row * 32 + fq * 8 + 4);
        float t = ((a[0] + a[1]) + (a[2] + a[3])) + ((b[0] + b[1]) + (b[2] + b[3]));
        t += __shfl_xor(t, 16); t += __shfl_xor(t, 32);
        return rsqrtf(t * (1.f / 2048.f) + 1e-6f);
    }
    static __device__ __forceinline__ unsigned ror1(unsigned x) { return (unsigned)__builtin_amdgcn_update_dpp(0, (int)x, 0x121, 0xf, 0xf, false); }
    static __device__ __forceinline__ unsigned ror2(unsigned x) { return (unsigned)__builtin_amdgcn_update_dpp(0, (int)x, 0x122, 0xf, 0xf, false); }
    __device__ __forceinline__ void ffn_gate(const f32x4 (&acc)[2][2][4][2], const Unit& u, int wr, int wc, int fr, int fq) const {
        unsigned row0 = (unsigned)(u.pm * BM + wr * 64 + fr), ch0 = (unsigned)(u.pn * HALF + wc * 32 + 8 * fq);
        asm volatile("" : "+v"(row0), "+v"(ch0));
        u32x2 pk[2][2][4][2];
#pragma unroll
        for (int h = 0; h < 2; ++h) {
            f32x4 pa[4], pb[4];
#pragma unroll
            for (int i = 0; i < 4; ++i) { const unsigned qo = (row0 + h * HALF + i * 16) * 32u + fq * 8u; pa[i] = *(const f32x4*)(ssq + qo); pb[i] = *(const f32x4*)(ssq + qo + 4u); }
#pragma unroll
            for (int i = 0; i < 4; ++i) { float t = ((pa[i][0] + pa[i][1]) + (pa[i][2] + pa[i][3])) + ((pb[i][0] + pb[i][1]) + (pb[i][2] + pb[i][3]));
                t += __shfl_xor(t, 16); t += __shfl_xor(t, 32); const float rsr = rsqrtf(t * (1.f / 2048.f) + 1e-6f);
#pragma unroll
                for (int bj = 0; bj < 2; ++bj)
#pragma unroll
                    for (int n = 0; n < 2; ++n) { const f32x4 v = acc[h][bj][i][n] * rsr; pk[h][bj][i][n].x = cvt_pk_bf16(v[0], v[1]); pk[h][bj][i][n].y = cvt_pk_bf16(v[2], v[3]); } }
            __builtin_amdgcn_sched_barrier(0);
        }
#pragma unroll
        for (int n = 0; n < 2; ++n) {
            __builtin_amdgcn_sched_barrier(0);
            const unsigned ch = ch0 + 4u * n;
            const f32x4 wg0 = *(const f32x4*)(cw + ch), wg1 = *(const f32x4*)(cw + (11264u + ch)), wg2 = *(const f32x4*)(cw + (22528u + ch)), bg = *(const f32x4*)(cb + ch);
            const f32x4 wv0 = *(const f32x4*)(cw + (5632u + ch)), wv1 = *(const f32x4*)(cw + (16896u + ch)), wv2 = *(const f32x4*)(cw + (28160u + ch)), bv = *(const f32x4*)(cb + (5632u + ch));
#pragma unroll
            for (int ai = 0; ai < 2; ++ai) {
                u32x2 gp = (u32x2){0u, 0u}, vp = gp;
#pragma unroll
                for (int m = 0; m < 4; ++m) {
                    const unsigned row = row0 + ai * HALF + m * 16;
                    const u32x2 gc = pk[ai][0][m][n], vc = pk[ai][1][m][n];
                    u32x2 g1, g2, v1, v2;
#pragma unroll
                    for (int q = 0; q < 2; ++q) {
                        const unsigned a1 = ror1(gc[q]), b1 = ror1(gp[q]), a2 = ror2(gc[q]), b2 = ror2(gp[q]);
                        const unsigned c1 = ror1(vc[q]), d1 = ror1(vp[q]), c2 = ror2(vc[q]), d2 = ror2(vp[q]);
                        g1[q] = fr >= 1 ? a1 : b1; g2[q] = fr >= 2 ? a2 : b2; v1[q] = fr >= 1 ? c1 : d1; v2[q] = fr >= 2 ? c2 : d2;
                    }
                    float o[4];
#pragma unroll
                    for (int j = 0; j < 4; ++j) {
                        const int q = j >> 1; const bool hi = j & 1;
                        const float g0f = hi ? bf_hi(gc[q]) : bf_lo(gc[q]), g1f = hi ? bf_hi(g1[q]) : bf_lo(g1[q]), g2f = hi ? bf_hi(g2[q]) : bf_lo(g2[q]);
                        const float v0f = hi ? bf_hi(vc[q]) : bf_lo(vc[q]), v1f = hi ? bf_hi(v1[q]) : bf_lo(v1[q]), v2f = hi ? bf_hi(v2[q]) : bf_lo(v2[q]);
                        const float cg = bg[j] + wg0[j] * g2f + wg1[j] * g1f + wg2[j] * g0f;
                        const float cv = bv[j] + wv0[j] * v2f + wv1[j] * v1f + wv2[j] * v0f;
                        o[j] = __fdividef(cg, 1.f + __expf(-cg)) * cv;
                    }
                    { u32x2 w; w.x = cvt_pk_bf16(o[0], o[1]); w.y = cvt_pk_bf16(o[2], o[3]); *(u32x2*)(G + (row * 5632u + ch)) = w; }
                    if ((m == 0 && fr < 2) || (m == 3 && fr >= 14)) {
                        const unsigned slot = (m == 0) ? (unsigned)fr : (unsigned)(fr - 12), uo = ((row >> 6) * 4u + slot) * 11264u + ch;
                        *(u32x2*)(US + uo) = gc; *(u32x2*)(US + (uo + 5632u)) = vc;
                    }
                    gp = gc; vp = vc;
                    __builtin_amdgcn_sched_barrier(0);
                }
            }
        }
    }
    template <int KIND> __device__ __forceinline__ void init_acc(f32x4 (&acc)[2][2][4][2], const Unit& u, int wr, int wc, int fr, int fq) const {
        const int row0 = u.pm * BM + wr * 64 + fr, col0 = u.pn * BM + wc * 32 + 8 * fq;
#pragma unroll
        for (int ai = 0; ai < 2; ++ai)
#pragma unroll
            for (int bj = 0; bj < 2; ++bj)
#pragma unroll
                for (int m = 0; m < 4; ++m)
#pragma unroll
                    for (int n = 0; n < 2; ++n) {
                        if (KIND == 1) {
                            const size_t eo = (size_t)(row0 + ai * HALF + m * 16) * ldc + col0 + bj * HALF + 4 * n;
                            const u32x2 hi = *(const u32x2*)(XB + eo), lo = *(const u32x2*)((const bf16_t*)X + eo);
                            acc[ai][bj][m][n] = (f32x4){bf_lo(hi.x) + bf_lo(lo.x), bf_hi(hi.x) + bf_hi(lo.x), bf_lo(hi.y) + bf_lo(lo.y), bf_hi(hi.y) + bf_hi(lo.y)};
                        } else acc[ai][bj][m][n] = (f32x4){0.f, 0.f, 0.f, 0.f};
                    }
    }
    template <int KIND> __device__ __forceinline__ void run(const f32x4 (&acc)[2][2][4][2], const Unit& u, int wr, int wc, int fr, int fq) const {
        const int row0 = u.pm * BM + wr * 64 + fr, col0 = u.pn * BM + wc * 32 + 8 * fq;
        if (KIND == 2) { ffn_gate(acc, u, wr, wc, fr, fq); return; }
        if (KIND == 0) {
            const int sm = u.which ? smode2 : smode, ld = u.which ? ldc2 : ldc; bf16_t* Oo = u.which ? O2 : O;
            LAS float* wsc = (LAS float*)(lds + 131072) + (wr * 4 + wc) * 64;
            if (sm == 2) {
                const int i = fq * 16 + fr, tok = u.pn * BM + wc * 32 + (i & 31) + (i >> 5) * HALF;
                float t = 0.f;
#pragma unroll
                for (int j = 0; j < 8; ++j) { const f32x4 a = *(const f32x4*)(ssq + (size_t)tok * 32 + 4 * j); t += (a[0] + a[1]) + (a[2] + a[3]); }
                wsc[i] = rsqrtf(t * (1.f / 2048.f) + 1e-6f);
                asm volatile("s_waitcnt lgkmcnt(0)" ::: "memory");
            }
            float rs8[8];
            if (sm == 1) {
                f32x4 pa[8], pb[8];
#pragma unroll
                for (int i = 0; i < 8; ++i) { const float* q = ssq + (size_t)(row0 + (i >> 2) * HALF + (i & 3) * 16) * 32 + fq * 8; pa[i] = *(const f32x4*)q; pb[i] = *(const f32x4*)(q + 4); }
#pragma unroll
                for (int i = 0; i < 8; ++i) { float t = ((pa[i][0] + pa[i][1]) + (pa[i][2] + pa[i][3])) + ((pb[i][0] + pb[i][1]) + (pb[i][2] + pb[i][3]));
                    t += __shfl_xor(t, 16); t += __shfl_xor(t, 32); rs8[i] = rsqrtf(t * (1.f / 2048.f) + 1e-6f); }
            } else {
#pragma unroll
                for (int i = 0; i < 8; ++i) rs8[i] = 1.f;
            }
#pragma unroll
            for (int ai = 0; ai < 2; ++ai)
#pragma unroll
                for (int m = 0; m < 4; ++m) { const int row = row0 + ai * HALF + m * 16; bf16_t* rowp = Oo + (size_t)row * ld + col0;
                    const float rsr = rs8[ai * 4 + m];
#pragma unroll
                    for (int bj = 0; bj < 2; ++bj) { f32x4 v0 = acc[ai][bj][m][0] * rsr, v1 = acc[ai][bj][m][1] * rsr;
                        if (sm == 2) { const f32x4 q0 = *(const LAS f32x4*)(wsc + bj * 32 + 8 * fq), q1 = *(const LAS f32x4*)(wsc + bj * 32 + 8 * fq + 4); v0 = v0 * q0; v1 = v1 * q1; }
                        u32x4 w; w.x = cvt_pk_bf16(v0[0], v0[1]); w.y = cvt_pk_bf16(v0[2], v0[3]); w.z = cvt_pk_bf16(v1[0], v1[1]); w.w = cvt_pk_bf16(v1[2], v1[3]);
                        *(u32x4*)(rowp + bj * HALF) = w; } }
            if (sm == 2) asm volatile("s_waitcnt lgkmcnt(0)" ::: "memory");
        } else {
#pragma unroll
            for (int ai = 0; ai < 2; ++ai)
#pragma unroll
                for (int m = 0; m < 4; ++m) { const int row = row0 + ai * HALF + m * 16; bf16_t* lp = (bf16_t*)X + (size_t)row * ldc + col0; bf16_t* bp = XB + (size_t)row * ldc + col0;
                    float ss = 0.f;
#pragma unroll
                    for (int bj = 0; bj < 2; ++bj) {
                        const f32x4 v0 = acc[ai][bj][m][0], v1 = acc[ai][bj][m][1];
                        ss += (v0[0] * v0[0] + v0[1] * v0[1]) + (v0[2] * v0[2] + v0[3] * v0[3]) + (v1[0] * v1[0] + v1[1] * v1[1]) + (v1[2] * v1[2] + v1[3] * v1[3]);
                        u32x4 w; w.x = cvt_pk_bf16(v0[0], v0[1]); w.y = cvt_pk_bf16(v0[2], v0[3]); w.z = cvt_pk_bf16(v1[0], v1[1]); w.w = cvt_pk_bf16(v1[2], v1[3]);
                        u32x4 wl; wl.x = cvt_pk_bf16(v0[0] - bf_lo(w.x), v0[1] - bf_hi(w.x)); wl.y = cvt_pk_bf16(v0[2] - bf_lo(w.y), v0[3] - bf_hi(w.y));
                        wl.z = cvt_pk_bf16(v1[0] - bf_lo(w.z), v1[1] - bf_hi(w.z)); wl.w = cvt_pk_bf16(v1[2] - bf_lo(w.w), v1[3] - bf_hi(w.w));
                        *(u32x4*)(bp + bj * HALF) = w; *(u32x4*)(lp + bj * HALF) = wl;
                    }
                    ss += __shfl_xor(ss, 16); ss += __shfl_xor(ss, 32);
                    if (fq == 0) ssq[(size_t)row * 32 + u.pn * 4 + wc] = ss;
                }
        }
    }
};

template <int KIND> __device__ __forceinline__ void gemm_phase(LAS unsigned char* lds, const Gemm g, const Order& S, const Epi& E) {
    const int tid = otid(), wid = __builtin_amdgcn_readfirstlane(tid >> 6), lane = tid & 63, wr = wid >> 2, wc = wid & 3, fr = lane & 15, fq = lane >> 4;
    const int K = g.K, nt = K / BK;
    unsigned voffA[2], voffB[2];
#pragma unroll
    for (int i = 0; i < 2; ++i) { int R, C; stage_rc(tid * 16 + i * 8192, R, C); const int Rb = (R & ~31) + perm32(R & 31);
        voffA[i] = (unsigned)(R * K + C) * 2u; voffB[i] = (unsigned)(Rb * K + C) * 2u; }
    const size_t kstep = (size_t)(BK * 2);
    const size_t hstep = (size_t)HALF * K * 2;
    const size_t tstep = 2 * hstep;
    const unsigned ldsw = (unsigned)wid * 1024u;
    const int aoff = lds_byte(wr * 64 + fr, fq * 8), boff = lds_byte(wc * 32 + fr, fq * 8);
#define PG8_SA(b, h) (((b) * 2 + (h)) * HTB)
#define PG8_SB(b, h) ((4 + (b) * 2 + (h)) * HTB)
#define PG8_STAGE(bufoff, gbase, voff) do { _Pragma("unroll") for (int _i = 0; _i < 2; ++_i) \
        __builtin_amdgcn_global_load_lds((const unsigned*)((const char*)(gbase) + (voff)[_i]), (LAS unsigned*)(lds + (bufoff) + ldsw + _i * 8192), 16, 0, 0); } while (0)
#define PG8_LDA(dst, b, h) do { _Pragma("unroll") for (int m = 0; m < 4; ++m) _Pragma("unroll") for (int k = 0; k < 2; ++k) dst[m][k] = *(const LAS bf16x8*)(lds + PG8_SA(b, h) + aoff + m * 2048 + k * 1024); } while (0)
#define PG8_LDB(dst, b, h) do { _Pragma("unroll") for (int n = 0; n < 2; ++n) _Pragma("unroll") for (int k = 0; k < 2; ++k) dst[n][k] = *(const LAS bf16x8*)(lds + PG8_SB(b, h) + boff + n * 2048 + k * 1024); } while (0)
#define PG8_MMA(ai, bj, At, Bt) do { __builtin_amdgcn_s_setprio(1); _Pragma("unroll") for (int m = 0; m < 4; ++m) _Pragma("unroll") for (int n = 0; n < 2; ++n) _Pragma("unroll") for (int k = 0; k < 2; ++k) \
        acc[ai][bj][m][n] = __builtin_amdgcn_mfma_f32_16x16x32_bf16(Bt[n][k], At[m][k], acc[ai][bj][m][n], 0, 0, 0); __builtin_amdgcn_s_setprio(0); } while (0)
#define PG8_WAIT_V(n) asm volatile("s_waitcnt vmcnt(" #n ")" ::: "memory")
#define PG8_WAIT_L(n) asm volatile("s_waitcnt lgkmcnt(" #n ")" ::: "memory")
#define PG8_BAR __builtin_amdgcn_s_barrier()
#define PG8_SCHED __builtin_amdgcn_sched_barrier(0)
    Unit cur, nxt; int ui = 0;
    if (!S.next(0, cur)) return;
    f32x4 acc[2][2][4][2];
    E.template init_acc<KIND>(acc, cur, wr, wc, fr, fq);
    bf16x8 At[4][2], B0[2][2], B1[2][2];
    const char* cA = (const char*)(cur.which ? g.A2 : g.A) + (size_t)cur.pm * tstep; const char* cB = (const char*)(cur.which ? g.Bt2 : g.Bt) + (size_t)cur.pn * tstep;
    PG8_STAGE(PG8_SB(0, 0), cB, voffB); PG8_STAGE(PG8_SA(0, 0), cA, voffA); PG8_STAGE(PG8_SB(0, 1), cB + hstep, voffB); PG8_STAGE(PG8_SA(0, 1), cA + hstep, voffA);
    if (wr == 1) PG8_BAR;
    PG8_WAIT_V(4); PG8_BAR;
    PG8_STAGE(PG8_SB(1, 0), cB + kstep, voffB); PG8_STAGE(PG8_SA(1, 0), cA + kstep, voffA); PG8_STAGE(PG8_SB(1, 1), cB + hstep + kstep, voffB);
    PG8_WAIT_V(6); PG8_BAR;
    for (;;) {
        const bool has_next = S.next(ui + 1, nxt);
        const char* nA = has_next ? (const char*)(nxt.which ? g.A2 : g.A) + (size_t)nxt.pm * tstep : cA; const char* nB = has_next ? (const char*)(nxt.which ? g.Bt2 : g.Bt) + (size_t)nxt.pn * tstep : cB;
        for (int t = 0; t < nt; t += 2) {
            const bool last = (t == nt - 2);
            const char* a1 = cA + (size_t)(t + 1) * kstep;
            const char* a2 = last ? nA : cA + (size_t)(t + 2) * kstep; const char* b2 = last ? nB : cB + (size_t)(t + 2) * kstep;
            const char* a3 = a2 + kstep; const char* b3 = b2 + kstep;
            PG8_LDB(B0, 0, 0); PG8_SCHED; PG8_LDA(At, 0, 0); PG8_STAGE(PG8_SA(1, 1), a1 + hstep, voffA);
            PG8_WAIT_L(8); PG8_BAR; PG8_WAIT_L(0); PG8_MMA(0, 0, At, B0); PG8_BAR; PG8_SCHED;
            PG8_LDB(B1, 0, 1); PG8_STAGE(PG8_SB(0, 0), b2, voffB);
            PG8_BAR; PG8_WAIT_L(0); PG8_MMA(0, 1, At, B1); PG8_BAR;
            PG8_LDA(At, 0, 1); PG8_STAGE(PG8_SA(0, 0), a2, voffA);
            PG8_BAR; PG8_WAIT_L(0); PG8_MMA(1, 0, At, B0); PG8_BAR; PG8_SCHED;
            PG8_STAGE(PG8_SB(0, 1), b2 + hstep, voffB);
            PG8_WAIT_V(6); PG8_BAR; PG8_MMA(1, 1, At, B1); PG8_BAR;
            PG8_LDB(B0, 1, 0); PG8_SCHED; PG8_LDA(At, 1, 0); PG8_STAGE(PG8_SA(0, 1), a2 + hstep, voffA);
            PG8_WAIT_L(8); PG8_BAR; PG8_WAIT_L(0); PG8_MMA(0, 0, At, B0); PG8_BAR; PG8_SCHED;
            PG8_LDB(B1, 1, 1); PG8_STAGE(PG8_SB(1, 0), b3, voffB);
            PG8_BAR; PG8_WAIT_L(0); PG8_MMA(0, 1, At, B1); PG8_BAR;
            PG8_LDA(At, 1, 1); PG8_STAGE(PG8_SA(1, 0), a3, voffA);
            PG8_BAR; PG8_WAIT_L(0); PG8_MMA(1, 0, At, B0); PG8_BAR; PG8_SCHED;
            PG8_STAGE(PG8_SB(1, 1), b3 + hstep, voffB);
            PG8_WAIT_V(6); PG8_BAR; PG8_MMA(1, 1, At, B1); PG8_BAR;
        }
        E.template run<KIND>(acc, cur, wr, wc, fr, fq);
        if (!has_next) break;
        E.template init_acc<KIND>(acc, nxt, wr, wc, fr, fq);
        cur = nxt; cA = nA; cB = nB; ++ui;
    }
    PG8_WAIT_V(0);
    if (wr == 0) PG8_BAR;
    PG8_BAR;
#undef PG8_SA
#undef PG8_SB
#undef PG8_STAGE
#undef PG8_LDA
#undef PG8_LDB
#undef PG8_MMA
#undef PG8_WAIT_V
#undef PG8_WAIT_L
#undef PG8_BAR
#undef PG8_SCHED
}
}

struct GemmDesc { const bf16_t* A; const bf16_t* Bt; int M, N, K; int kind; bf16_t* O; float* X; int ldc; int diag; int smode; };

struct Seg { const float* src; bf16_t* dst; const float* gain; int K, ldw, c0, ncols, rep, cstride, dstride, nitems; };
constexpr int NSEG = 37;

__device__ __forceinline__ void set_seg(LAS Seg* s, const float* src, bf16_t* dst, int K, int ldw, int c0, int ncols, int rep = 1, int cstride = 0, int dstride = 0, const float* gain = nullptr) {
    { int z = 0; asm volatile("" : "+v"(z)); K += z; ldw += z; c0 += z; ncols += z; rep += z; cstride += z; dstride += z; }
    { unsigned long long u0 = (unsigned long long)src, u1 = (unsigned long long)dst, u2 = (unsigned long long)gain; asm volatile("" : "+v"(u0), "+v"(u1), "+v"(u2));
      src = (const float*)u0; dst = (bf16_t*)u1; gain = (const float*)u2; }
    s->src = src; s->dst = dst; s->gain = gain; s->K = K; s->ldw = ldw; s->c0 = c0; s->ncols = ncols; s->rep = rep; s->cstride = cstride; s->dstride = dstride; s->nitems = (K / 64) * (ncols / 64) * rep;
}
__device__ void build_segs(const Params& p, LAS Seg* sg) {
    unsigned char* ws = p.ws; int n = 0;
    for (int i = 0; i < 4; ++i) {
        set_seg(sg + n++, p.in[I_WUP] + (size_t)i * 2048 * 11264, (bf16_t*)(ws + W_UP) + (size_t)i * 11264 * 2048, 2048, 11264, 0, 128, 44, 128, 256, p.in[I_FFN_NORM] + i * 2048);
        set_seg(sg + n++, p.in[I_WUP] + (size_t)i * 2048 * 11264, (bf16_t*)(ws + W_UP) + (size_t)i * 11264 * 2048 + (size_t)128 * 2048, 2048, 11264, 5632, 128, 44, 128, 256, p.in[I_FFN_NORM] + i * 2048);
        set_seg(sg + n++, p.in[I_WDOWN] + (size_t)i * 5632 * 2048, (bf16_t*)(ws + W_DOWN) + (size_t)i * 2048 * 5632, 5632, 2048, 0, 2048);
    }
    set_seg(sg + n++, p.in[I_SB_IN], (bf16_t*)(ws + W_SB_IN1), 2048, 6656, 0, 4096, 1, 0, 0, p.in[I_ATTN_NORM] + 0 * 2048);
    set_seg(sg + n++, p.in[I_SB_IN], (bf16_t*)(ws + W_SB_IN1) + (size_t)4096 * 2048, 2048, 6656, 6144, 512, 1, 0, 0, p.in[I_ATTN_NORM] + 0 * 2048);
    set_seg(sg + n++, p.in[I_SB_IN], (bf16_t*)(ws + W_SB_V), 2048, 6656, 4096, 2048, 1, 0, 0, p.in[I_ATTN_NORM] + 0 * 2048);
    set_seg(sg + n++, p.in[I_SB_OUT], (bf16_t*)(ws + W_SB_OUT), 2560, 2048, 0, 2048);
    set_seg(sg + n++, p.in[I_FOX_IN], (bf16_t*)(ws + W_FOX_IN1), 2048, 6672, 0, 4096, 1, 0, 0, p.in[I_ATTN_NORM] + 1 * 2048);
    set_seg(sg + n++, p.in[I_FOX_IN], (bf16_t*)(ws + W_FOX_IN1) + (size_t)4096 * 2048, 2048, 6672, 6160, 512, 1, 0, 0, p.in[I_ATTN_NORM] + 1 * 2048);
    set_seg(sg + n++, p.in[I_FOX_IN], (bf16_t*)(ws + W_FOX_V), 2048, 6672, 4096, 2048, 1, 0, 0, p.in[I_ATTN_NORM] + 1 * 2048);
    set_seg(sg + n++, p.in[I_FOX_OUT], (bf16_t*)(ws + W_FOX_OUT), 2560, 2048, 0, 2048);
    set_seg(sg + n++, p.in[I_SWA_IN], (bf16_t*)(ws + W_SWA_IN1), 2048, 3072, 0, 2304, 1, 0, 0, p.in[I_ATTN_NORM] + 2 * 2048);
    set_seg(sg + n++, p.in[I_SWA_IN], (bf16_t*)(ws + W_SWA_IN1) + (size_t)2304 * 2048, 2048, 3072, 2560, 512, 1, 0, 0, p.in[I_ATTN_NORM] + 2 * 2048);
    set_seg(sg + n++, p.in[I_SWA_IN], (bf16_t*)(ws + W_SWA_V), 2048, 3072, 2304, 256, 1, 0, 0, p.in[I_ATTN_NORM] + 2 * 2048);
    set_seg(sg + n++, p.in[I_SWA_OUT], (bf16_t*)(ws + W_SWA_OUT), 2560, 2048, 0, 2048);
    set_seg(sg + n++, p.in[I_MLA_IN], (bf16_t*)(ws + W_MLA_IN), 2048, 1344, 0, 1344, 1, 0, 0, p.in[I_ATTN_NORM] + 3 * 2048);
    set_seg(sg + n++, p.in[I_MLA_UQ], (bf16_t*)(ws + W_MLA_UQ), 512, 3072, 0, 3072);
    set_seg(sg + n++, p.in[I_MLA_UKV], (bf16_t*)(ws + W_MLA_KN), 256, 4096, 0, 128, 16, 256, 128);
    set_seg(sg + n++, p.in[I_MLA_UKV], (bf16_t*)(ws + W_MLA_V), 256, 4096, 128, 128, 16, 256, 128);
    set_seg(sg + n++, p.in[I_MLA_OUT], (bf16_t*)(ws + W_MLA_OUT), 2560, 2048, 0, 2048);
    for (int i = 0; i < 4; ++i) {
        set_seg(sg + n++, p.in[I_WMEMKV] + (size_t)i * 2048 * 1024, (bf16_t*)(ws + W_MEMK) + (size_t)i * 512 * 2048, 2048, 1024, 0, 512);
        set_seg(sg + n++, p.in[I_WMEMKV] + (size_t)i * 2048 * 1024, (bf16_t*)(ws + W_MEMV) + (size_t)i * 512 * 2048, 2048, 1024, 512, 512);
    }
}

__device__ __forceinline__ void transpose_item(const float* W, int ldw, int K, int c0, bf16_t* WT, int item, int nblk, LAS float* scr, int lane, const float* gain, bool nt) {
    const int kb = item / nblk, nb = item % nblk, k0 = 64 * kb, n0 = 64 * nb;
    const float* src = W + (size_t)(k0 + (lane >> 4)) * ldw + c0 + n0 + (lane & 15) * 4;
    f32x4 v[16];
#pragma unroll
    for (int j = 0; j < 16; ++j) v[j] = __builtin_nontemporal_load((const f32x4*)(src + (size_t)(4 * j) * ldw));
    if (gain) {
#pragma unroll
        for (int j = 0; j < 16; ++j) v[j] = v[j] * gain[k0 + 4 * j + (lane >> 4)];
    }
#pragma unroll
    for (int j = 0; j < 16; ++j) { LAS float* d = scr + (4 * j + (lane >> 4)) * 65 + (lane & 15) * 4; d[0] = v[j].x; d[1] = v[j].y; d[2] = v[j].z; d[3] = v[j].w; }
    asm volatile("s_waitcnt lgkmcnt(0)" ::: "memory");
    const int c = lane & 7;
#pragma unroll
    for (int j = 0; j < 8; ++j) { const int n = (lane >> 3) + 8 * j; const LAS float* sp = scr + (8 * c) * 65 + n;
        u32x4 o; o.x = cvt_pk_bf16(sp[0 * 65], sp[1 * 65]); o.y = cvt_pk_bf16(sp[2 * 65], sp[3 * 65]); o.z = cvt_pk_bf16(sp[4 * 65], sp[5 * 65]); o.w = cvt_pk_bf16(sp[6 * 65], sp[7 * 65]);
        u32x4* dp = (u32x4*)(WT + (size_t)(n0 + n) * K + k0 + 8 * c);
        if (nt) __builtin_nontemporal_store(o, dp); else *dp = o; }
    asm volatile("s_waitcnt lgkmcnt(0)" ::: "memory");
}

__device__ __forceinline__ void rms_row_bf16(const float* xrow, const float* g, bf16_t* orow, float* xcopy, int lane, f32x4 (&y)[8]) {
    const f32x4* xr = (const f32x4*)xrow + lane; float ss = 0.f;
#pragma unroll
    for (int j = 0; j < 8; ++j) { y[j] = xr[64 * j]; ss += (y[j].x * y[j].x + y[j].y * y[j].y) + (y[j].z * y[j].z + y[j].w * y[j].w); }
    if (xcopy) {
#pragma unroll
        for (int j = 0; j < 8; ++j) ((f32x4*)xcopy + lane)[64 * j] = y[j];
    }
    const float rs = rsqrtf(wave_sum(ss) * (1.f / 2048.f) + 1e-6f);
    const f32x4* gr = (const f32x4*)g + lane; u32x2* o8 = (u32x2*)orow + lane;
#pragma unroll
    for (int j = 0; j < 8; ++j) { const f32x4 gg = gr[64 * j]; y[j] = (y[j] * rs) * gg; u32x2 w; w.x = cvt_pk_bf16(y[j].x, y[j].y); w.y = cvt_pk_bf16(y[j].z, y[j].w); o8[64 * j] = w; }
}

__device__ void phase_conv(const Params& p, LAS unsigned char* lds) {
    LAS Seg* sg = (LAS Seg*)lds;
    const int tid = otid(), wave = tid >> 6, lane = tid & 63;
    if (tid == 0) build_segs(p, sg);
    __syncthreads();
    LAS float* scr = (LAS float*)(lds + 4096 + wave * 16640);
    const int gw = blockIdx.x * NWAVE + wave, NGW = gridDim.x * NWAVE;
    int total = 0;
    for (int s = 0; s < NSEG; ++s) total += sg[s].nitems;
    for (int it = gw; it < total; it += NGW) {
        int r = it, s = 0;
        while (r >= sg[s].nitems) { r -= sg[s].nitems; ++s; }
        const int K = sg[s].K, nblk = sg[s].ncols / 64, per = (K / 64) * nblk, ri = r / per, within = r - ri * per;
        const size_t doff = (size_t)((const unsigned char*)sg[s].dst - p.ws);
        const bool keep = (doff >= W_SB_IN1 && doff < W_FOX_IN1) || (doff >= W_MEMK && doff < W_UP + (size_t)11264 * 2048 * 2) || (doff >= W_DOWN && doff < W_DOWN + (size_t)2048 * 5632 * 2);
        transpose_item(sg[s].src, sg[s].ldw, K, sg[s].c0 + ri * sg[s].cstride, sg[s].dst + (size_t)ri * sg[s].dstride * K, within, nblk, scr, lane, sg[s].gain, !keep);
    }
    for (int rt = gw; rt < 2048; rt += NGW) {
        const int l = rt >> 9, r = rt & 511; f32x4 y[8];
        rms_row_bf16(p.in[I_MEM] + (size_t)r * 2048, p.in[I_MEM_NORM] + l * 2048, (bf16_t*)(p.ws + OFF_MEMH) + (size_t)rt * 2048, nullptr, lane, y);
    }
    const int gt = blockIdx.x * NTHR + tid, NT = gridDim.x * NTHR;
    for (int i = gt; i < 32 * 128; i += NT) {
        const int h = i >> 7, dist = i & 127; int bucket;
        if (dist < 16) bucket = dist;
        else { const float d = (float)dist; int large = 16 + (int)(logf(d / 16.f) / 2.0794415416798357f * 16.f); bucket = large < 31 ? large : 31; }
        ((float*)(p.ws + OFF_BIAST))[i] = p.in[I_RELB][bucket * 32 + h];
    }
    for (int i = gt; i < 16 * 2048; i += NT) { const int j = i >> 11, k = i & 2047; ((float*)(p.ws + OFF_WF))[i] = p.in[I_FOX_IN][(size_t)k * 6672 + 6144 + j]; }
    for (int i = gt; i < 192 * 2048 / 8; i += NT) ((u32x4*)((bf16_t*)(p.ws + W_MLA_IN) + (size_t)1344 * 2048))[i] = (u32x4){0u, 0u, 0u, 0u};
}

__device__ void phase_norm(const Params& p, const float* xin, const float* g, int mode) {
    const int tid = otid(), wave = tid >> 6, lane = tid & 63;
    const int gw = blockIdx.x * NWAVE + wave, NGW = gridDim.x * NWAVE;
    for (int row = gw; row < T; row += NGW) {
        f32x4 y[8]; float ss = 0.f;
        u32x2* h8 = (u32x2*)((bf16_t*)(p.ws + OFF_H) + (size_t)row * 2048) + lane; u32x2* l8 = (u32x2*)((bf16_t*)(p.ws + OFF_XR) + (size_t)row * 2048) + lane;
        if (mode == 1) {
            const f32x4* xr = (const f32x4*)(xin + (size_t)row * 2048) + lane;
#pragma unroll
            for (int j = 0; j < 8; ++j) y[j] = xr[64 * j];
        } else {
#pragma unroll
            for (int j = 0; j < 8; ++j) { const u32x2 a = h8[64 * j], b = l8[64 * j]; y[j] = (f32x4){bf_lo(a.x) + bf_lo(b.x), bf_hi(a.x) + bf_hi(b.x), bf_lo(a.y) + bf_lo(b.y), bf_hi(a.y) + bf_hi(b.y)}; }
        }
#pragma unroll
        for (int j = 0; j < 8; ++j) ss += (y[j].x * y[j].x + y[j].y * y[j].y) + (y[j].z * y[j].z + y[j].w * y[j].w);
        ss = wave_sum(ss);
        if (mode == 1) {
#pragma unroll
            for (int j = 0; j < 8; ++j) { u32x2 w; w.x = cvt_pk_bf16(y[j].x, y[j].y); w.y = cvt_pk_bf16(y[j].z, y[j].w); h8[64 * j] = w;
                u32x2 wl; wl.x = cvt_pk_bf16(y[j].x - bf_lo(w.x), y[j].y - bf_hi(w.x)); wl.y = cvt_pk_bf16(y[j].z - bf_lo(w.y), y[j].w - bf_hi(w.y)); l8[64 * j] = wl; }
            if (lane < 32) ((float*)(p.ws + OFF_SSQ))[(size_t)row * 32 + lane] = lane == 0 ? ss : 0.f;
            continue;
        }
        const float rs = rsqrtf(ss * (1.f / 2048.f) + 1e-6f);
        const f32x4* gr = (const f32x4*)g + lane;
        if (mode == 3) {
            f32x4* o = (f32x4*)(p.out + (size_t)row * 2048) + lane;
#pragma unroll
            for (int j = 0; j < 8; ++j) o[64 * j] = (y[j] * rs) * gr[64 * j];
            continue;
        }
#pragma unroll
        for (int j = 0; j < 8; ++j) y[j] = (y[j] * rs) * gr[64 * j];
        const float* wf = (const float*)(p.ws + OFF_WF);
        float mine = 0.f;
#pragma unroll 1
        for (int jf = 0; jf < 16; ++jf) {
            const f32x4* wr_ = (const f32x4*)(wf + jf * 2048) + lane; float d = 0.f;
#pragma unroll
            for (int j = 0; j < 8; ++j) { const f32x4 w = wr_[64 * j]; d += (y[j].x * w.x + y[j].y * w.y) + (y[j].z * w.z + y[j].w * w.w); }
            d = wave_sum(d);
            if (lane == jf) mine = d;
        }
        if (lane < 16) { const float xv = mine + p.in[I_FOX_BF][lane]; const float ls = fminf(xv, 0.f) - __logf(1.f + __expf(-fabsf(xv))); ((float*)(p.ws + OFF_LF))[(size_t)row * 16 + lane] = ls; }
    }
}

__device__ void fox_scan(const Params& p, LAS unsigned char* lds) {
    LAS float* sh = (LAS float*)lds; const int tid = otid();
    for (int bh = blockIdx.x; bh < 32; bh += gridDim.x) {
        const int bb = bh >> 4, head = bh & 15; const float* lf = (const float*)(p.ws + OFF_LF); float* lfc = (float*)(p.ws + OFF_LFC) + (size_t)bh * 4096;
        float v[8]; float run = 0.f;
#pragma unroll
        for (int e = 0; e < 8; ++e) { run += lf[(size_t)(bb * 4096 + tid * 8 + e) * 16 + head]; v[e] = run; }
        sh[tid] = run; __syncthreads();
        for (int off = 1; off < 512; off <<= 1) { float x = sh[tid]; if (tid >= off) x += sh[tid - off]; __syncthreads(); sh[tid] = x; __syncthreads(); }
        const float excl = sh[tid] - run;
#pragma unroll
        for (int e = 0; e < 8; ++e) lfc[tid * 8 + e] = excl + v[e];
        __syncthreads();
    }
}

__device__ void ffn_fixup(const Params& p, int layer, int pm) {
    const bf16_t* us = (const bf16_t*)(p.ws + OFF_U); bf16_t* g = (bf16_t*)(p.ws + OFF_G);
    const float* cw = p.in[I_CONVW] + (size_t)layer * 3 * 11264; const float* cb = p.in[I_CONVB] + (size_t)layer * 11264;
    constexpr int NCH = DFF / 8;
    for (int item = otid(); item < 8 * NCH; item += NTHR) {
        const int ri = item / NCH, chunk = item - ri * NCH, c = chunk * 8, w = ri & 1, t = pm * 256 + (ri >> 1) * 64 + w, blk = t >> 6, tl = t & (SEQ - 1);
        const bf16_t* r0 = us + ((size_t)blk * 4 + w) * 11264 + c;
        const bf16_t* r1 = w == 1 ? us + ((size_t)blk * 4 + 0) * 11264 + c : us + ((size_t)(blk - 1) * 4 + 3) * 11264 + c;
        const bf16_t* r2 = w == 1 ? us + ((size_t)(blk - 1) * 4 + 3) * 11264 + c : us + ((size_t)(blk - 1) * 4 + 2) * 11264 + c;
        const bool has1 = tl >= 1, has2 = tl >= 2;
        const u32x4 z4 = (u32x4){0u, 0u, 0u, 0u};
        const u32x4 a0 = *(const u32x4*)r0, b0 = *(const u32x4*)(r0 + DFF);
        const u32x4 a1 = has1 ? *(const u32x4*)r1 : z4, b1 = has1 ? *(const u32x4*)(r1 + DFF) : z4;
        const u32x4 a2 = has2 ? *(const u32x4*)r2 : z4, b2 = has2 ? *(const u32x4*)(r2 + DFF) : z4;
        float o[8];
#pragma unroll
        for (int e = 0; e < 8; ++e) {
            const int q = e >> 1; const bool hi = e & 1;
            const float g0 = hi ? bf_hi(a0[q]) : bf_lo(a0[q]), g1 = hi ? bf_hi(a1[q]) : bf_lo(a1[q]), g2 = hi ? bf_hi(a2[q]) : bf_lo(a2[q]);
            const float v0 = hi ? bf_hi(b0[q]) : bf_lo(b0[q]), v1 = hi ? bf_hi(b1[q]) : bf_lo(b1[q]), v2 = hi ? bf_hi(b2[q]) : bf_lo(b2[q]);
            const float cg = cb[c + e] + cw[c + e] * g2 + cw[11264 + c + e] * g1 + cw[22528 + c + e] * g0;
            const float cv = cb[DFF + c + e] + cw[DFF + c + e] * v2 + cw[11264 + DFF + c + e] * v1 + cw[22528 + DFF + c + e] * v0;
            o[e] = cg / (1.f + __expf(-cg)) * cv;
        }
        u32x4 wv; wv.x = cvt_pk_bf16(o[0], o[1]); wv.y = cvt_pk_bf16(o[2], o[3]); wv.z = cvt_pk_bf16(o[4], o[5]); wv.w = cvt_pk_bf16(o[6], o[7]);
        *(u32x4*)(g + (size_t)t * DFF + c) = wv;
    }
}

__device__ void phase_mla_mid(const Params& p) {
    const int tid = otid(), wave = tid >> 6, lane = tid & 63;
    const int gw = blockIdx.x * NWAVE + wave, NGW = gridDim.x * NWAVE;
    const bf16_t* pr = (const bf16_t*)(p.ws + OFF_PROJ);
    for (int row = gw; row < T; row += NGW) {
        const bf16_t* rp = pr + (size_t)row * 1536;
        { const u32x4 a = *(const u32x4*)(rp + lane * 8); float v[8];
#pragma unroll
          for (int e = 0; e < 4; ++e) { v[2 * e] = bf_lo(a[e]); v[2 * e + 1] = bf_hi(a[e]); }
          float ss = 0.f;
#pragma unroll
          for (int e = 0; e < 8; ++e) ss += v[e] * v[e];
          const float rs = rsqrtf(wave_sum(ss) * (1.f / 512.f) + 1e-6f);
          const f32x4 g0 = *(const f32x4*)(p.in[I_MLA_QN] + lane * 8), g1 = *(const f32x4*)(p.in[I_MLA_QN] + lane * 8 + 4);
          u32x4 w; w.x = cvt_pk_bf16(v[0] * rs * g0[0], v[1] * rs * g0[1]); w.y = cvt_pk_bf16(v[2] * rs * g0[2], v[3] * rs * g0[3]);
          w.z = cvt_pk_bf16(v[4] * rs * g1[0], v[5] * rs * g1[1]); w.w = cvt_pk_bf16(v[6] * rs * g1[2], v[7] * rs * g1[3]);
          *(u32x4*)((bf16_t*)(p.ws + OFF_CQN) + (size_t)row * 512 + lane * 8) = w; }
        { const u32x2 a = *(const u32x2*)(rp + 512 + lane * 4); float v[4] = {bf_lo(a.x), bf_hi(a.x), bf_lo(a.y), bf_hi(a.y)};
          const float ss = v[0] * v[0] + v[1] * v[1] + v[2] * v[2] + v[3] * v[3];
          const float rs = rsqrtf(wave_sum(ss) * (1.f / 256.f) + 1e-6f);
          const f32x4 g0 = *(const f32x4*)(p.in[I_MLA_KVN] + lane * 4);
          u32x2 w; w.x = cvt_pk_bf16(v[0] * rs * g0[0], v[1] * rs * g0[1]); w.y = cvt_pk_bf16(v[2] * rs * g0[2], v[3] * rs * g0[3]);
          *(u32x2*)((bf16_t*)(p.ws + OFF_CKVN) + (size_t)row * 256 + lane * 4) = w; }
        if (lane < 32) {
            const float x1 = __uint_as_float((unsigned)rp[768 + lane] << 16), x2 = __uint_as_float((unsigned)rp[800 + lane] << 16);
            const float pos = (float)((const int*)p.in[I_POS])[row]; float s, c; sincos_big(pos * rope_inv_freq(lane), s, c);
            bf16_t* ko = (bf16_t*)(p.ws + OFF_KPE) + (size_t)row * 64;
            const unsigned w = cvt_pk_bf16(x1 * c - x2 * s, x2 * c + x1 * s);
            ko[lane] = (bf16_t)(w & 0xffffu); ko[32 + lane] = (bf16_t)(w >> 16);
        }
    }
}

struct AttnArgs {
    const bf16_t* q; int ldq, qoff;
    const bf16_t* k; int ldk, koff;
    const bf16_t* k2;
    const bf16_t* vt; int ldvt, vrow0, vcol_base;
    int qrow_base, krow_base;
    bf16_t* o; int ocol;
    int q0;
    const float* lfc; const float* biasrow; float sink; const int* pos;
    float scale;
};

#ifndef NQB_SB
#define NQB_SB 2
#endif
#ifndef NQB_FOX
#define NQB_FOX 2
#endif
#ifndef NQB_SWA
#define NQB_SWA 2
#endif
#ifndef NQB_MLA
#define NQB_MLA 2
#endif
#ifndef NQB_MEM
#define NQB_MEM 1
#endif
template <int MODE, int NQB, int NNB, bool MASKED>
__device__ __forceinline__ void att_scores(f32x4 (&st)[4][NQB], f32x4 (&oacc)[NNB][NQB], float (&mrun)[NQB], float (&lsum)[NQB], float (&carry)[NQB], const float (&ct)[NQB],
                                           int wr0, int r, int quad, int kt, float scale2, LAS unsigned char* tbl) {
    const int key0 = kt * 64 + quad * 4;
#pragma unroll
    for (int qb = 0; qb < NQB; ++qb) {
        const int t = wr0 + qb * 16 + r;
        if (MODE == 0) {
            float gprod[4];
#pragma unroll
            for (int kb = 0; kb < 4; ++kb) {
                float pe = 1.f;
#pragma unroll
                for (int j = 3; j >= 0; --j) {
                    const float u = __builtin_amdgcn_fmed3f(st[kb][qb][j] * scale2, -115.f, 115.f);
                    const float e = fast_exp2(u);
                    float beta = __builtin_amdgcn_rcpf(1.f + e), omb = e * beta;
                    if (MASKED) { const bool valid = (key0 + kb * 16 + j) < t; beta = valid ? beta : 0.f; omb = valid ? omb : 1.f; }
                    st[kb][qb][j] = beta * pe;
                    pe *= omb;
                }
                gprod[kb] = pe;
            }
            float Hh[4], Tt[4];
#pragma unroll
            for (int kb = 0; kb < 4; ++kb) {
                const float g0 = gprod[kb], g1 = __shfl_xor(g0, 16), g2 = __shfl_xor(g0, 32), g3 = __shfl_xor(g0, 48);
                Tt[kb] = (g0 * g1) * (g2 * g3);
                Hh[kb] = (((quad ^ 1) > quad) ? g1 : 1.f) * (((quad ^ 2) > quad) ? g2 : 1.f) * (((quad ^ 3) > quad) ? g3 : 1.f);
            }
            float Bs = carry[qb];
#pragma unroll
            for (int kb = 3; kb >= 0; --kb) {
                const float mul = Hh[kb] * Bs;
#pragma unroll
                for (int j = 0; j < 4; ++j) st[kb][qb][j] *= mul;
                Bs *= Tt[kb];
            }
            carry[qb] = Bs;
        } else {
            float mx = -INFINITY;
#pragma unroll
            for (int kb = 0; kb < 4; ++kb) {
                f32x4 cs = (f32x4){0.f, 0.f, 0.f, 0.f};
                if (MODE == 1) cs = *(const LAS f32x4*)(tbl + (kt * 64 + kb * 16 + quad * 4) * 4);
#pragma unroll
                for (int j = 0; j < 4; ++j) {
                    const int key = key0 + kb * 16 + j;
                    float v = st[kb][qb][j] * scale2;
                    if (MODE == 1) v += ct[qb] - cs[j];
                    if (MODE == 2) { const int dist = t - key; const bool valid = dist >= 0 && dist < 128; const int di = dist < 0 ? 0 : (dist > 127 ? 127 : dist); v += ((const LAS float*)tbl)[di]; v = valid ? v : -INFINITY; }
                    else if (MASKED) v = (key <= t) ? v : -INFINITY;
                    st[kb][qb][j] = v; mx = fmaxf(mx, v);
                }
            }
            mx = fmaxf(mx, __shfl_xor(mx, 16)); mx = fmaxf(mx, __shfl_xor(mx, 32));
            const float m_old = mrun[qb], m_new = fmaxf(m_old, mx), m_use = (m_new == -INFINITY) ? 0.f : m_new;
            const float alpha = fast_exp2(m_old - m_use);
            mrun[qb] = m_new;
            float ps = 0.f;
#pragma unroll
            for (int kb = 0; kb < 4; ++kb)
#pragma unroll
                for (int j = 0; j < 4; ++j) { const float pv = fast_exp2(st[kb][qb][j] - m_use); st[kb][qb][j] = pv; ps += pv; }
            lsum[qb] = lsum[qb] * alpha + ps;
            if (RESCALE_ALWAYS || __builtin_amdgcn_ballot_w64(m_new != m_old) != 0ull) {
#pragma unroll
                for (int nb = 0; nb < NNB; ++nb) oacc[nb][qb] = oacc[nb][qb] * alpha;
            }
        }
    }
}

template <int MODE, int NQB>
__device__ __forceinline__ void attn_item(LAS unsigned char* lds, const AttnArgs& a) {
    constexpr int WROWS = 16 * NQB, QR = 128 * NQB;
    constexpr int DK = (MODE == 2) ? 64 : (MODE == 3 ? 192 : 128);
    constexpr int DV = (MODE == 2) ? 64 : 128;
    constexpr int NKK = DK / 32, NNB = DV / 16;
    constexpr int K128_BYTES = (MODE == 2) ? 0 : 16384;
    constexpr int K64_BYTES = (MODE == 2 || MODE == 3) ? 8192 : 0;
    constexpr int KT_BYTES = K128_BYTES + K64_BYTES, VT_BYTES = DV * 128, BUF_BYTES = KT_BYTES + VT_BYTES + 256;
    constexpr int NP128 = K128_BYTES / 8192, NPV = VT_BYTES / 8192;
    constexpr int NBUF = 3, TBL_OFF = NBUF * BUF_BYTES;
    constexpr int NDMA = NP128 + (K64_BYTES ? 1 : 0) + NPV;
    const int tid = otid(), wave = __builtin_amdgcn_readfirstlane(tid >> 6), lane = tid & 63, r = lane & 15, quad = lane >> 4;
    const int wr0 = a.q0 + wave * WROWS;
    int kt_hi, kt_lo, wkt_hi, wkt_lo;
    if (MODE == 4) { kt_lo = 0; kt_hi = 3; wkt_lo = 0; wkt_hi = 3; }
    else if (MODE == 2) { kt_hi = (a.q0 + QR - 1) >> 6; kt_lo = a.q0 >= 128 ? (a.q0 - 128) >> 6 : 0; wkt_hi = (wr0 + WROWS - 1) >> 6; wkt_lo = wr0 >= 127 ? (wr0 - 127) >> 6 : 0; }
    else { kt_hi = (a.q0 + QR - 1) >> 6; kt_lo = 0; wkt_hi = (wr0 + WROWS - 1) >> 6; wkt_lo = 0; }

    unsigned ko128[NP128 > 0 ? NP128 : 1], ko64 = 0, vo[NPV];
#pragma unroll
    for (int i = 0; i < NP128; ++i) { const int s = (wave + 8 * i) * 64 + lane, row = s >> 4, cp = s & 15, c = cp ^ (row & 15); ko128[i] = (unsigned)(row * a.ldk + c * 8) * 2u; }
    if (K64_BYTES) { const int s = wave * 64 + lane, row = s >> 3, cp = s & 7, c = cp ^ ((row >> 1) & 7); ko64 = (unsigned)(row * (MODE == 3 ? 64 : a.ldk) + c * 8) * 2u; }
#pragma unroll
    for (int i = 0; i < NPV; ++i) { const int s = (wave + 8 * i) * 64 + lane, row = s >> 3, cp = s & 7, c = cp ^ ((row >> 1) & 7); vo[i] = (unsigned)(row * a.ldvt + c * 8) * 2u; }
    const int x128 = quad ^ r, x64 = quad ^ (r >> 1), y0 = (quad >> 1) ^ (r >> 1);
    const int krd128 = r * 256, krd64 = r * 128, vrd = r * 128 + (quad & 1) * 8;

    bf16x8 qf[NQB][NKK];
#pragma unroll
    for (int qb = 0; qb < NQB; ++qb) {
        const int t = wr0 + qb * 16 + r;
        const bf16_t* qp = a.q + (size_t)(a.qrow_base + t) * a.ldq + a.qoff;
#pragma unroll
        for (int kk = 0; kk < (MODE == 3 ? 4 : NKK); ++kk) qf[qb][kk] = *(const bf16x8*)(qp + kk * 32 + quad * 8);
        if (MODE == 3) {
            const bf16x8 c1 = *(const bf16x8*)(qp + 128 + quad * 8), c2 = *(const bf16x8*)(qp + 160 + quad * 8);
            const float pos = (float)a.pos[t];
            bf16x8 o1, o2;
#pragma unroll
            for (int e = 0; e < 8; e += 2) {
                float s0, c0, s1, cc1; sincos_big(pos * rope_inv_freq(quad * 8 + e), s0, c0); sincos_big(pos * rope_inv_freq(quad * 8 + e + 1), s1, cc1);
                const float x10 = __uint_as_float((unsigned)(unsigned short)c1[e] << 16), x20 = __uint_as_float((unsigned)(unsigned short)c2[e] << 16);
                const float x11 = __uint_as_float((unsigned)(unsigned short)c1[e + 1] << 16), x21 = __uint_as_float((unsigned)(unsigned short)c2[e + 1] << 16);
                const unsigned wa = cvt_pk_bf16(x10 * c0 - x20 * s0, x11 * cc1 - x21 * s1), wb = cvt_pk_bf16(x20 * c0 + x10 * s0, x21 * cc1 + x11 * s1);
                o1[e] = (short)(wa & 0xffffu); o1[e + 1] = (short)(wa >> 16); o2[e] = (short)(wb & 0xffffu); o2[e + 1] = (short)(wb >> 16);
            }
            qf[qb][NKK - 2] = o1; qf[qb][NKK - 1] = o2;
        }
    }
    f32x4 oacc[NNB][NQB];
#pragma unroll
    for (int nb = 0; nb < NNB; ++nb)
#pragma unroll
        for (int qb = 0; qb < NQB; ++qb) oacc[nb][qb] = (f32x4){0.f, 0.f, 0.f, 0.f};
    float mrun[NQB], lsum[NQB], carry[NQB], ct[NQB];
#pragma unroll
    for (int qb = 0; qb < NQB; ++qb) {
        mrun[qb] = (MODE == 2) ? a.sink * LOG2E : -INFINITY; lsum[qb] = (MODE == 2 && quad == 0) ? 1.f : 0.f; carry[qb] = 1.f;
        ct[qb] = (MODE == 1) ? a.lfc[wr0 + qb * 16 + r] * LOG2E : 0.f;
    }
    if (MODE == 2) { if (tid < 128) ((LAS float*)(lds + TBL_OFF))[tid] = a.biasrow[tid] * LOG2E; }
    const float scale2 = (MODE == 0) ? -a.scale * LOG2E : a.scale * LOG2E;

    const char* kbase = (const char*)(a.k + (size_t)a.krow_base * a.ldk + a.koff);
    const char* k2base = (MODE == 3) ? (const char*)(a.k2 + (size_t)a.krow_base * 64) : kbase;
    const char* vbase = (const char*)(a.vt + (size_t)a.vrow0 * a.ldvt + a.vcol_base);
#define ATT_DMA(kt_, buf_) do { LAS unsigned char* bp = lds + (buf_) * BUF_BYTES + wave * 1024; \
        const char* kg = kbase + (size_t)(kt_) * 64 * a.ldk * 2; \
        _Pragma("unroll") for (int i = 0; i < NP128; ++i) __builtin_amdgcn_global_load_lds((const unsigned*)(kg + ko128[i]), (LAS unsigned*)(bp + i * 8192), 16, 0, 0); \
        if (K64_BYTES) { const char* k2g = (MODE == 3) ? k2base + (size_t)(kt_) * 64 * 64 * 2 : kg; \
            __builtin_amdgcn_global_load_lds((const unsigned*)(k2g + ko64), (LAS unsigned*)(bp + K128_BYTES), 16, 0, 0); } \
        const char* vg = vbase + (size_t)(kt_) * 64 * 2; \
        _Pragma("unroll") for (int i = 0; i < NPV; ++i) __builtin_amdgcn_global_load_lds((const unsigned*)(vg + vo[i]), (LAS unsigned*)(bp + KT_BYTES + i * 8192), 16, 0, 0); \
    } while (0)
#define ATT_WAIT_TILE(more_) do { if (more_) { if (NDMA == 2) asm volatile("s_waitcnt vmcnt(2) lgkmcnt(0)" ::: "memory"); else if (NDMA == 4) asm volatile("s_waitcnt vmcnt(4) lgkmcnt(0)" ::: "memory"); \
            else asm volatile("s_waitcnt vmcnt(5) lgkmcnt(0)" ::: "memory"); } else asm volatile("s_waitcnt vmcnt(0) lgkmcnt(0)" ::: "memory"); \
        __builtin_amdgcn_s_barrier(); asm volatile("" ::: "memory"); } while (0)

    const int n_tiles = kt_hi - kt_lo + 1;
    if (MODE == 1) { const int n4 = (a.q0 + QR) >> 2; for (int i = tid; i < n4; i += NTHR) *(LAS f32x4*)(lds + TBL_OFF + i * 16) = *(const f32x4*)(a.lfc + i * 4) * LOG2E; }
    asm volatile("s_waitcnt vmcnt(0)" ::: "memory");
    ATT_DMA(kt_hi, 0);
    if (n_tiles > 1) ATT_DMA(kt_hi - 1, 1);
    ATT_WAIT_TILE(n_tiles > 1);
    int cur = 0;
    for (int it = 0; it < n_tiles; ++it) {
        const int kt = kt_hi - it;
        if (it + 2 < n_tiles) { const int b2 = cur + 2 >= NBUF ? cur + 2 - NBUF : cur + 2; ATT_DMA(kt - 2, b2); }
        if (kt >= wkt_lo && kt <= wkt_hi) {
            LAS unsigned char* kbuf = lds + cur * BUF_BYTES; LAS unsigned char* vbuf = kbuf + KT_BYTES;
            f32x4 st[4][NQB];
#pragma unroll
            for (int kb = 0; kb < 4; ++kb)
#pragma unroll
                for (int qb = 0; qb < NQB; ++qb) st[kb][qb] = (f32x4){0.f, 0.f, 0.f, 0.f};
#pragma unroll
            for (int kb = 0; kb < 4; ++kb) {
#pragma unroll
                for (int kk = 0; kk < NKK; ++kk) {
                    bf16x8 af;
                    if (MODE == 2) af = *(const LAS bf16x8*)(kbuf + kb * 2048 + krd64 + ((x64 ^ (kk * 4)) * 16));
                    else if (MODE == 3 && kk >= 4) af = *(const LAS bf16x8*)(kbuf + K128_BYTES + kb * 2048 + krd64 + ((x64 ^ ((kk - 4) * 4)) * 16));
                    else af = *(const LAS bf16x8*)(kbuf + kb * 4096 + krd128 + ((x128 ^ (kk * 4)) * 16));
#pragma unroll
                    for (int qb = 0; qb < NQB; ++qb) st[kb][qb] = __builtin_amdgcn_mfma_f32_16x16x32_bf16(af, qf[qb][kk], st[kb][qb], 0, 0, 0);
                }
            }
            const bool need_mask = (MODE == 2) ? true : (MODE == 4) ? false : (kt * 64 + 63 >= wr0);
            if (need_mask) att_scores<MODE, NQB, NNB, true>(st, oacc, mrun, lsum, carry, ct, wr0, r, quad, kt, scale2, lds + TBL_OFF);
            else att_scores<MODE, NQB, NNB, false>(st, oacc, mrun, lsum, carry, ct, wr0, r, quad, kt, scale2, lds + TBL_OFF);
#pragma unroll
            for (int k2 = 0; k2 < 2; ++k2) {
                bf16x8 pf[NQB];
#pragma unroll
                for (int qb = 0; qb < NQB; ++qb) {
                    u32x4 w; w.x = cvt_pk_bf16(st[2 * k2][qb][0], st[2 * k2][qb][1]); w.y = cvt_pk_bf16(st[2 * k2][qb][2], st[2 * k2][qb][3]);
                    w.z = cvt_pk_bf16(st[2 * k2 + 1][qb][0], st[2 * k2 + 1][qb][1]); w.w = cvt_pk_bf16(st[2 * k2 + 1][qb][2], st[2 * k2 + 1][qb][3]);
                    pf[qb] = __builtin_bit_cast(bf16x8, w);
                }
                const int vlo = vrd + ((y0 ^ (k2 * 4)) * 16), vhi = vrd + (((y0 ^ 2) ^ (k2 * 4)) * 16);
#pragma unroll
                for (int nb = 0; nb < NNB; ++nb) {
                    const u32x2 lo = *(const LAS u32x2*)(vbuf + nb * 2048 + vlo), hi = *(const LAS u32x2*)(vbuf + nb * 2048 + vhi);
                    const bf16x8 vf = __builtin_bit_cast(bf16x8, (u32x4){lo.x, lo.y, hi.x, hi.y});
#pragma unroll
                    for (int qb = 0; qb < NQB; ++qb) oacc[nb][qb] = __builtin_amdgcn_mfma_f32_16x16x32_bf16(vf, pf[qb], oacc[nb][qb], 0, 0, 0);
                }
            }
        }
        ATT_WAIT_TILE(it + 2 < n_tiles);
        cur = cur + 1 == NBUF ? 0 : cur + 1;
    }
#undef ATT_DMA
#undef ATT_WAIT_TILE
#pragma unroll
    for (int qb = 0; qb < NQB; ++qb) {
        float inv = 1.f;
        if (MODE != 0) { float l = lsum[qb]; l += __shfl_xor(l, 16); l += __shfl_xor(l, 32); inv = 1.f / l; }
        const int t = wr0 + qb * 16 + r;
        bf16_t* op = a.o + (size_t)(a.qrow_base + t) * ATTW + a.ocol + quad * 4;
#pragma unroll
        for (int nb = 0; nb < NNB; ++nb) { const f32x4 v = oacc[nb][qb] * inv; u32x2 w; w.x = cvt_pk_bf16(v[0], v[1]); w.y = cvt_pk_bf16(v[2], v[3]); *(u32x2*)(op + nb * 16) = w; }
    }
}

__device__ __forceinline__ void mem_attn_item(const Params& p, LAS unsigned char* lds, int layer, int idx, const bf16_t* q, int ldq, int qoff) {
    constexpr int NQBLK = SEQ / (128 * NQB_MEM);
    const int qblk = idx % NQBLK, mh = (idx / NQBLK) & 3, b = idx / (4 * NQBLK);
    AttnArgs a;
    a.q = q; a.ldq = ldq; a.qoff = qoff + mh * 128;
    a.k = (const bf16_t*)(p.ws + OFF_MEMK); a.ldk = 2048; a.koff = layer * 512 + mh * 128; a.k2 = nullptr;
    a.vt = (const bf16_t*)(p.ws + OFF_MEMVT); a.ldvt = 2048; a.vrow0 = layer * 512 + mh * 128; a.vcol_base = layer * 512 + b * 256;
    a.qrow_base = b * SEQ; a.krow_base = layer * 512 + b * 256;
    a.o = (bf16_t*)(p.ws + OFF_ATT); a.ocol = 2048 + mh * 128; a.q0 = qblk * 128 * NQB_MEM;
    a.lfc = nullptr; a.biasrow = nullptr; a.sink = 0.f; a.pos = nullptr; a.scale = 0.08838834764831845f;
    attn_item<4, NQB_MEM>(lds, a);
}

__device__ void phase_attn(const Params& p, LAS unsigned char* lds, int layer) {
    const bf16_t* proj = (const bf16_t*)(p.ws + OFF_PROJ);
    if (layer == 2) {
        constexpr int NQBLK = SEQ / (128 * NQB_SWA);
        for (int idx = blockIdx.x; idx < 64 * NQBLK; idx += gridDim.x) {
            const int qblk = idx % NQBLK, head = (idx / NQBLK) & 31, b = idx / (32 * NQBLK), kvh = head >> 3;
            AttnArgs a;
            a.q = proj; a.ldq = 2816; a.qoff = head * 64;
            a.k = proj; a.ldk = 2816; a.koff = 2048 + kvh * 64; a.k2 = nullptr;
            a.vt = (const bf16_t*)(p.ws + OFF_VT); a.ldvt = T; a.vrow0 = kvh * 64; a.vcol_base = b * SEQ;
            a.qrow_base = b * SEQ; a.krow_base = b * SEQ;
            a.o = (bf16_t*)(p.ws + OFF_ATT); a.ocol = head * 64; a.q0 = qblk * 128 * NQB_SWA;
            a.lfc = nullptr; a.biasrow = (const float*)(p.ws + OFF_BIAST) + head * 128; a.sink = p.in[I_SWA_SINKS][head]; a.pos = nullptr; a.scale = 0.125f;
            attn_item<2, NQB_SWA>(lds, a);
        }
    } else {
        const int nqb = layer == 0 ? NQB_SB : layer == 1 ? NQB_FOX : NQB_MLA, NQBLK = SEQ / (128 * nqb);
        for (int ps = blockIdx.x; ps < 32 * (NQBLK / 2); ps += gridDim.x) {
            const int xcd = ps & 7, j = ps >> 3, combo = xcd * 4 + (j & 3), pair = j >> 2, b = combo >> 4, head = combo & 15;
            for (int s = 0; s < 2; ++s) {
                const int qblk = s == 0 ? NQBLK - 1 - pair : pair;
                AttnArgs a;
                a.vt = (const bf16_t*)(p.ws + OFF_VT); a.ldvt = T; a.vrow0 = head * 128; a.vcol_base = b * SEQ;
                a.qrow_base = b * SEQ; a.krow_base = b * SEQ;
                a.o = (bf16_t*)(p.ws + OFF_ATT); a.ocol = head * 128; a.q0 = qblk * 128 * nqb;
                a.lfc = nullptr; a.biasrow = nullptr; a.sink = 0.f; a.pos = nullptr; a.k2 = nullptr;
                if (layer == 3) {
                    a.q = (const bf16_t*)(p.ws + OFF_Q3); a.ldq = 3072; a.qoff = head * 192;
                    a.k = (const bf16_t*)(p.ws + OFF_KN); a.ldk = 2048; a.koff = head * 128; a.k2 = (const bf16_t*)(p.ws + OFF_KPE);
                    a.pos = (const int*)p.in[I_POS] + b * SEQ; a.scale = 0.07216878364870322f;
                    attn_item<3, NQB_MLA>(lds, a);
                } else {
                    a.q = proj; a.ldq = 4608; a.qoff = head * 128;
                    a.k = proj; a.ldk = 4608; a.koff = 2048 + head * 128; a.scale = 0.08838834764831845f;
                    if (layer == 1) { a.lfc = (const float*)(p.ws + OFF_LFC) + (size_t)(b * 16 + head) * 4096; attn_item<1, NQB_FOX>(lds, a); }
                    else attn_item<0, NQB_SB>(lds, a);
                }
            }
        }
    }
    for (int idx = blockIdx.x; idx < 8 * (SEQ / (128 * NQB_MEM)); idx += gridDim.x) {
        if (layer == 2) mem_attn_item(p, lds, layer, idx, proj, 2816, 2304);
        else if (layer == 3) mem_attn_item(p, lds, layer, idx, proj, 1536, 832);
        else mem_attn_item(p, lds, layer, idx, proj, 4608, 4096);
    }
}

enum { K_GIN = 0, K_ATT, K_GOUT, K_NORMF, K_GUP, K_CONVG, K_GDOWN, K_NORMA, K_MID, K_G2, K_FINAL, K_CONV, K_NORM0 };

__device__ __forceinline__ bool get_gemm(const Params& p, int kind, int layer, int gi, GemmDesc& d) {
    unsigned char* ws = p.ws;
    d.kind = 0; d.O = nullptr; d.X = nullptr; d.diag = 0; d.smode = 0;
    const bf16_t* h = (const bf16_t*)(ws + OFF_H);
    if (kind == K_GIN && layer == 0 && gi >= 2) {
        gi -= 2;
        if (gi == 0) { d.A = (const bf16_t*)(ws + OFF_MEMH); d.Bt = (const bf16_t*)(ws + W_MEMK); d.M = 2048; d.N = 2048; d.K = 2048; d.O = (bf16_t*)(ws + OFF_MEMK); d.ldc = 2048; d.diag = 1; return true; }
        if (gi == 1) { d.A = (const bf16_t*)(ws + W_MEMV); d.Bt = (const bf16_t*)(ws + OFF_MEMH); d.M = 2048; d.N = 2048; d.K = 2048; d.O = (bf16_t*)(ws + OFF_MEMVT); d.ldc = 2048; d.diag = 1; return true; }
        return false;
    }
    if (kind == K_GIN) {
        const size_t w1 = layer == 0 ? W_SB_IN1 : layer == 1 ? W_FOX_IN1 : layer == 2 ? W_SWA_IN1 : W_MLA_IN;
        const size_t wv = layer == 0 ? W_SB_V : layer == 1 ? W_FOX_V : W_SWA_V;
        const int n1 = layer < 2 ? 4608 : layer == 2 ? 2816 : 1536; const int mv = layer < 2 ? 2048 : layer == 2 ? 256 : 0;
        if (gi == 0) { d.A = h; d.Bt = (const bf16_t*)(ws + w1); d.M = T; d.N = n1; d.K = 2048; d.O = (bf16_t*)(ws + OFF_PROJ); d.ldc = n1; d.smode = 1; return true; }
        if (gi == 1 && mv) { d.A = (const bf16_t*)(ws + wv); d.Bt = h; d.M = mv; d.N = T; d.K = 2048; d.O = (bf16_t*)(ws + OFF_VT); d.ldc = T; d.smode = 2; return true; }
        return false;
    }
    if (kind == K_G2) {
        if (gi == 0) { d.A = (const bf16_t*)(ws + OFF_CQN); d.Bt = (const bf16_t*)(ws + W_MLA_UQ); d.M = T; d.N = 3072; d.K = 512; d.O = (bf16_t*)(ws + OFF_Q3); d.ldc = 3072; return true; }
        if (gi == 1) { d.A = (const bf16_t*)(ws + OFF_CKVN); d.Bt = (const bf16_t*)(ws + W_MLA_KN); d.M = T; d.N = 2048; d.K = 256; d.O = (bf16_t*)(ws + OFF_KN); d.ldc = 2048; return true; }
        if (gi == 2) { d.A = (const bf16_t*)(ws + W_MLA_V); d.Bt = (const bf16_t*)(ws + OFF_CKVN); d.M = 2048; d.N = T; d.K = 256; d.O = (bf16_t*)(ws + OFF_VT); d.ldc = T; return true; }
        return false;
    }
    if (kind == K_GOUT) {
        if (gi) return false;
        const size_t wo = layer == 0 ? W_SB_OUT : layer == 1 ? W_FOX_OUT : layer == 2 ? W_SWA_OUT : W_MLA_OUT;
        d.A = (const bf16_t*)(ws + OFF_ATT); d.Bt = (const bf16_t*)(ws + wo); d.M = T; d.N = 2048; d.K = 2560; d.kind = 1; d.X = (float*)(ws + OFF_XR); d.ldc = 2048; return true;
    }
    if (kind == K_GUP) {
        if (gi) return false;
        d.A = h; d.Bt = (const bf16_t*)(ws + W_UP) + (size_t)layer * 11264 * 2048; d.M = T; d.N = 11264; d.K = 2048; d.kind = 2; d.ldc = 11264; d.smode = 1; return true;
    }
    if (kind == K_GDOWN) {
        if (gi) return false;
        d.A = (const bf16_t*)(ws + OFF_G); d.Bt = (const bf16_t*)(ws + W_DOWN) + (size_t)layer * 2048 * 5632; d.M = T; d.N = 2048; d.K = 5632; d.kind = 1; d.X = (float*)(ws + OFF_XR); d.ldc = 2048; return true;
    }
    return false;
}

constexpr int N_PHASES = 1 + 6 + 5 + 5 + 8;
__device__ __forceinline__ void decode_phase(int ph, int& kind, int& layer) {
    if (ph == 0) { kind = K_CONV; layer = 0; return; }
    const int q = ph - 1;
    if (q < 16) {
        int k;
        if (q < 6) { layer = 0; k = q; } else if (q < 11) { layer = 1; k = q - 6; } else { layer = 2; k = q - 11; }
        kind = k == 0 ? K_GIN : k == 1 ? K_ATT : k == 2 ? K_GOUT : k == 3 ? K_GUP : k == 4 ? K_GDOWN : K_NORMA;
        return;
    }
    layer = 3; const int k = q - 16;
    kind = k == 0 ? K_GIN : k == 1 ? K_MID : k == 2 ? K_G2 : k == 3 ? K_ATT : k == 4 ? K_GOUT : k == 5 ? K_GUP : k == 6 ? K_GDOWN : K_FINAL;
}

__global__ void __launch_bounds__(NTHR, 2) fwd_megakernel(Params p) {
    extern __shared__ __attribute__((aligned(16))) unsigned char shm[];
    LAS unsigned char* lds = (LAS unsigned char*)shm;
    volatile LAS unsigned* xst = (volatile LAS unsigned*)(lds + LDS_BYTES - 16);
    if (threadIdx.x == 0) { xst[0] = 0u; xst[1] = 0u; xst[2] = 0u; xst[3] = 0u; }
    __syncthreads();
    const XcdBarrier xb = xcd_barrier_post((unsigned*)(p.ws + OFF_BAR), xst);
    for (int ph = p.ph_lo; ph < p.ph_hi; ++ph) {
        if (ph != p.ph_lo) { if (ph == p.ph_lo + 1) cg::this_grid().sync(); else xcd_barrier(xb); }
        int kind, layer; decode_phase(ph, kind, layer);
        if (kind == K_CONV) { phase_conv(p, lds); phase_norm(p, p.in[I_X], p.in[I_ATTN_NORM], 1); }
        else if (kind == K_NORMA) phase_norm(p, (const float*)(p.ws + OFF_XR), p.in[I_ATTN_NORM] + 1 * 2048, 2);
        else if (kind == K_FINAL) phase_norm(p, (const float*)(p.ws + OFF_XR), p.in[I_FINAL_NORM], 3);
        else if (kind == K_MID) phase_mla_mid(p);
        else if (kind == K_ATT) { for (int rep = 0; rep < PROBE_ATT_REPS; ++rep) { if (rep) xcd_barrier(xb); phase_attn(p, lds, layer); } }
        else if (kind == K_GIN && layer == 1) fox_scan(p, lds);
        if (kind == K_GIN || kind == K_G2 || kind == K_GOUT || kind == K_GUP || kind == K_GDOWN) {
            if (kind == K_GDOWN) {
                pg8::Order S0; S0.init(T, 2048, (int)gridDim.x, (int)blockIdx.x, 0); pg8::Unit u0;
                for (int i = 0; S0.next(i, u0); ++i) ffn_fixup(p, layer, u0.pm);
                asm volatile("s_waitcnt vmcnt(0)" ::: "memory");
            }
            const int greps = (kind == K_GIN || kind == K_G2 || kind == K_GUP) ? PROBE_GEMM_REPS : 1;
            for (int grep_ = 0; grep_ < greps; ++grep_) {
            if (grep_) xcd_barrier(xb);
            __syncthreads();
            int shift = 0;
            for (int gi = 0; gi < 4; ++gi) {
                GemmDesc d, d2; d2.M = 0; d2.N = 0; d2.A = nullptr; d2.Bt = nullptr; d2.O = nullptr; d2.ldc = 0; d2.smode = 0;
                if (!get_gemm(p, kind, layer, gi, d)) break;
                const bool merged = (kind == K_GIN && gi == 0) ? get_gemm(p, kind, layer, 1, d2) : false;
                pg8::Order S; const int G = (int)gridDim.x;
                S.init(d.M, d.N, G, (int)((blockIdx.x + G - shift) % G), d.diag, merged ? d2.M : 0, merged ? d2.N : 0);
                pg8::Epi E; E.kind = d.kind; E.smode = d.smode; E.O = d.O; E.X = d.X; E.XB = (bf16_t*)(p.ws + OFF_H); E.ssq = (float*)(p.ws + OFF_SSQ); E.ldc = d.ldc; E.lds = lds;
                E.cw = p.in[I_CONVW] + (size_t)layer * 3 * 11264; E.cb = p.in[I_CONVB] + (size_t)layer * 11264; E.G = (bf16_t*)(p.ws + OFF_G); E.US = (bf16_t*)(p.ws + OFF_U);
                pg8::Gemm g; g.A = d.A; g.Bt = d.Bt; g.M = d.M; g.N = d.N; g.K = d.K; g.A2 = d2.A; g.Bt2 = d2.Bt;
                E.O2 = d2.O; E.ldc2 = d2.ldc; E.smode2 = d2.smode;
                if (d.kind == 0) pg8::gemm_phase<0>(lds, g, S, E); else if (d.kind == 1) pg8::gemm_phase<1>(lds, g, S, E); else pg8::gemm_phase<2>(lds, g, S, E);
                const int nu = (d.diag ? 16 : (d.M / 256) * (d.N / 256)) + (merged ? (d2.M / 256) * (d2.N / 256) : 0);
                shift = ((shift + nu) % G) & ~7;
                if (merged) ++gi;
            }
            }
        }
    }
}

extern "C" void kernel_launch(void* const* d_in, const int* in_sizes, int n_in, void* d_out, int out_size, void* d_ws, size_t ws_size, hipStream_t stream) {
    static int grid = 0;
    if (grid == 0) {
        if (n_in != N_IN || ws_size < WS_END) { fprintf(stderr, "kernel_launch: unexpected n_in %d or ws_size %zu (< %zu)\n", n_in, ws_size, (size_t)WS_END); grid = -1; return; }
        int dev = 0, cus = 0, per_cu = 0;
        hipGetDevice(&dev); hipDeviceGetAttribute(&cus, hipDeviceAttributeMultiprocessorCount, dev);
        if (hipFuncSetAttribute((const void*)fwd_megakernel, hipFuncAttributeMaxDynamicSharedMemorySize, LDS_BYTES) != hipSuccess) { fprintf(stderr, "kernel_launch: hipFuncSetAttribute failed\n"); grid = -1; return; }
        if (hipOccupancyMaxActiveBlocksPerMultiprocessor(&per_cu, (const void*)fwd_megakernel, NTHR, LDS_BYTES) != hipSuccess || per_cu < 1) { fprintf(stderr, "kernel_launch: occupancy query says %d\n", per_cu); per_cu = 1; }
        (void)hipGetLastError();
        grid = cus;
        fprintf(stderr, "kernel_launch: grid %d (cus %d, per_cu %d)\n", grid, cus, per_cu);
    }
    if (grid < 0) return;
    if (hipMemsetAsync((char*)d_ws + OFF_BAR, 0, BAR_BYTES, stream) != hipSuccess) { fprintf(stderr, "kernel_launch: memset of barrier words failed\n"); return; }
    Params p{};
    for (int i = 0; i < N_IN; ++i) p.in[i] = (const float*)d_in[i];
    p.out = (float*)d_out; p.ws = (unsigned char*)d_ws;
#if N_LAUNCH_MODE == 1
    p.ph_lo = 0; p.ph_hi = N_PHASES;
    void* args[] = {&p};
    hipError_t e = hipLaunchCooperativeKernel((const void*)fwd_megakernel, dim3(grid), dim3(NTHR), args, LDS_BYTES, stream);
    if (e != hipSuccess) fprintf(stderr, "cooperative launch failed: %s (grid %d)\n", hipGetErrorString(e), grid);
#else
    for (int ph = 0; ph < N_PHASES; ++ph) {
        p.ph_lo = ph; p.ph_hi = ph + 1;
        hipLaunchKernelGGL(fwd_megakernel, dim3(grid), dim3(NTHR), LDS_BYTES, stream, p);
    }
#endif
}
```

```cpp
#include <hip/hip_runtime.h>
#include <hip/hip_cooperative_groups.h>
#include <cstdio>
#include <cstdint>
namespace cg = cooperative_groups;

#ifndef N_LAUNCH_MODE
#define N_LAUNCH_MODE 1
#endif

#ifndef RESCALE_ALWAYS
#define RESCALE_ALWAYS 1
#endif
#ifndef PROBE_GEMM_REPS
#define PROBE_GEMM_REPS 1
#endif
#ifndef PROBE_SYNC_EXTRA
#define PROBE_SYNC_EXTRA 0
#endif
#ifndef PROBE_ATT_REPS
#define PROBE_ATT_REPS 1
#endif
#define LAS __attribute__((address_space(3)))
typedef unsigned short bf16_t;
typedef short bf16x8 __attribute__((ext_vector_type(8)));
typedef float f32x4 __attribute__((ext_vector_type(4)));
typedef float f32x2 __attribute__((ext_vector_type(2)));
typedef unsigned u32x4 __attribute__((ext_vector_type(4)));
typedef unsigned u32x2 __attribute__((ext_vector_type(2)));

constexpr int T = 8192, D = 2048, SEQ = 4096, DFF = 5632, ATTW = 2560;
constexpr float LOG2E = 1.4426950408889634f;
constexpr int NTHR = 512, NWAVE = 8;
constexpr int LDS_BYTES = 140288;

constexpr size_t OFF_XR = 0;
constexpr size_t OFF_H = OFF_XR + (size_t)T * D * 4;
constexpr size_t OFF_PROJ = OFF_H + (size_t)T * D * 2;
constexpr size_t OFF_VT = OFF_PROJ + (size_t)T * 4608 * 2;
constexpr size_t OFF_ATT = OFF_VT + (size_t)2048 * T * 2;
constexpr size_t OFF_U = OFF_ATT + (size_t)T * ATTW * 2;
constexpr size_t OFF_G = OFF_U + (size_t)T * 11264 * 2;
constexpr size_t OFF_MEMH = OFF_G + (size_t)T * DFF * 2;
constexpr size_t OFF_MEMK = OFF_MEMH + (size_t)2048 * 2048 * 2;
constexpr size_t OFF_MEMVT = OFF_MEMK + (size_t)2048 * 2048 * 2;
constexpr size_t OFF_LF = OFF_MEMVT + (size_t)2048 * 2048 * 2;
constexpr size_t OFF_LFC = OFF_LF + (size_t)T * 16 * 4;
constexpr size_t OFF_BIAST = OFF_LFC + (size_t)32 * 4096 * 4;
constexpr size_t OFF_WF = OFF_BIAST + (size_t)32 * 128 * 4;
constexpr size_t OFF_CQN = OFF_WF + (size_t)16 * 2048 * 4;
constexpr size_t OFF_CKVN = OFF_CQN + (size_t)T * 512 * 2;
constexpr size_t OFF_KPE = OFF_CKVN + (size_t)T * 256 * 2;
constexpr size_t OFF_Q3 = OFF_KPE + (size_t)T * 64 * 2;
constexpr size_t OFF_KN = OFF_Q3 + (size_t)T * 3072 * 2;
constexpr size_t OFF_W = OFF_KN + (size_t)T * 2048 * 2;
constexpr size_t W_SB_IN1 = OFF_W;
constexpr size_t W_SB_V = W_SB_IN1 + (size_t)4608 * 2048 * 2;
constexpr size_t W_SB_OUT = W_SB_V + (size_t)2048 * 2048 * 2;
constexpr size_t W_FOX_IN1 = W_SB_OUT + (size_t)2048 * 2560 * 2;
constexpr size_t W_FOX_V = W_FOX_IN1 + (size_t)4608 * 2048 * 2;
constexpr size_t W_FOX_OUT = W_FOX_V + (size_t)2048 * 2048 * 2;
constexpr size_t W_SWA_IN1 = W_FOX_OUT + (size_t)2048 * 2560 * 2;
constexpr size_t W_SWA_V = W_SWA_IN1 + (size_t)2816 * 2048 * 2;
constexpr size_t W_SWA_OUT = W_SWA_V + (size_t)256 * 2048 * 2;
constexpr size_t W_MLA_IN = W_SWA_OUT + (size_t)2048 * 2560 * 2;
constexpr size_t W_MLA_UQ = W_MLA_IN + (size_t)1536 * 2048 * 2;
constexpr size_t W_MLA_KN = W_MLA_UQ + (size_t)3072 * 512 * 2;
constexpr size_t W_MLA_V = W_MLA_KN + (size_t)2048 * 256 * 2;
constexpr size_t W_MLA_OUT = W_MLA_V + (size_t)2048 * 256 * 2;
constexpr size_t W_MEMK = W_MLA_OUT + (size_t)2048 * 2560 * 2;
constexpr size_t W_MEMV = W_MEMK + (size_t)2048 * 2048 * 2;
constexpr size_t W_UP = W_MEMV + (size_t)2048 * 2048 * 2;
constexpr size_t W_DOWN = W_UP + (size_t)4 * 11264 * 2048 * 2;
constexpr size_t OFF_BAR = W_DOWN + (size_t)4 * 2048 * 5632 * 2;
constexpr size_t BAR_BYTES = 16384;
constexpr size_t OFF_SSQ = OFF_BAR + BAR_BYTES;
constexpr size_t WS_END = OFF_SSQ + (size_t)T * 32 * 4;

enum { I_X = 0, I_MEM, I_POS, I_RELB, I_ATTN_NORM, I_MEM_NORM, I_WMEMKV, I_FFN_NORM, I_WUP, I_CONVW, I_CONVB, I_WDOWN, I_FINAL_NORM,
       I_SB_IN, I_SB_OUT, I_FOX_IN, I_FOX_BF, I_FOX_OUT, I_SWA_IN, I_SWA_SINKS, I_SWA_OUT, I_MLA_IN, I_MLA_QN, I_MLA_UQ, I_MLA_KVN, I_MLA_UKV, I_MLA_OUT, N_IN };

struct Params {
    const float* in[N_IN];
    float* out;
    unsigned char* ws;
    int ph_lo, ph_hi;
};

__device__ __forceinline__ unsigned cvt_pk_bf16(float lo, float hi) { unsigned r; asm volatile("v_cvt_pk_bf16_f32 %0, %1, %2" : "=v"(r) : "v"(lo), "v"(hi)); return r; }
__device__ __forceinline__ int otid() { int t = threadIdx.x; asm volatile("" : "+v"(t)); return t; }
__device__ __forceinline__ float bf_lo(unsigned u) { return __uint_as_float(u << 16); }
__device__ __forceinline__ float bf_hi(unsigned u) { return __uint_as_float(u & 0xffff0000u); }
__device__ __forceinline__ float wave_sum(float v) {
#pragma unroll
    for (int o = 1; o < 64; o <<= 1) v += __shfl_xor(v, o);
    return v;
}
__device__ __forceinline__ float fast_exp2(float x) { return __builtin_amdgcn_exp2f(x); }
__device__ __forceinline__ void sincos_big(float ang, float& s, float& c) {
    const double a = (double)ang; const double n = rint(a * 0.15915494309189535); const float rf = (float)(a - n * 6.283185307179586);
    s = __sinf(rf); c = __cosf(rf);
}
__device__ __forceinline__ float rope_inv_freq(int i) { return exp2f(-(float)i * 0.41524101186092029f); }


#define XB_TMO      128
#define XB_XCNT(j)  (256  + 64 * (j))
#define XB_XSUB(j)  (1280 + 64 * (j))
#define XB_XGEN(j)  (2304 + 64 * (j))
#define XB_TOP      3328
#define XB_TOPGEN   3392
#define XCD_BAR_WORDS 3456
#define XB_SPIN_CAP (1u << 18)
__device__ __forceinline__ unsigned xb_ld(unsigned* p)              { return __hip_atomic_load(p, __ATOMIC_RELAXED, __HIP_MEMORY_SCOPE_AGENT); }
__device__ __forceinline__ unsigned xb_add(unsigned* p, unsigned v) { return __hip_atomic_fetch_add(p, v, __ATOMIC_RELAXED, __HIP_MEMORY_SCOPE_AGENT); }
__device__ __forceinline__ unsigned xb_xcc_id() { return (unsigned)__builtin_amdgcn_s_getreg((3 << 11) | 20) & 0xFu; }
#define XB_SPIN(cond, bar) do { unsigned _sp = 0; while (cond) { __builtin_amdgcn_s_sleep(1); \
    if ((++_sp & 255u) == 0u) { if (xb_ld(&(bar)[XB_TMO])) break; if (_sp > XB_SPIN_CAP) { atomicAdd(&(bar)[XB_TMO], 1u); break; } } } } while (0)
struct XcdBarrier { unsigned* bar; unsigned x; volatile LAS unsigned* st; };
__device__ __forceinline__ XcdBarrier xcd_barrier_post(unsigned* bar, volatile LAS unsigned* st) {
    XcdBarrier b; b.bar = bar; b.x = xb_xcc_id(); b.st = st;
    if (threadIdx.x == 0) (void)xb_add(&bar[XB_XCNT(b.x)], 1u);
    return b;
}
__device__ __forceinline__ void xcd_barrier_complete(unsigned* bar, unsigned x, unsigned& nloc, unsigned& nx) {
    const unsigned G = gridDim.x * gridDim.y * gridDim.z;
    unsigned sum, cnt, mine, sp = 0u;
    for (;;) {
        sum = 0u; cnt = 0u; mine = 0u;
#pragma unroll
        for (unsigned j = 0; j < 16; ++j) { const unsigned c = xb_ld(&bar[XB_XCNT(j)]); sum += c; cnt += (c > 0u) ? 1u : 0u; mine = (j == x) ? c : mine; }
        if (sum == G) break;
        __builtin_amdgcn_s_sleep(1);
        if ((++sp & 255u) == 0u) { if (xb_ld(&bar[XB_TMO])) break; if (sp > XB_SPIN_CAP) { atomicAdd(&bar[XB_TMO], 1u); break; } }
    }
    nloc = mine > 0u ? mine : 1u; nx = cnt > 0u ? cnt : 1u;
}
__device__ __forceinline__ void xcd_barrier(const XcdBarrier& b) {
    asm volatile("s_waitcnt vmcnt(0)" ::: "memory");
    __syncthreads();
    if (threadIdx.x == 0) {
        unsigned* bar = b.bar;
        __builtin_amdgcn_s_waitcnt(0);
        unsigned nloc = b.st[0], nx = b.st[1];
        if (nloc == 0u) { xcd_barrier_complete(bar, b.x, nloc, nx); b.st[0] = nloc; b.st[1] = nx; }
        const unsigned old = xb_add(&bar[XB_XSUB(b.x)], 1u);
        const unsigned gen = old / nloc;
        if (old + 1u == (gen + 1u) * nloc) {
            __builtin_amdgcn_fence(__ATOMIC_RELEASE, "agent");
            asm volatile("s_waitcnt vmcnt(0)" ::: "memory");
            const unsigned og = xb_add(&bar[XB_TOP], 1u);
            const unsigned tg = og / nx;
            if (og + 1u == (tg + 1u) * nx) xb_add(&bar[XB_TOPGEN], 1u);
            else XB_SPIN(xb_ld(&bar[XB_TOPGEN]) == tg, bar);
            __builtin_amdgcn_fence(__ATOMIC_ACQUIRE, "agent");
            xb_add(&bar[XB_XGEN(b.x)], 1u);
            asm volatile("s_waitcnt vmcnt(0)" ::: "memory");
        } else {
            XB_SPIN(xb_ld(&bar[XB_XGEN(b.x)]) == gen, bar);
            __builtin_amdgcn_fence(__ATOMIC_ACQUIRE, "agent");
            asm volatile("s_waitcnt vmcnt(0)" ::: "memory");
        }
    }
    __syncthreads();
}

namespace pg8 {
constexpr int BM = 256, BK = 64, HALF = 128, HTB = HALF * BK * 2, STAGE_BYTES = 8 * HTB, NXCD = 8, WGM = 8;
__device__ __forceinline__ int lds_byte(int r, int c) { const int st = (r >> 4) * 2 + (c >> 5), rr = r & 15, cc = c & 31, ob = rr * 64 + cc * 2; return st * 1024 + (ob ^ (((ob >> 9) & 1) << 5)); }
__device__ __forceinline__ void stage_rc(int b, int& R, int& C) { const int st = b / 1024, sb = b % 1024, swz = sb ^ (((sb >> 9) & 1) << 5); R = (st >> 1) * 16 + swz / 64; C = (st & 1) * 32 + (swz % 64) / 2; }
__device__ __forceinline__ int perm32(int rho) { const int n = rho >> 4, i = rho & 15; return 8 * (i >> 2) + 4 * n + (i & 3); }
struct Unit { int pm, pn, which; };
struct Gemm { const bf16_t* A; const bf16_t* Bt; int M, N, K; const bf16_t* A2; const bf16_t* Bt2; };

struct Order {
    int nM, nN, nwg, G, c, diag, nM2, nN2, nwg2;
    __device__ void init(int M, int N, int G_, int c_, int diag_, int M2 = 0, int N2 = 0) { nM = M / BM; nN = N / BM; nwg = nM * nN; G = G_; c = c_; diag = diag_; nM2 = M2 / BM; nN2 = N2 / BM; nwg2 = nM2 * nN2; }
    static __device__ void tile_map(int wgid, int nM_, int nN_, int nwg_, Unit& u) {
        { const int q = nwg_ / NXCD, r = nwg_ % NXCD, xcd = wgid % NXCD, off = wgid / NXCD; wgid = (xcd < r ? xcd * (q + 1) : r * (q + 1) + (xcd - r) * q) + off; }
        const int nig = WGM * nN_, gid = wgid / nig, fm = gid * WGM, gsz = (nM_ - fm) < WGM ? (nM_ - fm) : WGM;
        u.pm = fm + ((wgid % nig) % gsz); u.pn = (wgid % nig) / gsz;
    }
    __device__ bool next(int i, Unit& u) const {
        u.which = 0;
        if (diag) { const int L = i * G + c; if (L >= 16) return false; const int l = L >> 2; u.pm = 2 * l + (L & 1); u.pn = 2 * l + ((L >> 1) & 1); return true; }
        const long L = (long)i * G + c; if (L >= nwg + nwg2) return false;
        if (L < nwg) tile_map((int)L, nM, nN, nwg, u); else { u.which = 1; tile_map((int)L - nwg, nM2, nN2, nwg2, u); }
        return true;
    }
};

struct Epi {
    int kind, smode; bf16_t* O; float* X; bf16_t* XB; float* ssq; int ldc; LAS unsigned char* lds;
    bf16_t* O2; int ldc2, smode2;
    const float* cw; const float* cb; bf16_t* G; bf16_t* US;
    __device__ __forceinline__ float row_rs(int row, int fq) const {
        const f32x4 a = *(const f32x4*)(ssq + (size_t)row * 32 + fq * 8), b = *(const f32x4*)(ssq + (size_t)row * 32 + fq * 8 + 4);
        float t = ((a[0] + a[1]) + (a[2] + a[3])) + ((b[0] + b[1]) + (b[2] + b[3]));
        t += __shfl_xor(t, 16); t += __shfl_xor(t, 32);
        return rsqrtf(t * (1.f / 2048.f) + 1e-6f);
    }
    static __device__ __forceinline__ unsigned ror1(unsigned x) { return (unsigned)__builtin_amdgcn_update_dpp(0, (int)x, 0x121, 0xf, 0xf, false); }
    static __device__ __forceinline__ unsigned ror2(unsigned x) { return (unsigned)__builtin_amdgcn_update_dpp(0, (int)x, 0x122, 0xf, 0xf, false); }
    __device__ __forceinline__ void ffn_gate(const f32x4 (&acc)[2][2][4][2], const Unit& u, int wr, int wc, int fr, int fq) const {
        unsigned row0 = (unsigned)(u.pm * BM + wr * 64 + fr), ch0 = (unsigned)(u.pn * HALF + wc * 32 + 8 * fq);
        asm volatile("" : "+v"(row0), "+v"(ch0));
        u32x2 pk[2][2][4][2];
#pragma unroll
        for (int h = 0; h < 2; ++h) {
            f32x4 pa[4], pb[4];
#pragma unroll
            for (int i = 0; i < 4; ++i) { const unsigned qo = (row0 + h * HALF + i * 16) * 32u + fq * 8u; pa[i] = *(const f32x4*)(ssq + qo); pb[i] = *(const f32x4*)(ssq + qo + 4u); }
#pragma unroll
            for (int i = 0; i < 4; ++i) { float t = ((pa[i][0] + pa[i][1]) + (pa[i][2] + pa[i][3])) + ((pb[i][0] + pb[i][1]) + (pb[i][2] + pb[i][3]));
                t += __shfl_xor(t, 16); t += __shfl_xor(t, 32); const float rsr = rsqrtf(t * (1.f / 2048.f) + 1e-6f);
#pragma unroll
                for (int bj = 0; bj < 2; ++bj)
#pragma unroll
                    for (int n = 0; n < 2; ++n) { const f32x4 v = acc[h][bj][i][n] * rsr; pk[h][bj][i][n].x = cvt_pk_bf16(v[0], v[1]); pk[h][bj][i][n].y = cvt_pk_bf16(v[2], v[3]); } }
            __builtin_amdgcn_sched_barrier(0);
        }
#pragma unroll
        for (int n = 0; n < 2; ++n) {
            __builtin_amdgcn_sched_barrier(0);
            const unsigned ch = ch0 + 4u * n;
            const f32x4 wg0 = *(const f32x4*)(cw + ch), wg1 = *(const f32x4*)(cw + (11264u + ch)), wg2 = *(const f32x4*)(cw + (22528u + ch)), bg = *(const f32x4*)(cb + ch);
            const f32x4 wv0 = *(const f32x4*)(cw + (5632u + ch)), wv1 = *(const f32x4*)(cw + (16896u + ch)), wv2 = *(const f32x4*)(cw + (28160u + ch)), bv = *(const f32x4*)(cb + (5632u + ch));
#pragma unroll
            for (int ai = 0; ai < 2; ++ai) {
                u32x2 gp = (u32x2){0u, 0u}, vp = gp;
#pragma unroll
                for (int m = 0; m < 4; ++m) {
                    const unsigned row = row0 + ai * HALF + m * 16;
                    const u32x2 gc = pk[ai][0][m][n], vc = pk[ai][1][m][n];
                    u32x2 g1, g2, v1, v2;
#pragma unroll
                    for (int q = 0; q < 2; ++q) {
                        const unsigned a1 = ror1(gc[q]), b1 = ror1(gp[q]), a2 = ror2(gc[q]), b2 = ror2(gp[q]);
                        const unsigned c1 = ror1(vc[q]), d1 = ror1(vp[q]), c2 = ror2(vc[q]), d2 = ror2(vp[q]);
                        g1[q] = fr >= 1 ? a1 : b1; g2[q] = fr >= 2 ? a2 : b2; v1[q] = fr >= 1 ? c1 : d1; v2[q] = fr >= 2 ? c2 : d2;
                    }
                    float o[4];
#pragma unroll
                    for (int j = 0; j < 4; ++j) {
                        const int q = j >> 1; const bool hi = j & 1;
                        const float g0f = hi ? bf_hi(gc[q]) : bf_lo(gc[q]), g1f = hi ? bf_hi(g1[q]) : bf_lo(g1[q]), g2f = hi ? bf_hi(g2[q]) : bf_lo(g2[q]);
                        const float v0f = hi ? bf_hi(vc[q]) : bf_lo(vc[q]), v1f = hi ? bf_hi(v1[q]) : bf_lo(v1[q]), v2f = hi ? bf_hi(v2[q]) : bf_lo(v2[q]);
                        const float cg = bg[j] + wg0[j] * g2f + wg1[j] * g1f + wg2[j] * g0f;
                        const float cv = bv[j] + wv0[j] * v2f + wv1[j] * v1f + wv2[j] * v0f;
                        o[j] = __fdividef(cg, 1.f + __expf(-cg)) * cv;
                    }
                    { u32x2 w; w.x = cvt_pk_bf16(o[0], o[1]); w.y = cvt_pk_bf16(o[2], o[3]); *(u32x2*)(G + (row * 5632u + ch)) = w; }
                    if ((m == 0 && fr < 2) || (m == 3 && fr >= 14)) {
                        const unsigned slot = (m == 0) ? (unsigned)fr : (unsigned)(fr - 12), uo = ((row >> 6) * 4u + slot) * 11264u + ch;
                        *(u32x2*)(US + uo) = gc; *(u32x2*)(US + (uo + 5632u)) = vc;
                    }
                    gp = gc; vp = vc;
                    __builtin_amdgcn_sched_barrier(0);
                }
            }
        }
    }
    template <int KIND> __device__ __forceinline__ void init_acc(f32x4 (&acc)[2][2][4][2], const Unit& u, int wr, int wc, int fr, int fq) const {
        const int row0 = u.pm * BM + wr * 64 + fr, col0 = u.pn * BM + wc * 32 + 8 * fq;
#pragma unroll
        for (int ai = 0; ai < 2; ++ai)
#pragma unroll
            for (int bj = 0; bj < 2; ++bj)
#pragma unroll
                for (int m = 0; m < 4; ++m)
#pragma unroll
                    for (int n = 0; n < 2; ++n) {
                        if (KIND == 1) {
                            const size_t eo = (size_t)(row0 + ai * HALF + m * 16) * ldc + col0 + bj * HALF + 4 * n;
                            const u32x2 hi = *(const u32x2*)(XB + eo), lo = *(const u32x2*)((const bf16_t*)X + eo);
                            acc[ai][bj][m][n] = (f32x4){bf_lo(hi.x) + bf_lo(lo.x), bf_hi(hi.x) + bf_hi(lo.x), bf_lo(hi.y) + bf_lo(lo.y), bf_hi(hi.y) + bf_hi(lo.y)};
                        } else acc[ai][bj][m][n] = (f32x4){0.f, 0.f, 0.f, 0.f};
                    }
    }
    template <int KIND> __device__ __forceinline__ void run(const f32x4 (&acc)[2][2][4][2], const Unit& u, int wr, int wc, int fr, int fq) const {
        const int row0 = u.pm * BM + wr * 64 + fr, col0 = u.pn * BM + wc * 32 + 8 * fq;
        if (KIND == 2) { ffn_gate(acc, u, wr, wc, fr, fq); return; }
        if (KIND == 0) {
            const int sm = u.which ? smode2 : smode, ld = u.which ? ldc2 : ldc; bf16_t* Oo = u.which ? O2 : O;
            LAS float* wsc = (LAS float*)(lds + 131072) + (wr * 4 + wc) * 64;
            if (sm == 2) {
                const int i = fq * 16 + fr, tok = u.pn * BM + wc * 32 + (i & 31) + (i >> 5) * HALF;
                float t = 0.f;
#pragma unroll
                for (int j = 0; j < 8; ++j) { const f32x4 a = *(const f32x4*)(ssq + (size_t)tok * 32 + 4 * j); t += (a[0] + a[1]) + (a[2] + a[3]); }
                wsc[i] = rsqrtf(t * (1.f / 2048.f) + 1e-6f);
                asm volatile("s_waitcnt lgkmcnt(0)" ::: "memory");
            }
            float rs8[8];
            if (sm == 1) {
                f32x4 pa[8], pb[8];
#pragma unroll
                for (int i = 0; i < 8; ++i) { const float* q = ssq + (size_t)(row0 + (i >> 2) * HALF + (i & 3) * 16) * 32 + fq * 8; pa[i] = *(const f32x4*)q; pb[i] = *(const f32x4*)(q + 4); }
#pragma unroll
                for (int i = 0; i < 8; ++i) { float t = ((pa[i][0] + pa[i][1]) + (pa[i][2] + pa[i][3])) + ((pb[i][0] + pb[i][1]) + (pb[i][2] + pb[i][3]));
                    t += __shfl_xor(t, 16); t += __shfl_xor(t, 32); rs8[i] = rsqrtf(t * (1.f / 2048.f) + 1e-6f); }
            } else {
#pragma unroll
                for (int i = 0; i < 8; ++i) rs8[i] = 1.f;
            }
#pragma unroll
            for (int ai = 0; ai < 2; ++ai)
#pragma unroll
                for (int m = 0; m < 4; ++m) { const int row = row0 + ai * HALF + m * 16; bf16_t* rowp = Oo + (size_t)row * ld + col0;
                    const float rsr = rs8[ai * 4 + m];
#pragma unroll
                    for (int bj = 0; bj < 2; ++bj) { f32x4 v0 = acc[ai][bj][m][0] * rsr, v1 = acc[ai][bj][m][1] * rsr;
                        if (sm == 2) { const f32x4 q0 = *(const LAS f32x4*)(wsc + bj * 32 + 8 * fq), q1 = *(const LAS f32x4*)(wsc + bj * 32 + 8 * fq + 4); v0 = v0 * q0; v1 = v1 * q1; }
                        u32x4 w; w.x = cvt_pk_bf16(v0[0], v0[1]); w.y = cvt_pk_bf16(v0[2], v0[3]); w.z = cvt_pk_bf16(v1[0], v1[1]); w.w = cvt_pk_bf16(v1[2], v1[3]);
                        *(u32x4*)(rowp + bj * HALF) = w; } }
            if (sm == 2) asm volatile("s_waitcnt lgkmcnt(0)" ::: "memory");
        } else {
#pragma unroll
            for (int ai = 0; ai < 2; ++ai)
#pragma unroll
                for (int m = 0; m < 4; ++m) { const int row = row0 + ai * HALF + m * 16; bf16_t* lp = (bf16_t*)X + (size_t)row * ldc + col0; bf16_t* bp = XB + (size_t)row * ldc + col0;
                    float ss = 0.f;
#pragma unroll
                    for (int bj = 0; bj < 2; ++bj) {
                        const f32x4 v0 = acc[ai][bj][m][0], v1 = acc[ai][bj][m][1];
                        ss += (v0[0] * v0[0] + v0[1] * v0[1]) + (v0[2] * v0[2] + v0[3] * v0[3]) + (v1[0] * v1[0] + v1[1] * v1[1]) + (v1[2] * v1[2] + v1[3] * v1[3]);
                        u32x4 w; w.x = cvt_pk_bf16(v0[0], v0[1]); w.y = cvt_pk_bf16(v0[2], v0[3]); w.z = cvt_pk_bf16(v1[0], v1[1]); w.w = cvt_pk_bf16(v1[2], v1[3]);
                        u32x4 wl; wl.x = cvt_pk_bf16(v0[0] - bf_lo(w.x), v0[1] - bf_hi(w.x)); wl.y = cvt_pk_bf16(v0[2] - bf_lo(w.y), v0[3] - bf_hi(w.y));
                        wl.z = cvt_pk_bf16(v1[0] - bf_lo(w.z), v1[1] - bf_hi(w.z)); wl.w = cvt_pk_bf16(v1[2] - bf_lo(w.w), v1[3] - bf_hi(w.w));
                        *(u32x4*)(bp + bj * HALF) = w; *(u32x4*)(lp + bj * HALF) = wl;
                    }
                    ss += __shfl_xor(ss, 16); ss += __shfl_xor(ss, 32);
                    if (fq == 0) ssq[(size_t)row * 32 + u.pn * 4 + wc] = ss;
                }
        }
    }
};

template <int KIND> __device__ __forceinline__ void gemm_phase(LAS unsigned char* lds, const Gemm g, const Order& S, const Epi& E) {
    const int tid = otid(), wid = __builtin_amdgcn_readfirstlane(tid >> 6), lane = tid & 63, wr = wid >> 2, wc = wid & 3, fr = lane & 15, fq = lane >> 4;
    const int K = g.K, nt = K / BK;
    unsigned voffA[2], voffB[2];
#pragma unroll
    for (int i = 0; i < 2; ++i) { int R, C; stage_rc(tid * 16 + i * 8192, R, C); const int Rb = (R & ~31) + perm32(R & 31);
        voffA[i] = (unsigned)(R * K + C) * 2u; voffB[i] = (unsigned)(Rb * K + C) * 2u; }
    const size_t kstep = (size_t)(BK * 2);
    const size_t hstep = (size_t)HALF * K * 2;
    const size_t tstep = 2 * hstep;
    const unsigned ldsw = (unsigned)wid * 1024u;
    const int aoff = lds_byte(wr * 64 + fr, fq * 8), boff = lds_byte(wc * 32 + fr, fq * 8);
#define PG8_SA(b, h) (((b) * 2 + (h)) * HTB)
#define PG8_SB(b, h) ((4 + (b) * 2 + (h)) * HTB)
#define PG8_STAGE(bufoff, gbase, voff) do { _Pragma("unroll") for (int _i = 0; _i < 2; ++_i) \
        __builtin_amdgcn_global_load_lds((const unsigned*)((const char*)(gbase) + (voff)[_i]), (LAS unsigned*)(lds + (bufoff) + ldsw + _i * 8192), 16, 0, 0); } while (0)
#define PG8_LDA(dst, b, h) do { _Pragma("unroll") for (int m = 0; m < 4; ++m) _Pragma("unroll") for (int k = 0; k < 2; ++k) dst[m][k] = *(const LAS bf16x8*)(lds + PG8_SA(b, h) + aoff + m * 2048 + k * 1024); } while (0)
#define PG8_LDB(dst, b, h) do { _Pragma("unroll") for (int n = 0; n < 2; ++n) _Pragma("unroll") for (int k = 0; k < 2; ++k) dst[n][k] = *(const LAS bf16x8*)(lds + PG8_SB(b, h) + boff + n * 2048 + k * 1024); } while (0)
#define PG8_MMA(ai, bj, At, Bt) do { __builtin_amdgcn_s_setprio(1); _Pragma("unroll") for (int m = 0; m < 4; ++m) _Pragma("unroll") for (int n = 0; n < 2; ++n) _Pragma("unroll") for (int k = 0; k < 2; ++k) \
        acc[ai][bj][m][n] = __builtin_amdgcn_mfma_f32_16x16x32_bf16(Bt[n][k], At[m][k], acc[ai][bj][m][n], 0, 0, 0); __builtin_amdgcn_s_setprio(0); } while (0)
#define PG8_WAIT_V(n) asm volatile("s_waitcnt vmcnt(" #n ")" ::: "memory")
#define PG8_WAIT_L(n) asm volatile("s_waitcnt lgkmcnt(" #n ")" ::: "memory")
#define PG8_BAR __builtin_amdgcn_s_barrier()
#define PG8_SCHED __builtin_amdgcn_sched_barrier(0)
    Unit cur, nxt; int ui = 0;
    if (!S.next(0, cur)) return;
    f32x4 acc[2][2][4][2];
    E.template init_acc<KIND>(acc, cur, wr, wc, fr, fq);
    bf16x8 At[4][2], B0[2][2], B1[2][2];
    const char* cA = (const char*)(cur.which ? g.A2 : g.A) + (size_t)cur.pm * tstep; const char* cB = (const char*)(cur.which ? g.Bt2 : g.Bt) + (size_t)cur.pn * tstep;
    PG8_STAGE(PG8_SB(0, 0), cB, voffB); PG8_STAGE(PG8_SA(0, 0), cA, voffA); PG8_STAGE(PG8_SB(0, 1), cB + hstep, voffB); PG8_STAGE(PG8_SA(0, 1), cA + hstep, voffA);
    if (wr == 1) PG8_BAR;
    PG8_WAIT_V(4); PG8_BAR;
    PG8_STAGE(PG8_SB(1, 0), cB + kstep, voffB); PG8_STAGE(PG8_SA(1, 0), cA + kstep, voffA); PG8_STAGE(PG8_SB(1, 1), cB + hstep + kstep, voffB);
    PG8_WAIT_V(6); PG8_BAR;
    for (;;) {
        const bool has_next = S.next(ui + 1, nxt);
        const char* nA = has_next ? (const char*)(nxt.which ? g.A2 : g.A) + (size_t)nxt.pm * tstep : cA; const char* nB = has_next ? (const char*)(nxt.which ? g.Bt2 : g.Bt) + (size_t)nxt.pn * tstep : cB;
        for (int t = 0; t < nt; t += 2) {
            const bool last = (t == nt - 2);
            const char* a1 = cA + (size_t)(t + 1) * kstep;
            const char* a2 = last ? nA : cA + (size_t)(t + 2) * kstep; const char* b2 = last ? nB : cB + (size_t)(t + 2) * kstep;
            const char* a3 = a2 + kstep; const char* b3 = b2 + kstep;
            PG8_LDB(B0, 0, 0); PG8_SCHED; PG8_LDA(At, 0, 0); PG8_STAGE(PG8_SA(1, 1), a1 + hstep, voffA);
            PG8_WAIT_L(8); PG8_BAR; PG8_WAIT_L(0); PG8_MMA(0, 0, At, B0); PG8_BAR; PG8_SCHED;
            PG8_LDB(B1, 0, 1); PG8_STAGE(PG8_SB(0, 0), b2, voffB);
            PG8_BAR; PG8_WAIT_L(0); PG8_MMA(0, 1, At, B1); PG8_BAR;
            PG8_LDA(At, 0, 1); PG8_STAGE(PG8_SA(0, 0), a2, voffA);
            PG8_BAR; PG8_WAIT_L(0); PG8_MMA(1, 0, At, B0); PG8_BAR; PG8_SCHED;
            PG8_STAGE(PG8_SB(0, 1), b2 + hstep, voffB);
            PG8_WAIT_V(6); PG8_BAR; PG8_MMA(1, 1, At, B1); PG8_BAR;
            PG8_LDB(B0, 1, 0); PG8_SCHED; PG8_LDA(At, 1, 0); PG8_STAGE(PG8_SA(0, 1), a2 + hstep, voffA);
            PG8_WAIT_L(8); PG8_BAR; PG8_WAIT_L(0); PG8_MMA(0, 0, At, B0); PG8_BAR; PG8_SCHED;
            PG8_LDB(B1, 1, 1); PG8_STAGE(PG8_SB(1, 0), b3, voffB);
            PG8_BAR; PG8_WAIT_L(0); PG8_MMA(0, 1, At, B1); PG8_BAR;
            PG8_LDA(At, 1, 1); PG8_STAGE(PG8_SA(1, 0), a3, voffA);
            PG8_BAR; PG8_WAIT_L(0); PG8_MMA(1, 0, At, B0); PG8_BAR; PG8_SCHED;
            PG8_STAGE(PG8_SB(1, 1), b3 + hstep, voffB);
            PG8_WAIT_V(6); PG8_BAR; PG8_MMA(1, 1, At, B1); PG8_BAR;
        }
        E.template run<KIND>(acc, cur, wr, wc, fr, fq);
        if (!has_next) break;
        E.template init_acc<KIND>(acc, nxt, wr, wc, fr, fq);
        cur = nxt; cA = nA; cB = nB; ++ui;
    }
    PG8_WAIT_V(0);
    if (wr == 0) PG8_BAR;
    PG8_BAR;
#undef PG8_SA
#undef PG8_SB
#undef PG8_STAGE
#undef PG8_LDA
#undef PG8_LDB
#undef PG8_MMA
#undef PG8_WAIT_V
#undef PG8_WAIT_L
#undef PG8_BAR
#undef PG8_SCHED
}
}

struct GemmDesc { const bf16_t* A; const bf16_t* Bt; int M, N, K; int kind; bf16_t* O; float* X; int ldc; int diag; int smode; };

struct Seg { const float* src; bf16_t* dst; const float* gain; int K, ldw, c0, ncols, rep, cstride, dstride, nitems; };
constexpr int NSEG = 37;

__device__ __forceinline__ void set_seg(LAS Seg* s, const float* src, bf16_t* dst, int K, int ldw, int c0, int ncols, int rep = 1, int cstride = 0, int dstride = 0, const float* gain = nullptr) {
    { int z = 0; asm volatile("" : "+v"(z)); K += z; ldw += z; c0 += z; ncols += z; rep += z; cstride += z; dstride += z; }
    { unsigned long long u0 = (unsigned long long)src, u1 = (unsigned long long)dst, u2 = (unsigned long long)gain; asm volatile("" : "+v"(u0), "+v"(u1), "+v"(u2));
      src = (const float*)u0; dst = (bf16_t*)u1; gain = (const float*)u2; }
    s->src = src; s->dst = dst; s->gain = gain; s->K = K; s->ldw = ldw; s->c0 = c0; s->ncols = ncols; s->rep = rep; s->cstride = cstride; s->dstride = dstride; s->nitems = (K / 64) * (ncols / 64) * rep;
}
__device__ void build_segs(const Params& p, LAS Seg* sg) {
    unsigned char* ws = p.ws; int n = 0;
    for (int i = 0; i < 4; ++i) {
        set_seg(sg + n++, p.in[I_WUP] + (size_t)i * 2048 * 11264, (bf16_t*)(ws + W_UP) + (size_t)i * 11264 * 2048, 2048, 11264, 0, 128, 44, 128, 256, p.in[I_FFN_NORM] + i * 2048);
        set_seg(sg + n++, p.in[I_WUP] + (size_t)i * 2048 * 11264, (bf16_t*)(ws + W_UP) + (size_t)i * 11264 * 2048 + (size_t)128 * 2048, 2048, 11264, 5632, 128, 44, 128, 256, p.in[I_FFN_NORM] + i * 2048);
        set_seg(sg + n++, p.in[I_WDOWN] + (size_t)i * 5632 * 2048, (bf16_t*)(ws + W_DOWN) + (size_t)i * 2048 * 5632, 5632, 2048, 0, 2048);
    }
    set_seg(sg + n++, p.in[I_SB_IN], (bf16_t*)(ws + W_SB_IN1), 2048, 6656, 0, 4096, 1, 0, 0, p.in[I_ATTN_NORM] + 0 * 2048);
    set_seg(sg + n++, p.in[I_SB_IN], (bf16_t*)(ws + W_SB_IN1) + (size_t)4096 * 2048, 2048, 6656, 6144, 512, 1, 0, 0, p.in[I_ATTN_NORM] + 0 * 2048);
    set_seg(sg + n++, p.in[I_SB_IN], (bf16_t*)(ws + W_SB_V), 2048, 6656, 4096, 2048, 1, 0, 0, p.in[I_ATTN_NORM] + 0 * 2048);
    set_seg(sg + n++, p.in[I_SB_OUT], (bf16_t*)(ws + W_SB_OUT), 2560, 2048, 0, 2048);
    set_seg(sg + n++, p.in[I_FOX_IN], (bf16_t*)(ws + W_FOX_IN1), 2048, 6672, 0, 4096, 1, 0, 0, p.in[I_ATTN_NORM] + 1 * 2048);
    set_seg(sg + n++, p.in[I_FOX_IN], (bf16_t*)(ws + W_FOX_IN1) + (size_t)4096 * 2048, 2048, 6672, 6160, 512, 1, 0, 0, p.in[I_ATTN_NORM] + 1 * 2048);
    set_seg(sg + n++, p.in[I_FOX_IN], (bf16_t*)(ws + W_FOX_V), 2048, 6672, 4096, 2048, 1, 0, 0, p.in[I_ATTN_NORM] + 1 * 2048);
    set_seg(sg + n++, p.in[I_FOX_OUT], (bf16_t*)(ws + W_FOX_OUT), 2560, 2048, 0, 2048);
    set_seg(sg + n++, p.in[I_SWA_IN], (bf16_t*)(ws + W_SWA_IN1), 2048, 3072, 0, 2304, 1, 0, 0, p.in[I_ATTN_NORM] + 2 * 2048);
    set_seg(sg + n++, p.in[I_SWA_IN], (bf16_t*)(ws + W_SWA_IN1) + (size_t)2304 * 2048, 2048, 3072, 2560, 512, 1, 0, 0, p.in[I_ATTN_NORM] + 2 * 2048);
    set_seg(sg + n++, p.in[I_SWA_IN], (bf16_t*)(ws + W_SWA_V), 2048, 3072, 2304, 256, 1, 0, 0, p.in[I_ATTN_NORM] + 2 * 2048);
    set_seg(sg + n++, p.in[I_SWA_OUT], (bf16_t*)(ws + W_SWA_OUT), 2560, 2048, 0, 2048);
    set_seg(sg + n++, p.in[I_MLA_IN], (bf16_t*)(ws + W_MLA_IN), 2048, 1344, 0, 1344, 1, 0, 0, p.in[I_ATTN_NORM] + 3 * 2048);
    set_seg(sg + n++, p.in[I_MLA_UQ], (bf16_t*)(ws + W_MLA_UQ), 512, 3072, 0, 3072);
    set_seg(sg + n++, p.in[I_MLA_UKV], (bf16_t*)(ws + W_MLA_KN), 256, 4096, 0, 128, 16, 256, 128);
    set_seg(sg + n++, p.in[I_MLA_UKV], (bf16_t*)(ws + W_MLA_V), 256, 4096, 128, 128, 16, 256, 128);
    set_seg(sg + n++, p.in[I_MLA_OUT], (bf16_t*)(ws + W_MLA_OUT), 2560, 2048, 0, 2048);
    for (int i = 0; i < 4; ++i) {
        set_seg(sg + n++, p.in[I_WMEMKV] + (size_t)i * 2048 * 1024, (bf16_t*)(ws + W_MEMK) + (size_t)i * 512 * 2048, 2048, 1024, 0, 512);
        set_seg(sg + n++, p.in[I_WMEMKV] + (size_t)i * 2048 * 1024, (bf16_t*)(ws + W_MEMV) + (size_t)i * 512 * 2048, 2048, 1024, 512, 512);
    }
}

__device__ __forceinline__ void transpose_item(const float* W, int ldw, int K, int c0, bf16_t* WT, int item, int nblk, LAS float* scr, int lane, const float* gain, bool nt) {
    const int kb = item / nblk, nb = item % nblk, k0 = 64 * kb, n0 = 64 * nb;
    const float* src = W + (size_t)(k0 + (lane >> 4)) * ldw + c0 + n0 + (lane & 15) * 4;
    f32x4 v[16];
#pragma unroll
    for (int j = 0; j < 16; ++j) v[j] = __builtin_nontemporal_load((const f32x4*)(src + (size_t)(4 * j) * ldw));
    if (gain) {
#pragma unroll
        for (int j = 0; j < 16; ++j) v[j] = v[j] * gain[k0 + 4 * j + (lane >> 4)];
    }
#pragma unroll
    for (int j = 0; j < 16; ++j) { LAS float* d = scr + (4 * j + (lane >> 4)) * 65 + (lane & 15) * 4; d[0] = v[j].x; d[1] = v[j].y; d[2] = v[j].z; d[3] = v[j].w; }
    asm volatile("s_waitcnt lgkmcnt(0)" ::: "memory");
    const int c = lane & 7;
#pragma unroll
    for (int j = 0; j < 8; ++j) { const int n = (lane >> 3) + 8 * j; const LAS float* sp = scr + (8 * c) * 65 + n;
        u32x4 o; o.x = cvt_pk_bf16(sp[0 * 65], sp[1 * 65]); o.y = cvt_pk_bf16(sp[2 * 65], sp[3 * 65]); o.z = cvt_pk_bf16(sp[4 * 65], sp[5 * 65]); o.w = cvt_pk_bf16(sp[6 * 65], sp[7 * 65]);
        u32x4* dp = (u32x4*)(WT + (size_t)(n0 + n) * K + k0 + 8 * c);
        if (nt) __builtin_nontemporal_store(o, dp); else *dp = o; }
    asm volatile("s_waitcnt lgkmcnt(0)" ::: "memory");
}

__device__ __forceinline__ void rms_row_bf16(const float* xrow, const float* g, bf16_t* orow, float* xcopy, int lane, f32x4 (&y)[8]) {
    const f32x4* xr = (const f32x4*)xrow + lane; float ss = 0.f;
#pragma unroll
    for (int j = 0; j < 8; ++j) { y[j] = xr[64 * j]; ss += (y[j].x * y[j].x + y[j].y * y[j].y) + (y[j].z * y[j].z + y[j].w * y[j].w); }
    if (xcopy) {
#pragma unroll
        for (int j = 0; j < 8; ++j) ((f32x4*)xcopy + lane)[64 * j] = y[j];
    }
    const float rs = rsqrtf(wave_sum(ss) * (1.f / 2048.f) + 1e-6f);
    const f32x4* gr = (const f32x4*)g + lane; u32x2* o8 = (u32x2*)orow + lane;
#pragma unroll
    for (int j = 0; j < 8; ++j) { const f32x4 gg = gr[64 * j]; y[j] = (y[j] * rs) * gg; u32x2 w; w.x = cvt_pk_bf16(y[j].x, y[j].y); w.y = cvt_pk_bf16(y[j].z, y[j].w); o8[64 * j] = w; }
}

__device__ void phase_conv(const Params& p, LAS unsigned char* lds) {
    LAS Seg* sg = (LAS Seg*)lds;
    const int tid = otid(), wave = tid >> 6, lane = tid & 63;
    if (tid == 0) build_segs(p, sg);
    __syncthreads();
    LAS float* scr = (LAS float*)(lds + 4096 + wave * 16640);
    const int gw = blockIdx.x * NWAVE + wave, NGW = gridDim.x * NWAVE;
    int total = 0;
    for (int s = 0; s < NSEG; ++s) total += sg[s].nitems;
    for (int it = gw; it < total; it += NGW) {
        int r = it, s = 0;
        while (r >= sg[s].nitems) { r -= sg[s].nitems; ++s; }
        const int K = sg[s].K, nblk = sg[s].ncols / 64, per = (K / 64) * nblk, ri = r / per, within = r - ri * per;
        const size_t doff = (size_t)((const unsigned char*)sg[s].dst - p.ws);
        const bool keep = (doff >= W_SB_IN1 && doff < W_FOX_IN1) || (doff >= W_MEMK && doff < W_UP + (size_t)11264 * 2048 * 2) || (doff >= W_DOWN && doff < W_DOWN + (size_t)2048 * 5632 * 2);
        transpose_item(sg[s].src, sg[s].ldw, K, sg[s].c0 + ri * sg[s].cstride, sg[s].dst + (size_t)ri * sg[s].dstride * K, within, nblk, scr, lane, sg[s].gain, !keep);
    }
    for (int rt = gw; rt < 2048; rt += NGW) {
        const int l = rt >> 9, r = rt & 511; f32x4 y[8];
        rms_row_bf16(p.in[I_MEM] + (size_t)r * 2048, p.in[I_MEM_NORM] + l * 2048, (bf16_t*)(p.ws + OFF_MEMH) + (size_t)rt * 2048, nullptr, lane, y);
    }
    const int gt = blockIdx.x * NTHR + tid, NT = gridDim.x * NTHR;
    for (int i = gt; i < 32 * 128; i += NT) {
        const int h = i >> 7, dist = i & 127; int bucket;
        if (dist < 16) bucket = dist;
        else { const float d = (float)dist; int large = 16 + (int)(logf(d / 16.f) / 2.0794415416798357f * 16.f); bucket = large < 31 ? large : 31; }
        ((float*)(p.ws + OFF_BIAST))[i] = p.in[I_RELB][bucket * 32 + h];
    }
    for (int i = gt; i < 16 * 2048; i += NT) { const int j = i >> 11, k = i & 2047; ((float*)(p.ws + OFF_WF))[i] = p.in[I_FOX_IN][(size_t)k * 6672 + 6144 + j]; }
    for (int i = gt; i < 192 * 2048 / 8; i += NT) ((u32x4*)((bf16_t*)(p.ws + W_MLA_IN) + (size_t)1344 * 2048))[i] = (u32x4){0u, 0u, 0u, 0u};
}

__device__ void phase_norm(const Params& p, const float* xin, const float* g, int mode) {
    const int tid = otid(), wave = tid >> 6, lane = tid & 63;
    const int gw = blockIdx.x * NWAVE + wave, NGW = gridDim.x * NWAVE;
    for (int row = gw; row < T; row += NGW) {
        f32x4 y[8]; float ss = 0.f;
        u32x2* h8 = (u32x2*)((bf16_t*)(p.ws + OFF_H) + (size_t)row * 2048) + lane; u32x2* l8 = (u32x2*)((bf16_t*)(p.ws + OFF_XR) + (size_t)row * 2048) + lane;
        if (mode == 1) {
            const f32x4* xr = (const f32x4*)(xin + (size_t)row * 2048) + lane;
#pragma unroll
            for (int j = 0; j < 8; ++j) y[j] = xr[64 * j];
        } else {
#pragma unroll
            for (int j = 0; j < 8; ++j) { const u32x2 a = h8[64 * j], b = l8[64 * j]; y[j] = (f32x4){bf_lo(a.x) + bf_lo(b.x), bf_hi(a.x) + bf_hi(b.x), bf_lo(a.y) + bf_lo(b.y), bf_hi(a.y) + bf_hi(b.y)}; }
        }
#pragma unroll
        for (int j = 0; j < 8; ++j) ss += (y[j].x * y[j].x + y[j].y * y[j].y) + (y[j].z * y[j].z + y[j].w * y[j].w);
        ss = wave_sum(ss);
        if (mode == 1) {
#pragma unroll
            for (int j = 0; j < 8; ++j) { u32x2 w; w.x = cvt_pk_bf16(y[j].x, y[j].y); w.y = cvt_pk_bf16(y[j].z, y[j].w); h8[64 * j] = w;
                u32x2 wl; wl.x = cvt_pk_bf16(y[j].x - bf_lo(w.x), y[j].y - bf_hi(w.x)); wl.y = cvt_pk_bf16(y[j].z - bf_lo(w.y), y[j].w - bf_hi(w.y)); l8[64 * j] = wl; }
            if (lane < 32) ((float*)(p.ws + OFF_SSQ))[(size_t)row * 32 + lane] = lane == 0 ? ss : 0.f;
            continue;
        }
        const float rs = rsqrtf(ss * (1.f / 2048.f) + 1e-6f);
        const f32x4* gr = (const f32x4*)g + lane;
        if (mode == 3) {
            f32x4* o = (f32x4*)(p.out + (size_t)row * 2048) + lane;
#pragma unroll
            for (int j = 0; j < 8; ++j) o[64 * j] = (y[j] * rs) * gr[64 * j];
            continue;
        }
#pragma unroll
        for (int j = 0; j < 8; ++j) y[j] = (y[j] * rs) * gr[64 * j];
        const float* wf = (const float*)(p.ws + OFF_WF);
        float mine = 0.f;
#pragma unroll 1
        for (int jf = 0; jf < 16; ++jf) {
            const f32x4* wr_ = (const f32x4*)(wf + jf * 2048) + lane; float d = 0.f;
#pragma unroll
            for (int j = 0; j < 8; ++j) { const f32x4 w = wr_[64 * j]; d += (y[j].x * w.x + y[j].y * w.y) + (y[j].z * w.z + y[j].w * w.w); }
            d = wave_sum(d);
            if (lane == jf) mine = d;
        }
        if (lane < 16) { const float xv = mine + p.in[I_FOX_BF][lane]; const float ls = fminf(xv, 0.f) - __logf(1.f + __expf(-fabsf(xv))); ((float*)(p.ws + OFF_LF))[(size_t)row * 16 + lane] = ls; }
    }
}

__device__ void fox_scan(const Params& p, LAS unsigned char* lds) {
    LAS float* sh = (LAS float*)lds; const int tid = otid();
    for (int bh = blockIdx.x; bh < 32; bh += gridDim.x) {
        const int bb = bh >> 4, head = bh & 15; const float* lf = (const float*)(p.ws + OFF_LF); float* lfc = (float*)(p.ws + OFF_LFC) + (size_t)bh * 4096;
        float v[8]; float run = 0.f;
#pragma unroll
        for (int e = 0; e < 8; ++e) { run += lf[(size_t)(bb * 4096 + tid * 8 + e) * 16 + head]; v[e] = run; }
        sh[tid] = run; __syncthreads();
        for (int off = 1; off < 512; off <<= 1) { float x = sh[tid]; if (tid >= off) x += sh[tid - off]; __syncthreads(); sh[tid] = x; __syncthreads(); }
        const float excl = sh[tid] - run;
#pragma unroll
        for (int e = 0; e < 8; ++e) lfc[tid * 8 + e] = excl + v[e];
        __syncthreads();
    }
}

__device__ void ffn_fixup(const Params& p, int layer, int pm) {
    const bf16_t* us = (const bf16_t*)(p.ws + OFF_U); bf16_t* g = (bf16_t*)(p.ws + OFF_G);
    const float* cw = p.in[I_CONVW] + (size_t)layer * 3 * 11264; const float* cb = p.in[I_CONVB] + (size_t)layer * 11264;
    constexpr int NCH = DFF / 8;
    for (int item = otid(); item < 8 * NCH; item += NTHR) {
        const int ri = item / NCH, chunk = item - ri * NCH, c = chunk * 8, w = ri & 1, t = pm * 256 + (ri >> 1) * 64 + w, blk = t >> 6, tl = t & (SEQ - 1);
        const bf16_t* r0 = us + ((size_t)blk * 4 + w) * 11264 + c;
        const bf16_t* r1 = w == 1 ? us + ((size_t)blk * 4 + 0) * 11264 + c : us + ((size_t)(blk - 1) * 4 + 3) * 11264 + c;
        const bf16_t* r2 = w == 1 ? us + ((size_t)(blk - 1) * 4 + 3) * 11264 + c : us + ((size_t)(blk - 1) * 4 + 2) * 11264 + c;
        const bool has1 = tl >= 1, has2 = tl >= 2;
        const u32x4 z4 = (u32x4){0u, 0u, 0u, 0u};
        const u32x4 a0 = *(const u32x4*)r0, b0 = *(const u32x4*)(r0 + DFF);
        const u32x4 a1 = has1 ? *(const u32x4*)r1 : z4, b1 = has1 ? *(const u32x4*)(r1 + DFF) : z4;
        const u32x4 a2 = has2 ? *(const u32x4*)r2 : z4, b2 = has2 ? *(const u32x4*)(r2 + DFF) : z4;
        float o[8];
#pragma unroll
        for (int e = 0; e < 8; ++e) {
            const int q = e >> 1; const bool hi = e & 1;
            const float g0 = hi ? bf_hi(a0[q]) : bf_lo(a0[q]), g1 = hi ? bf_hi(a1[q]) : bf_lo(a1[q]), g2 = hi ? bf_hi(a2[q]) : bf_lo(a2[q]);
            const float v0 = hi ? bf_hi(b0[q]) : bf_lo(b0[q]), v1 = hi ? bf_hi(b1[q]) : bf_lo(b1[q]), v2 = hi ? bf_hi(b2[q]) : bf_lo(b2[q]);
            const float cg = cb[c + e] + cw[c + e] * g2 + cw[11264 + c + e] * g1 + cw[22528 + c + e] * g0;
            const float cv = cb[DFF + c + e] + cw[DFF + c + e] * v2 + cw[11264 + DFF + c + e] * v1 + cw[22528 + DFF + c + e] * v0;
            o[e] = cg / (1.f + __expf(-cg)) * cv;
        }
        u32x4 wv; wv.x = cvt_pk_bf16(o[0], o[1]); wv.y = cvt_pk_bf16(o[2], o[3]); wv.z = cvt_pk_bf16(o[4], o[5]); wv.w = cvt_pk_bf16(o[6], o[7]);
        *(u32x4*)(g + (size_t)t * DFF + c) = wv;
    }
}

__device__ void phase_mla_mid(const Params& p) {
    const int tid = otid(), wave = tid >> 6, lane = tid & 63;
    const int gw = blockIdx.x * NWAVE + wave, NGW = gridDim.x * NWAVE;
    const bf16_t* pr = (const bf16_t*)(p.ws + OFF_PROJ);
    for (int row = gw; row < T; row += NGW) {
        const bf16_t* rp = pr + (size_t)row * 1536;
        { const u32x4 a = *(const u32x4*)(rp + lane * 8); float v[8];
#pragma unroll
          for (int e = 0; e < 4; ++e) { v[2 * e] = bf_lo(a[e]); v[2 * e + 1] = bf_hi(a[e]); }
          float ss = 0.f;
#pragma unroll
          for (int e = 0; e < 8; ++e) ss += v[e] * v[e];
          const float rs = rsqrtf(wave_sum(ss) * (1.f / 512.f) + 1e-6f);
          const f32x4 g0 = *(const f32x4*)(p.in[I_MLA_QN] + lane * 8), g1 = *(const f32x4*)(p.in[I_MLA_QN] + lane * 8 + 4);
          u32x4 w; w.x = cvt_pk_bf16(v[0] * rs * g0[0], v[1] * rs * g0[1]); w.y = cvt_pk_bf16(v[2] * rs * g0[2], v[3] * rs * g0[3]);
          w.z = cvt_pk_bf16(v[4] * rs * g1[0], v[5] * rs * g1[1]); w.w = cvt_pk_bf16(v[6] * rs * g1[2], v[7] * rs * g1[3]);
          *(u32x4*)((bf16_t*)(p.ws + OFF_CQN) + (size_t)row * 512 + lane * 8) = w; }
        { const u32x2 a = *(const u32x2*)(rp + 512 + lane * 4); float v[4] = {bf_lo(a.x), bf_hi(a.x), bf_lo(a.y), bf_hi(a.y)};
          const float ss = v[0] * v[0] + v[1] * v[1] + v[2] * v[2] + v[3] * v[3];
          const float rs = rsqrtf(wave_sum(ss) * (1.f / 256.f) + 1e-6f);
          const f32x4 g0 = *(const f32x4*)(p.in[I_MLA_KVN] + lane * 4);
          u32x2 w; w.x = cvt_pk_bf16(v[0] * rs * g0[0], v[1] * rs * g0[1]); w.y = cvt_pk_bf16(v[2] * rs * g0[2], v[3] * rs * g0[3]);
          *(u32x2*)((bf16_t*)(p.ws + OFF_CKVN) + (size_t)row * 256 + lane * 4) = w; }
        if (lane < 32) {
            const float x1 = __uint_as_float((unsigned)rp[768 + lane] << 16), x2 = __uint_as_float((unsigned)rp[800 + lane] << 16);
            const float pos = (float)((const int*)p.in[I_POS])[row]; float s, c; sincos_big(pos * rope_inv_freq(lane), s, c);
            bf16_t* ko = (bf16_t*)(p.ws + OFF_KPE) + (size_t)row * 64;
            const unsigned w = cvt_pk_bf16(x1 * c - x2 * s, x2 * c + x1 * s);
            ko[lane] = (bf16_t)(w & 0xffffu); ko[32 + lane] = (bf16_t)(w >> 16);
        }
    }
}

struct AttnArgs {
    const bf16_t* q; int ldq, qoff;
    const bf16_t* k; int ldk, koff;
    const bf16_t* k2;
    const bf16_t* vt; int ldvt, vrow0, vcol_base;
    int qrow_base, krow_base;
    bf16_t* o; int ocol;
    int q0;
    const float* lfc; const float* biasrow; float sink; const int* pos;
    float scale;
};

#ifndef NQB_SB
#define NQB_SB 2
#endif
#ifndef NQB_FOX
#define NQB_FOX 2
#endif
#ifndef NQB_SWA
#define NQB_SWA 2
#endif
#ifndef NQB_MLA
#define NQB_MLA 2
#endif
#ifndef NQB_MEM
#define NQB_MEM 1
#endif
template <int MODE, int NQB, int NNB, bool MASKED>
__device__ __forceinline__ void att_scores(f32x4 (&st)[4][NQB], f32x4 (&oacc)[NNB][NQB], float (&mrun)[NQB], float (&lsum)[NQB], float (&carry)[NQB], const float (&ct)[NQB],
                                           int wr0, int r, int quad, int kt, float scale2, LAS unsigned char* tbl) {
    const int key0 = kt * 64 + quad * 4;
#pragma unroll
    for (int qb = 0; qb < NQB; ++qb) {
        const int t = wr0 + qb * 16 + r;
        if (MODE == 0) {
            float gprod[4];
#pragma unroll
            for (int kb = 0; kb < 4; ++kb) {
                float pe = 1.f;
#pragma unroll
                for (int j = 3; j >= 0; --j) {
                    const float u = __builtin_amdgcn_fmed3f(st[kb][qb][j] * scale2, -115.f, 115.f);
                    const float e = fast_exp2(u);
                    float beta = __builtin_amdgcn_rcpf(1.f + e), omb = e * beta;
                    if (MASKED) { const bool valid = (key0 + kb * 16 + j) < t; beta = valid ? beta : 0.f; omb = valid ? omb : 1.f; }
                    st[kb][qb][j] = beta * pe;
                    pe *= omb;
                }
                gprod[kb] = pe;
            }
            float Hh[4], Tt[4];
#pragma unroll
            for (int kb = 0; kb < 4; ++kb) {
                const float g0 = gprod[kb], g1 = __shfl_xor(g0, 16), g2 = __shfl_xor(g0, 32), g3 = __shfl_xor(g0, 48);
                Tt[kb] = (g0 * g1) * (g2 * g3);
                Hh[kb] = (((quad ^ 1) > quad) ? g1 : 1.f) * (((quad ^ 2) > quad) ? g2 : 1.f) * (((quad ^ 3) > quad) ? g3 : 1.f);
            }
            float Bs = carry[qb];
#pragma unroll
            for (int kb = 3; kb >= 0; --kb) {
                const float mul = Hh[kb] * Bs;
#pragma unroll
                for (int j = 0; j < 4; ++j) st[kb][qb][j] *= mul;
                Bs *= Tt[kb];
            }
            carry[qb] = Bs;
        } else {
            float mx = -INFINITY;
#pragma unroll
            for (int kb = 0; kb < 4; ++kb) {
                f32x4 cs = (f32x4){0.f, 0.f, 0.f, 0.f};
                if (MODE == 1) cs = *(const LAS f32x4*)(tbl + (kt * 64 + kb * 16 + quad * 4) * 4);
#pragma unroll
                for (int j = 0; j < 4; ++j) {
                    const int key = key0 + kb * 16 + j;
                    float v = st[kb][qb][j] * scale2;
                    if (MODE == 1) v += ct[qb] - cs[j];
                    if (MODE == 2) { const int dist = t - key; const bool valid = dist >= 0 && dist < 128; const int di = dist < 0 ? 0 : (dist > 127 ? 127 : dist); v += ((const LAS float*)tbl)[di]; v = valid ? v : -INFINITY; }
                    else if (MASKED) v = (key <= t) ? v : -INFINITY;
                    st[kb][qb][j] = v; mx = fmaxf(mx, v);
                }
            }
            mx = fmaxf(mx, __shfl_xor(mx, 16)); mx = fmaxf(mx, __shfl_xor(mx, 32));
            const float m_old = mrun[qb], m_new = fmaxf(m_old, mx), m_use = (m_new == -INFINITY) ? 0.f : m_new;
            const float alpha = fast_exp2(m_old - m_use);
            mrun[qb] = m_new;
            float ps = 0.f;
#pragma unroll
            for (int kb = 0; kb < 4; ++kb)
#pragma unroll
                for (int j = 0; j < 4; ++j) { const float pv = fast_exp2(st[kb][qb][j] - m_use); st[kb][qb][j] = pv; ps += pv; }
            lsum[qb] = lsum[qb] * alpha + ps;
            if (RESCALE_ALWAYS || __builtin_amdgcn_ballot_w64(m_new != m_old) != 0ull) {
#pragma unroll
                for (int nb = 0; nb < NNB; ++nb) oacc[nb][qb] = oacc[nb][qb] * alpha;
            }
        }
    }
}

template <int MODE, int NQB>
__device__ __forceinline__ void attn_item(LAS unsigned char* lds, const AttnArgs& a) {
    constexpr int WROWS = 16 * NQB, QR = 128 * NQB;
    constexpr int DK = (MODE == 2) ? 64 : (MODE == 3 ? 192 : 128);
    constexpr int DV = (MODE == 2) ? 64 : 128;
    constexpr int NKK = DK / 32, NNB = DV / 16;
    constexpr int K128_BYTES = (MODE == 2) ? 0 : 16384;
    constexpr int K64_BYTES = (MODE == 2 || MODE == 3) ? 8192 : 0;
    constexpr int KT_BYTES = K128_BYTES + K64_BYTES, VT_BYTES = DV * 128, BUF_BYTES = KT_BYTES + VT_BYTES + 256;
    constexpr int NP128 = K128_BYTES / 8192, NPV = VT_BYTES / 8192;
    constexpr int NBUF = 3, TBL_OFF = NBUF * BUF_BYTES;
    constexpr int NDMA = NP128 + (K64_BYTES ? 1 : 0) + NPV;
    const int tid = otid(), wave = __builtin_amdgcn_readfirstlane(tid >> 6), lane = tid & 63, r = lane & 15, quad = lane >> 4;
    const int wr0 = a.q0 + wave * WROWS;
    int kt_hi, kt_lo, wkt_hi, wkt_lo;
    if (MODE == 4) { kt_lo = 0; kt_hi = 3; wkt_lo = 0; wkt_hi = 3; }
    else if (MODE == 2) { kt_hi = (a.q0 + QR - 1) >> 6; kt_lo = a.q0 >= 128 ? (a.q0 - 128) >> 6 : 0; wkt_hi = (wr0 + WROWS - 1) >> 6; wkt_lo = wr0 >= 127 ? (wr0 - 127) >> 6 : 0; }
    else { kt_hi = (a.q0 + QR - 1) >> 6; kt_lo = 0; wkt_hi = (wr0 + WROWS - 1) >> 6; wkt_lo = 0; }

    unsigned ko128[NP128 > 0 ? NP128 : 1], ko64 = 0, vo[NPV];
#pragma unroll
    for (int i = 0; i < NP128; ++i) { const int s = (wave + 8 * i) * 64 + lane, row = s >> 4, cp = s & 15, c = cp ^ (row & 15); ko128[i] = (unsigned)(row * a.ldk + c * 8) * 2u; }
    if (K64_BYTES) { const int s = wave * 64 + lane, row = s >> 3, cp = s & 7, c = cp ^ ((row >> 1) & 7); ko64 = (unsigned)(row * (MODE == 3 ? 64 : a.ldk) + c * 8) * 2u; }
#pragma unroll
    for (int i = 0; i < NPV; ++i) { const int s = (wave + 8 * i) * 64 + lane, row = s >> 3, cp = s & 7, c = cp ^ ((row >> 1) & 7); vo[i] = (unsigned)(row * a.ldvt + c * 8) * 2u; }
    const int x128 = quad ^ r, x64 = quad ^ (r >> 1), y0 = (quad >> 1) ^ (r >> 1);
    const int krd128 = r * 256, krd64 = r * 128, vrd = r * 128 + (quad & 1) * 8;

    bf16x8 qf[NQB][NKK];
#pragma unroll
    for (int qb = 0; qb < NQB; ++qb) {
        const int t = wr0 + qb * 16 + r;
        const bf16_t* qp = a.q + (size_t)(a.qrow_base + t) * a.ldq + a.qoff;
#pragma unroll
        for (int kk = 0; kk < (MODE == 3 ? 4 : NKK); ++kk) qf[qb][kk] = *(const bf16x8*)(qp + kk * 32 + quad * 8);
        if (MODE == 3) {
            const bf16x8 c1 = *(const bf16x8*)(qp + 128 + quad * 8), c2 = *(const bf16x8*)(qp + 160 + quad * 8);
            const float pos = (float)a.pos[t];
            bf16x8 o1, o2;
#pragma unroll
            for (int e = 0; e < 8; e += 2) {
                float s0, c0, s1, cc1; sincos_big(pos * rope_inv_freq(quad * 8 + e), s0, c0); sincos_big(pos * rope_inv_freq(quad * 8 + e + 1), s1, cc1);
                const float x10 = __uint_as_float((unsigned)(unsigned short)c1[e] << 16), x20 = __uint_as_float((unsigned)(unsigned short)c2[e] << 16);
                const float x11 = __uint_as_float((unsigned)(unsigned short)c1[e + 1] << 16), x21 = __uint_as_float((unsigned)(unsigned short)c2[e + 1] << 16);
                const unsigned wa = cvt_pk_bf16(x10 * c0 - x20 * s0, x11 * cc1 - x21 * s1), wb = cvt_pk_bf16(x20 * c0 + x10 * s0, x21 * cc1 + x11 * s1);
                o1[e] = (short)(wa & 0xffffu); o1[e + 1] = (short)(wa >> 16); o2[e] = (short)(wb & 0xffffu); o2[e + 1] = (short)(wb >> 16);
            }
            qf[qb][NKK - 2] = o1; qf[qb][NKK - 1] = o2;
        }
    }
    f32x4 oacc[NNB][NQB];
#pragma unroll
    for (int nb = 0; nb < NNB; ++nb)
#pragma unroll
        for (int qb = 0; qb < NQB; ++qb) oacc[nb][qb] = (f32x4){0.f, 0.f, 0.f, 0.f};
    float mrun[NQB], lsum[NQB], carry[NQB], ct[NQB];
#pragma unroll
    for (int qb = 0; qb < NQB; ++qb) {
        mrun[qb] = (MODE == 2) ? a.sink * LOG2E : -INFINITY; lsum[qb] = (MODE == 2 && quad == 0) ? 1.f : 0.f; carry[qb] = 1.f;
        ct[qb] = (MODE == 1) ? a.lfc[wr0 + qb * 16 + r] * LOG2E : 0.f;
    }
    if (MODE == 2) { if (tid < 128) ((LAS float*)(lds + TBL_OFF))[tid] = a.biasrow[tid] * LOG2E; }
    const float scale2 = (MODE == 0) ? -a.scale * LOG2E : a.scale * LOG2E;

    const char* kbase = (const char*)(a.k + (size_t)a.krow_base * a.ldk + a.koff);
    const char* k2base = (MODE == 3) ? (const char*)(a.k2 + (size_t)a.krow_base * 64) : kbase;
    const char* vbase = (const char*)(a.vt + (size_t)a.vrow0 * a.ldvt + a.vcol_base);
#define ATT_DMA(kt_, buf_) do { LAS unsigned char* bp = lds + (buf_) * BUF_BYTES + wave * 1024; \
        const char* kg = kbase + (size_t)(kt_) * 64 * a.ldk * 2; \
        _Pragma("unroll") for (int i = 0; i < NP128; ++i) __builtin_amdgcn_global_load_lds((const unsigned*)(kg + ko128[i]), (LAS unsigned*)(bp + i * 8192), 16, 0, 0); \
        if (K64_BYTES) { const char* k2g = (MODE == 3) ? k2base + (size_t)(kt_) * 64 * 64 * 2 : kg; \
            __builtin_amdgcn_global_load_lds((const unsigned*)(k2g + ko64), (LAS unsigned*)(bp + K128_BYTES), 16, 0, 0); } \
        const char* vg = vbase + (size_t)(kt_) * 64 * 2; \
        _Pragma("unroll") for (int i = 0; i < NPV; ++i) __builtin_amdgcn_global_load_lds((const unsigned*)(vg + vo[i]), (LAS unsigned*)(bp + KT_BYTES + i * 8192), 16, 0, 0); \
    } while (0)
#define ATT_WAIT_TILE(more_) do { if (more_) { if (NDMA == 2) asm volatile("s_waitcnt vmcnt(2) lgkmcnt(0)" ::: "memory"); else if (NDMA == 4) asm volatile("s_waitcnt vmcnt(4) lgkmcnt(0)" ::: "memory"); \
            else asm volatile("s_waitcnt vmcnt(5) lgkmcnt(0)" ::: "memory"); } else asm volatile("s_waitcnt vmcnt(0) lgkmcnt(0)" ::: "memory"); \
        __builtin_amdgcn_s_barrier(); asm volatile("" ::: "memory"); } while (0)

    const int n_tiles = kt_hi - kt_lo + 1;
    if (MODE == 1) { const int n4 = (a.q0 + QR) >> 2; for (int i = tid; i < n4; i += NTHR) *(LAS f32x4*)(lds + TBL_OFF + i * 16) = *(const f32x4*)(a.lfc + i * 4) * LOG2E; }
    asm volatile("s_waitcnt vmcnt(0)" ::: "memory");
    ATT_DMA(kt_hi, 0);
    if (n_tiles > 1) ATT_DMA(kt_hi - 1, 1);
    ATT_WAIT_TILE(n_tiles > 1);
    int cur = 0;
    for (int it = 0; it < n_tiles; ++it) {
        const int kt = kt_hi - it;
        if (it + 2 < n_tiles) { const int b2 = cur + 2 >= NBUF ? cur + 2 - NBUF : cur + 2; ATT_DMA(kt - 2, b2); }
        if (kt >= wkt_lo && kt <= wkt_hi) {
            LAS unsigned char* kbuf = lds + cur * BUF_BYTES; LAS unsigned char* vbuf = kbuf + KT_BYTES;
            f32x4 st[4][NQB];
#pragma unroll
            for (int kb = 0; kb < 4; ++kb)
#pragma unroll
                for (int qb = 0; qb < NQB; ++qb) st[kb][qb] = (f32x4){0.f, 0.f, 0.f, 0.f};
#pragma unroll
            for (int kb = 0; kb < 4; ++kb) {
#pragma unroll
                for (int kk = 0; kk < NKK; ++kk) {
                    bf16x8 af;
                    if (MODE == 2) af = *(const LAS bf16x8*)(kbuf + kb * 2048 + krd64 + ((x64 ^ (kk * 4)) * 16));
                    else if (MODE == 3 && kk >= 4) af = *(const LAS bf16x8*)(kbuf + K128_BYTES + kb * 2048 + krd64 + ((x64 ^ ((kk - 4) * 4)) * 16));
                    else af = *(const LAS bf16x8*)(kbuf + kb * 4096 + krd128 + ((x128 ^ (kk * 4)) * 16));
#pragma unroll
                    for (int qb = 0; qb < NQB; ++qb) st[kb][qb] = __builtin_amdgcn_mfma_f32_16x16x32_bf16(af, qf[qb][kk], st[kb][qb], 0, 0, 0);
                }
            }
            const bool need_mask = (MODE == 2) ? true : (MODE == 4) ? false : (kt * 64 + 63 >= wr0);
            if (need_mask) att_scores<MODE, NQB, NNB, true>(st, oacc, mrun, lsum, carry, ct, wr0, r, quad, kt, scale2, lds + TBL_OFF);
            else att_scores<MODE, NQB, NNB, false>(st, oacc, mrun, lsum, carry, ct, wr0, r, quad, kt, scale2, lds + TBL_OFF);
#pragma unroll
            for (int k2 = 0; k2 < 2; ++k2) {
                bf16x8 pf[NQB];
#pragma unroll
                for (int qb = 0; qb < NQB; ++qb) {
                    u32x4 w; w.x = cvt_pk_bf16(st[2 * k2][qb][0], st[2 * k2][qb][1]); w.y = cvt_pk_bf16(st[2 * k2][qb][2], st[2 * k2][qb][3]);
                    w.z = cvt_pk_bf16(st[2 * k2 + 1][qb][0], st[2 * k2 + 1][qb][1]); w.w = cvt_pk_bf16(st[2 * k2 + 1][qb][2], st[2 * k2 + 1][qb][3]);
                    pf[qb] = __builtin_bit_cast(bf16x8, w);
                }
                const int vlo = vrd + ((y0 ^ (k2 * 4)) * 16), vhi = vrd + (((y0 ^ 2) ^ (k2 * 4)) * 16);
#pragma unroll
                for (int nb = 0; nb < NNB; ++nb) {
                    const u32x2 lo = *(const LAS u32x2*)(vbuf + nb * 2048 + vlo), hi = *(const LAS u32x2*)(vbuf + nb * 2048 + vhi);
                    const bf16x8 vf = __builtin_bit_cast(bf16x8, (u32x4){lo.x, lo.y, hi.x, hi.y});
#pragma unroll
                    for (int qb = 0; qb < NQB; ++qb) oacc[nb][qb] = __builtin_amdgcn_mfma_f32_16x16x32_bf16(vf, pf[qb], oacc[nb][qb], 0, 0, 0);
                }
            }
        }
        ATT_WAIT_TILE(it + 2 < n_tiles);
        cur = cur + 1 == NBUF ? 0 : cur + 1;
    }
#undef ATT_DMA
#undef ATT_WAIT_TILE
#pragma unroll
    for (int qb = 0; qb < NQB; ++qb) {
        float inv = 1.f;
        if (MODE != 0) { float l = lsum[qb]; l += __shfl_xor(l, 16); l += __shfl_xor(l, 32); inv = 1.f / l; }
        const int t = wr0 + qb * 16 + r;
        bf16_t* op = a.o + (size_t)(a.qrow_base + t) * ATTW + a.ocol + quad * 4;
#pragma unroll
        for (int nb = 0; nb < NNB; ++nb) { const f32x4 v = oacc[nb][qb] * inv; u32x2 w; w.x = cvt_pk_bf16(v[0], v[1]); w.y = cvt_pk_bf16(v[2], v[3]); *(u32x2*)(op + nb * 16) = w; }
    }
}

__device__ __forceinline__ void mem_attn_item(const Params& p, LAS unsigned char* lds, int layer, int idx, const bf16_t* q, int ldq, int qoff) {
    constexpr int NQBLK = SEQ / (128 * NQB_MEM);
    const int qblk = idx % NQBLK, mh = (idx / NQBLK) & 3, b = idx / (4 * NQBLK);
    AttnArgs a;
    a.q = q; a.ldq = ldq; a.qoff = qoff + mh * 128;
    a.k = (const bf16_t*)(p.ws + OFF_MEMK); a.ldk = 2048; a.koff = layer * 512 + mh * 128; a.k2 = nullptr;
    a.vt = (const bf16_t*)(p.ws + OFF_MEMVT); a.ldvt = 2048; a.vrow0 = layer * 512 + mh * 128; a.vcol_base = layer * 512 + b * 256;
    a.qrow_base = b * SEQ; a.krow_base = layer * 512 + b * 256;
    a.o = (bf16_t*)(p.ws + OFF_ATT); a.ocol = 2048 + mh * 128; a.q0 = qblk * 128 * NQB_MEM;
    a.lfc = nullptr; a.biasrow = nullptr; a.sink = 0.f; a.pos = nullptr; a.scale = 0.08838834764831845f;
    attn_item<4, NQB_MEM>(lds, a);
}

__device__ void phase_attn(const Params& p, LAS unsigned char* lds, int layer) {
    const bf16_t* proj = (const bf16_t*)(p.ws + OFF_PROJ);
    if (layer == 2) {
        constexpr int NQBLK = SEQ / (128 * NQB_SWA);
        for (int idx = blockIdx.x; idx < 64 * NQBLK; idx += gridDim.x) {
            const int qblk = idx % NQBLK, head = (idx / NQBLK) & 31, b = idx / (32 * NQBLK), kvh = head >> 3;
            AttnArgs a;
            a.q = proj; a.ldq = 2816; a.qoff = head * 64;
            a.k = proj; a.ldk = 2816; a.koff = 2048 + kvh * 64; a.k2 = nullptr;
            a.vt = (const bf16_t*)(p.ws + OFF_VT); a.ldvt = T; a.vrow0 = kvh * 64; a.vcol_base = b * SEQ;
            a.qrow_base = b * SEQ; a.krow_base = b * SEQ;
            a.o = (bf16_t*)(p.ws + OFF_ATT); a.ocol = head * 64; a.q0 = qblk * 128 * NQB_SWA;
            a.lfc = nullptr; a.biasrow = (const float*)(p.ws + OFF_BIAST) + head * 128; a.sink = p.in[I_SWA_SINKS][head]; a.pos = nullptr; a.scale = 0.125f;
            attn_item<2, NQB_SWA>(lds, a);
        }
    } else {
        const int nqb = layer == 0 ? NQB_SB : layer == 1 ? NQB_FOX : NQB_MLA, NQBLK = SEQ / (128 * nqb);
        for (int ps = blockIdx.x; ps < 32 * (NQBLK / 2); ps += gridDim.x) {
            const int xcd = ps & 7, j = ps >> 3, combo = xcd * 4 + (j & 3), pair = j >> 2, b = combo >> 4, head = combo & 15;
            for (int s = 0; s < 2; ++s) {
                const int qblk = s == 0 ? NQBLK - 1 - pair : pair;
                AttnArgs a;
                a.vt = (const bf16_t*)(p.ws + OFF_VT); a.ldvt = T; a.vrow0 = head * 128; a.vcol_base = b * SEQ;
                a.qrow_base = b * SEQ; a.krow_base = b * SEQ;
                a.o = (bf16_t*)(p.ws + OFF_ATT); a.ocol = head * 128; a.q0 = qblk * 128 * nqb;
                a.lfc = nullptr; a.biasrow = nullptr; a.sink = 0.f; a.pos = nullptr; a.k2 = nullptr;
                if (layer == 3) {
                    a.q = (const bf16_t*)(p.ws + OFF_Q3); a.ldq = 3072; a.qoff = head * 192;
                    a.k = (const bf16_t*)(p.ws + OFF_KN); a.ldk = 2048; a.koff = head * 128; a.k2 = (const bf16_t*)(p.ws + OFF_KPE);
                    a.pos = (const int*)p.in[I_POS] + b * SEQ; a.scale = 0.07216878364870322f;
                    attn_item<3, NQB_MLA>(lds, a);
                } else {
                    a.q = proj; a.ldq = 4608; a.qoff = head * 128;
                    a.k = proj; a.ldk = 4608; a.koff = 2048 + head * 128; a.scale = 0.08838834764831845f;
                    if (layer == 1) { a.lfc = (const float*)(p.ws + OFF_LFC) + (size_t)(b * 16 + head) * 4096; attn_item<1, NQB_FOX>(lds, a); }
                    else attn_item<0, NQB_SB>(lds, a);
                }
            }
        }
    }
    for (int idx = blockIdx.x; idx < 8 * (SEQ / (128 * NQB_MEM)); idx += gridDim.x) {
        if (layer == 2) mem_attn_item(p, lds, layer, idx, proj, 2816, 2304);
        else if (layer == 3) mem_attn_item(p, lds, layer, idx, proj, 1536, 832);
        else mem_attn_item(p, lds, layer, idx, proj, 4608, 4096);
    }
}

enum { K_GIN = 0, K_ATT, K_GOUT, K_NORMF, K_GUP, K_CONVG, K_GDOWN, K_NORMA, K_MID, K_G2, K_FINAL, K_CONV, K_NORM0 };

__device__ __forceinline__ bool get_gemm(const Params& p, int kind, int layer, int gi, GemmDesc& d) {
    unsigned char* ws = p.ws;
    d.kind = 0; d.O = nullptr; d.X = nullptr; d.diag = 0; d.smode = 0;
    const bf16_t* h = (const bf16_t*)(ws + OFF_H);
    if (kind == K_GIN && layer == 0 && gi >= 2) {
        gi -= 2;
        if (gi == 0) { d.A = (const bf16_t*)(ws + OFF_MEMH); d.Bt = (const bf16_t*)(ws + W_MEMK); d.M = 2048; d.N = 2048; d.K = 2048; d.O = (bf16_t*)(ws + OFF_MEMK); d.ldc = 2048; d.diag = 1; return true; }
        if (gi == 1) { d.A = (const bf16_t*)(ws + W_MEMV); d.Bt = (const bf16_t*)(ws + OFF_MEMH); d.M = 2048; d.N = 2048; d.K = 2048; d.O = (bf16_t*)(ws + OFF_MEMVT); d.ldc = 2048; d.diag = 1; return true; }
        return false;
    }
    if (kind == K_GIN) {
        const size_t w1 = layer == 0 ? W_SB_IN1 : layer == 1 ? W_FOX_IN1 : layer == 2 ? W_SWA_IN1 : W_MLA_IN;
        const size_t wv = layer == 0 ? W_SB_V : layer == 1 ? W_FOX_V : W_SWA_V;
        const int n1 = layer < 2 ? 4608 : layer == 2 ? 2816 : 1536; const int mv = layer < 2 ? 2048 : layer == 2 ? 256 : 0;
        if (gi == 0) { d.A = h; d.Bt = (const bf16_t*)(ws + w1); d.M = T; d.N = n1; d.K = 2048; d.O = (bf16_t*)(ws + OFF_PROJ); d.ldc = n1; d.smode = 1; return true; }
        if (gi == 1 && mv) { d.A = (const bf16_t*)(ws + wv); d.Bt = h; d.M = mv; d.N = T; d.K = 2048; d.O = (bf16_t*)(ws + OFF_VT); d.ldc = T; d.smode = 2; return true; }
        return false;
    }
    if (kind == K_G2) {
        if (gi == 0) { d.A = (const bf16_t*)(ws + OFF_CQN); d.Bt = (const bf16_t*)(ws + W_MLA_UQ); d.M = T; d.N = 3072; d.K = 512; d.O = (bf16_t*)(ws + OFF_Q3); d.ldc = 3072; return true; }
        if (gi == 1) { d.A = (const bf16_t*)(ws + OFF_CKVN); d.Bt = (const bf16_t*)(ws + W_MLA_KN); d.M = T; d.N = 2048; d.K = 256; d.O = (bf16_t*)(ws + OFF_KN); d.ldc = 2048; return true; }
        if (gi == 2) { d.A = (const bf16_t*)(ws + W_MLA_V); d.Bt = (const bf16_t*)(ws + OFF_CKVN); d.M = 2048; d.N = T; d.K = 256; d.O = (bf16_t*)(ws + OFF_VT); d.ldc = T; return true; }
        return false;
    }
    if (kind == K_GOUT) {
        if (gi) return false;
        const size_t wo = layer == 0 ? W_SB_OUT : layer == 1 ? W_FOX_OUT : layer == 2 ? W_SWA_OUT : W_MLA_OUT;
        d.A = (const bf16_t*)(ws + OFF_ATT); d.Bt = (const bf16_t*)(ws + wo); d.M = T; d.N = 2048; d.K = 2560; d.kind = 1; d.X = (float*)(ws + OFF_XR); d.ldc = 2048; return true;
    }
    if (kind == K_GUP) {
        if (gi) return false;
        d.A = h; d.Bt = (const bf16_t*)(ws + W_UP) + (size_t)layer * 11264 * 2048; d.M = T; d.N = 11264; d.K = 2048; d.kind = 2; d.ldc = 11264; d.smode = 1; return true;
    }
    if (kind == K_GDOWN) {
        if (gi) return false;
        d.A = (const bf16_t*)(ws + OFF_G); d.Bt = (const bf16_t*)(ws + W_DOWN) + (size_t)layer * 2048 * 5632; d.M = T; d.N = 2048; d.K = 5632; d.kind = 1; d.X = (float*)(ws + OFF_XR); d.ldc = 2048; return true;
    }
    return false;
}

constexpr int N_PHASES = 1 + 6 + 5 + 5 + 8;
__device__ __forceinline__ void decode_phase(int ph, int& kind, int& layer) {
    if (ph == 0) { kind = K_CONV; layer = 0; return; }
    const int q = ph - 1;
    if (q < 16) {
        int k;
        if (q < 6) { layer = 0; k = q; } else if (q < 11) { layer = 1; k = q - 6; } else { layer = 2; k = q - 11; }
        kind = k == 0 ? K_GIN : k == 1 ? K_ATT : k == 2 ? K_GOUT : k == 3 ? K_GUP : k == 4 ? K_GDOWN : K_NORMA;
        return;
    }
    layer = 3; const int k = q - 16;
    kind = k == 0 ? K_GIN : k == 1 ? K_MID : k == 2 ? K_G2 : k == 3 ? K_ATT : k == 4 ? K_GOUT : k == 5 ? K_GUP : k == 6 ? K_GDOWN : K_FINAL;
}

__global__ void __launch_bounds__(NTHR, 2) fwd_megakernel(Params p) {
    extern __shared__ __attribute__((aligned(16))) unsigned char shm[];
    LAS unsigned char* lds = (LAS unsigned char*)shm;
    volatile LAS unsigned* xst = (volatile LAS unsigned*)(lds + LDS_BYTES - 16);
    if (threadIdx.x == 0) { xst[0] = 0u; xst[1] = 0u; xst[2] = 0u; xst[3] = 0u; }
    __syncthreads();
    const XcdBarrier xb = xcd_barrier_post((unsigned*)(p.ws + OFF_BAR), xst);
    for (int ph = p.ph_lo; ph < p.ph_hi; ++ph) {
        if (ph != p.ph_lo) { if (p.ph_hi < 0) cg::this_grid().sync(); else xcd_barrier(xb); }
        int kind, layer; decode_phase(ph, kind, layer);
        if (kind == K_CONV) { phase_conv(p, lds); phase_norm(p, p.in[I_X], p.in[I_ATTN_NORM], 1); }
        else if (kind == K_NORMA) phase_norm(p, (const float*)(p.ws + OFF_XR), p.in[I_ATTN_NORM] + 1 * 2048, 2);
        else if (kind == K_FINAL) phase_norm(p, (const float*)(p.ws + OFF_XR), p.in[I_FINAL_NORM], 3);
        else if (kind == K_MID) phase_mla_mid(p);
        else if (kind == K_ATT) { for (int rep = 0; rep < PROBE_ATT_REPS; ++rep) { if (rep) xcd_barrier(xb); phase_attn(p, lds, layer); } }
        else if (kind == K_GIN && layer == 1) fox_scan(p, lds);
        if (kind == K_GIN || kind == K_G2 || kind == K_GOUT || kind == K_GUP || kind == K_GDOWN) {
            if (kind == K_GDOWN) {
                pg8::Order S0; S0.init(T, 2048, (int)gridDim.x, (int)blockIdx.x, 0); pg8::Unit u0;
                for (int i = 0; S0.next(i, u0); ++i) ffn_fixup(p, layer, u0.pm);
                asm volatile("s_waitcnt vmcnt(0)" ::: "memory");
            }
            const int greps = (kind == K_GIN || kind == K_G2 || kind == K_GUP) ? PROBE_GEMM_REPS : 1;
            for (int grep_ = 0; grep_ < greps; ++grep_) {
            if (grep_) xcd_barrier(xb);
            __syncthreads();
            int shift = 0;
            for (int gi = 0; gi < 4; ++gi) {
                GemmDesc d, d2; d2.M = 0; d2.N = 0; d2.A = nullptr; d2.Bt = nullptr; d2.O = nullptr; d2.ldc = 0; d2.smode = 0;
                if (!get_gemm(p, kind, layer, gi, d)) break;
                const bool merged = (kind == K_GIN && gi == 0) ? get_gemm(p, kind, layer, 1, d2) : false;
                pg8::Order S; const int G = (int)gridDim.x;
                S.init(d.M, d.N, G, (int)((blockIdx.x + G - shift) % G), d.diag, merged ? d2.M : 0, merged ? d2.N : 0);
                pg8::Epi E; E.kind = d.kind; E.smode = d.smode; E.O = d.O; E.X = d.X; E.XB = (bf16_t*)(p.ws + OFF_H); E.ssq = (float*)(p.ws + OFF_SSQ); E.ldc = d.ldc; E.lds = lds;
                E.cw = p.in[I_CONVW] + (size_t)layer * 3 * 11264; E.cb = p.in[I_CONVB] + (size_t)layer * 11264; E.G = (bf16_t*)(p.ws + OFF_G); E.US = (bf16_t*)(p.ws + OFF_U);
                pg8::Gemm g; g.A = d.A; g.Bt = d.Bt; g.M = d.M; g.N = d.N; g.K = d.K; g.A2 = d2.A; g.Bt2 = d2.Bt;
                E.O2 = d2.O; E.ldc2 = d2.ldc; E.smode2 = d2.smode;
                if (d.kind == 0) pg8::gemm_phase<0>(lds, g, S, E); else if (d.kind == 1) pg8::gemm_phase<1>(lds, g, S, E); else pg8::gemm_phase<2>(lds, g, S, E);
                const int nu = (d.diag ? 16 : (d.M / 256) * (d.N / 256)) + (merged ? (d2.M / 256) * (d2.N / 256) : 0);
                shift = ((shift + nu) % G) & ~7;
                if (merged) ++gi;
            }
            }
        }
    }
}

extern "C" void kernel_launch(void* const* d_in, const int* in_sizes, int n_in, void* d_out, int out_size, void* d_ws, size_t ws_size, hipStream_t stream) {
    static int grid = 0;
    if (grid == 0) {
        if (n_in != N_IN || ws_size < WS_END) { fprintf(stderr, "kernel_launch: unexpected n_in %d or ws_size %zu (< %zu)\n", n_in, ws_size, (size_t)WS_END); grid = -1; return; }
        int dev = 0, cus = 0, per_cu = 0;
        hipGetDevice(&dev); hipDeviceGetAttribute(&cus, hipDeviceAttributeMultiprocessorCount, dev);
        if (hipFuncSetAttribute((const void*)fwd_megakernel, hipFuncAttributeMaxDynamicSharedMemorySize, LDS_BYTES) != hipSuccess) { fprintf(stderr, "kernel_launch: hipFuncSetAttribute failed\n"); grid = -1; return; }
        if (hipOccupancyMaxActiveBlocksPerMultiprocessor(&per_cu, (const void*)fwd_megakernel, NTHR, LDS_BYTES) != hipSuccess || per_cu < 1) { fprintf(stderr, "kernel_launch: occupancy query says %d\n", per_cu); per_cu = 1; }
        (void)hipGetLastError();
        grid = cus;
        fprintf(stderr, "kernel_launch: grid %d (cus %d, per_cu %d)\n", grid, cus, per_cu);
    }
    if (grid < 0) return;
    if (hipMemsetAsync((char*)d_ws + OFF_BAR, 0, BAR_BYTES, stream) != hipSuccess) { fprintf(stderr, "kernel_launch: memset of barrier words failed\n"); return; }
    Params p{};
    for (int i = 0; i < N_IN; ++i) p.in[i] = (const float*)d_in[i];
    p.out = (float*)d_out; p.ws = (unsigned char*)d_ws;
#if N_LAUNCH_MODE == 1
    p.ph_lo = 0; p.ph_hi = N_PHASES;
    void* args[] = {&p};
    hipError_t e = hipLaunchCooperativeKernel((const void*)fwd_megakernel, dim3(grid), dim3(NTHR), args, LDS_BYTES, stream);
    if (e != hipSuccess) fprintf(stderr, "cooperative launch failed: %s (grid %d)\n", hipGetErrorString(e), grid);
#else
    for (int ph = 0; ph < N_PHASES; ++ph) {
        p.ph_lo = ph; p.ph_hi = ph + 1;
        hipLaunchKernelGGL(fwd_megakernel, dim3(grid), dim3(NTHR), LDS_BYTES, stream, p);
    }
#endif
}
```

```cpp
#include <hip/hip_runtime.h>
#include <hip/hip_cooperative_groups.h>
#include <cstdio>
#include <cstdint>
namespace cg = cooperative_groups;

#ifndef N_LAUNCH_MODE
#define N_LAUNCH_MODE 1
#endif

#ifndef RESCALE_ALWAYS
#define RESCALE_ALWAYS 1
#endif
#ifndef PROBE_GEMM_REPS
#define PROBE_GEMM_REPS 1
#endif
#ifndef PROBE_SYNC_EXTRA
#define PROBE_SYNC_EXTRA 0
#endif
#ifndef PROBE_ATT_REPS
#define PROBE_ATT_REPS 1
#endif
#define LAS __attribute__((address_space(3)))
typedef unsigned short bf16_t;
typedef short bf16x8 __attribute__((ext_vector_type(8)));
typedef float f32x4 __attribute__((ext_vector_type(4)));
typedef float f32x2 __attribute__((ext_vector_type(2)));
typedef unsigned u32x4 __attribute__((ext_vector_type(4)));
typedef unsigned u32x2 __attribute__((ext_vector_type(2)));

constexpr int T = 8192, D = 2048, SEQ = 4096, DFF = 5632, ATTW = 2560;
constexpr float LOG2E = 1.4426950408889634f;
constexpr int NTHR = 512, NWAVE = 8;
constexpr int LDS_BYTES = 140288;

constexpr size_t OFF_XR = 0;
constexpr size_t OFF_H = OFF_XR + (size_t)T * D * 4;
constexpr size_t OFF_PROJ = OFF_H + (size_t)T * D * 2;
constexpr size_t OFF_VT = OFF_PROJ + (size_t)T * 4608 * 2;
constexpr size_t OFF_ATT = OFF_VT + (size_t)2048 * T * 2;
constexpr size_t OFF_U = OFF_ATT + (size_t)T * ATTW * 2;
constexpr size_t OFF_G = OFF_U + (size_t)T * 11264 * 2;
constexpr size_t OFF_MEMH = OFF_G + (size_t)T * DFF * 2;
constexpr size_t OFF_MEMK = OFF_MEMH + (size_t)2048 * 2048 * 2;
constexpr size_t OFF_MEMVT = OFF_MEMK + (size_t)2048 * 2048 * 2;
constexpr size_t OFF_LF = OFF_MEMVT + (size_t)2048 * 2048 * 2;
constexpr size_t OFF_LFC = OFF_LF + (size_t)T * 16 * 4;
constexpr size_t OFF_BIAST = OFF_LFC + (size_t)32 * 4096 * 4;
constexpr size_t OFF_WF = OFF_BIAST + (size_t)32 * 128 * 4;
constexpr size_t OFF_CQN = OFF_WF + (size_t)16 * 2048 * 4;
constexpr size_t OFF_CKVN = OFF_CQN + (size_t)T * 512 * 2;
constexpr size_t OFF_KPE = OFF_CKVN + (size_t)T * 256 * 2;
constexpr size_t OFF_Q3 = OFF_KPE + (size_t)T * 64 * 2;
constexpr size_t OFF_KN = OFF_Q3 + (size_t)T * 3072 * 2;
constexpr size_t OFF_W = OFF_KN + (size_t)T * 2048 * 2;
constexpr size_t W_SB_IN1 = OFF_W;
constexpr size_t W_SB_V = W_SB_IN1 + (size_t)4608 * 2048 * 2;
constexpr size_t W_SB_OUT = W_SB_V + (size_t)2048 * 2048 * 2;
constexpr size_t W_FOX_IN1 = W_SB_OUT + (size_t)2048 * 2560 * 2;
constexpr size_t W_FOX_V = W_FOX_IN1 + (size_t)4608 * 2048 * 2;
constexpr size_t W_FOX_OUT = W_FOX_V + (size_t)2048 * 2048 * 2;
constexpr size_t W_SWA_IN1 = W_FOX_OUT + (size_t)2048 * 2560 * 2;
constexpr size_t W_SWA_V = W_SWA_IN1 + (size_t)2816 * 2048 * 2;
constexpr size_t W_SWA_OUT = W_SWA_V + (size_t)256 * 2048 * 2;
constexpr size_t W_MLA_IN = W_SWA_OUT + (size_t)2048 * 2560 * 2;
constexpr size_t W_MLA_UQ = W_MLA_IN + (size_t)1536 * 2048 * 2;
constexpr size_t W_MLA_KN = W_MLA_UQ + (size_t)3072 * 512 * 2;
constexpr size_t W_MLA_V = W_MLA_KN + (size_t)2048 * 256 * 2;
constexpr size_t W_MLA_OUT = W_MLA_V + (size_t)2048 * 256 * 2;
constexpr size_t W_MEMK = W_MLA_OUT + (size_t)2048 * 2560 * 2;
constexpr size_t W_MEMV = W_MEMK + (size_t)2048 * 2048 * 2;
constexpr size_t W_UP = W_MEMV + (size_t)2048 * 2048 * 2;
constexpr size_t W_DOWN = W_UP + (size_t)4 * 11264 * 2048 * 2;
constexpr size_t OFF_BAR = W_DOWN + (size_t)4 * 2048 * 5632 * 2;
constexpr size_t BAR_BYTES = 16384;
constexpr size_t OFF_SSQ = OFF_BAR + BAR_BYTES;
constexpr size_t WS_END = OFF_SSQ + (size_t)T * 32 * 4;

enum { I_X = 0, I_MEM, I_POS, I_RELB, I_ATTN_NORM, I_MEM_NORM, I_WMEMKV, I_FFN_NORM, I_WUP, I_CONVW, I_CONVB, I_WDOWN, I_FINAL_NORM,
       I_SB_IN, I_SB_OUT, I_FOX_IN, I_FOX_BF, I_FOX_OUT, I_SWA_IN, I_SWA_SINKS, I_SWA_OUT, I_MLA_IN, I_MLA_QN, I_MLA_UQ, I_MLA_KVN, I_MLA_UKV, I_MLA_OUT, N_IN };

struct Params {
    const float* in[N_IN];
    float* out;
    unsigned char* ws;
    int ph_lo, ph_hi;
};

__device__ __forceinline__ unsigned cvt_pk_bf16(float lo, float hi) { unsigned r; asm volatile("v_cvt_pk_bf16_f32 %0, %1, %2" : "=v"(r) : "v"(lo), "v"(hi)); return r; }
__device__ __forceinline__ int otid() { int t = threadIdx.x; asm volatile("" : "+v"(t)); return t; }
__device__ __forceinline__ float bf_lo(unsigned u) { return __uint_as_float(u << 16); }
__device__ __forceinline__ float bf_hi(unsigned u) { return __uint_as_float(u & 0xffff0000u); }
__device__ __forceinline__ float wave_sum(float v) {
#pragma unroll
    for (int o = 1; o < 64; o <<= 1) v += __shfl_xor(v, o);
    return v;
}
__device__ __forceinline__ float fast_exp2(float x) { return __builtin_amdgcn_exp2f(x); }
__device__ __forceinline__ void sincos_big(float ang, float& s, float& c) {
    const double a = (double)ang; const double n = rint(a * 0.15915494309189535); const float rf = (float)(a - n * 6.283185307179586);
    s = __sinf(rf); c = __cosf(rf);
}
__device__ __forceinline__ float rope_inv_freq(int i) { return exp2f(-(float)i * 0.41524101186092029f); }


#define XB_TMO      128
#define XB_XCNT(j)  (256  + 64 * (j))
#define XB_XSUB(j)  (1280 + 64 * (j))
#define XB_XGEN(j)  (2304 + 64 * (j))
#define XB_TOP      3328
#define XB_TOPGEN   3392
#define XCD_BAR_WORDS 3456
#define XB_SPIN_CAP (1u << 18)
__device__ __forceinline__ unsigned xb_ld(unsigned* p)              { return __hip_atomic_load(p, __ATOMIC_RELAXED, __HIP_MEMORY_SCOPE_AGENT); }
__device__ __forceinline__ unsigned xb_add(unsigned* p, unsigned v) { return __hip_atomic_fetch_add(p, v, __ATOMIC_RELAXED, __HIP_MEMORY_SCOPE_AGENT); }
__device__ __forceinline__ unsigned xb_xcc_id() { return (unsigned)__builtin_amdgcn_s_getreg((3 << 11) | 20) & 0xFu; }
#define XB_SPIN(cond, bar) do { unsigned _sp = 0; while (cond) { __builtin_amdgcn_s_sleep(1); \
    if ((++_sp & 255u) == 0u) { if (xb_ld(&(bar)[XB_TMO])) break; if (_sp > XB_SPIN_CAP) { atomicAdd(&(bar)[XB_TMO], 1u); break; } } } } while (0)
struct XcdBarrier { unsigned* bar; unsigned x; volatile LAS unsigned* st; };
__device__ __forceinline__ XcdBarrier xcd_barrier_post(unsigned* bar, volatile LAS unsigned* st) {
    XcdBarrier b; b.bar = bar; b.x = xb_xcc_id(); b.st = st;
    if (threadIdx.x == 0) (void)xb_add(&bar[XB_XCNT(b.x)], 1u);
    return b;
}
__device__ __forceinline__ void xcd_barrier_complete(unsigned* bar, unsigned x, unsigned& nloc, unsigned& nx) {
    const unsigned G = gridDim.x * gridDim.y * gridDim.z;
    unsigned sum, cnt, mine, sp = 0u;
    for (;;) {
        sum = 0u; cnt = 0u; mine = 0u;
#pragma unroll
        for (unsigned j = 0; j < 16; ++j) { const unsigned c = xb_ld(&bar[XB_XCNT(j)]); sum += c; cnt += (c > 0u) ? 1u : 0u; mine = (j == x) ? c : mine; }
        if (sum == G) break;
        __builtin_amdgcn_s_sleep(1);
        if ((++sp & 255u) == 0u) { if (xb_ld(&bar[XB_TMO])) break; if (sp > XB_SPIN_CAP) { atomicAdd(&bar[XB_TMO], 1u); break; } }
    }
    nloc = mine > 0u ? mine : 1u; nx = cnt > 0u ? cnt : 1u;
}
__device__ __forceinline__ void xcd_barrier(const XcdBarrier& b) {
    asm volatile("s_waitcnt vmcnt(0)" ::: "memory");
    __syncthreads();
    if (threadIdx.x == 0) {
        unsigned* bar = b.bar;
        __builtin_amdgcn_s_waitcnt(0);
        unsigned nloc = b.st[0], nx = b.st[1];
        if (nloc == 0u) { xcd_barrier_complete(bar, b.x, nloc, nx); b.st[0] = nloc; b.st[1] = nx; }
        const unsigned old = xb_add(&bar[XB_XSUB(b.x)], 1u);
        const unsigned gen = old / nloc;
        if (old + 1u == (gen + 1u) * nloc) {
            __builtin_amdgcn_fence(__ATOMIC_RELEASE, "agent");
            asm volatile("s_waitcnt vmcnt(0)" ::: "memory");
            const unsigned og = xb_add(&bar[XB_TOP], 1u);
            const unsigned tg = og / nx;
            if (og + 1u == (tg + 1u) * nx) xb_add(&bar[XB_TOPGEN], 1u);
            else XB_SPIN(xb_ld(&bar[XB_TOPGEN]) == tg, bar);
            __builtin_amdgcn_fence(__ATOMIC_ACQUIRE, "agent");
            xb_add(&bar[XB_XGEN(b.x)], 1u);
            asm volatile("s_waitcnt vmcnt(0)" ::: "memory");
        } else {
            XB_SPIN(xb_ld(&bar[XB_XGEN(b.x)]) == gen, bar);
            __builtin_amdgcn_fence(__ATOMIC_ACQUIRE, "agent");
            asm volatile("s_waitcnt vmcnt(0)" ::: "memory");
        }
    }
    __syncthreads();
}

namespace pg8 {
constexpr int BM = 256, BK = 64, HALF = 128, HTB = HALF * BK * 2, STAGE_BYTES = 8 * HTB, NXCD = 8, WGM = 8;
__device__ __forceinline__ int lds_byte(int r, int c) { const int st = (r >> 4) * 2 + (c >> 5), rr = r & 15, cc = c & 31, ob = rr * 64 + cc * 2; return st * 1024 + (ob ^ (((ob >> 9) & 1) << 5)); }
__device__ __forceinline__ void stage_rc(int b, int& R, int& C) { const int st = b / 1024, sb = b % 1024, swz = sb ^ (((sb >> 9) & 1) << 5); R = (st >> 1) * 16 + swz / 64; C = (st & 1) * 32 + (swz % 64) / 2; }
__device__ __forceinline__ int perm32(int rho) { const int n = rho >> 4, i = rho & 15; return 8 * (i >> 2) + 4 * n + (i & 3); }
struct Unit { int pm, pn, which; };
struct Gemm { const bf16_t* A; const bf16_t* Bt; int M, N, K; const bf16_t* A2; const bf16_t* Bt2; };

struct Order {
    int nM, nN, nwg, G, c, diag, nM2, nN2, nwg2;
    __device__ void init(int M, int N, int G_, int c_, int diag_, int M2 = 0, int N2 = 0) { nM = M / BM; nN = N / BM; nwg = nM * nN; G = G_; c = c_; diag = diag_; nM2 = M2 / BM; nN2 = N2 / BM; nwg2 = nM2 * nN2; }
    static __device__ void tile_map(int wgid, int nM_, int nN_, int nwg_, Unit& u) {
        { const int q = nwg_ / NXCD, r = nwg_ % NXCD, xcd = wgid % NXCD, off = wgid / NXCD; wgid = (xcd < r ? xcd * (q + 1) : r * (q + 1) + (xcd - r) * q) + off; }
        const int nig = WGM * nN_, gid = wgid / nig, fm = gid * WGM, gsz = (nM_ - fm) < WGM ? (nM_ - fm) : WGM;
        u.pm = fm + ((wgid % nig) % gsz); u.pn = (wgid % nig) / gsz;
    }
    __device__ bool next(int i, Unit& u) const {
        u.which = 0;
        if (diag) { const int L = i * G + c; if (L >= 16) return false; const int l = L >> 2; u.pm = 2 * l + (L & 1); u.pn = 2 * l + ((L >> 1) & 1); return true; }
        const long L = (long)i * G + c; if (L >= nwg + nwg2) return false;
        if (L < nwg) tile_map((int)L, nM, nN, nwg, u); else { u.which = 1; tile_map((int)L - nwg, nM2, nN2, nwg2, u); }
        return true;
    }
};

struct Epi {
    int kind, smode; bf16_t* O; float* X; bf16_t* XB; float* ssq; int ldc; LAS unsigned char* lds;
    bf16_t* O2; int ldc2, smode2;
    const float* cw; const float* cb; bf16_t* G; bf16_t* US;
    __device__ __forceinline__ float row_rs(int row, int fq) const {
        const f32x4 a = *(const f32x4*)(ssq + (size_t)row * 32 + fq * 8), b = *(const f32x4*)(ssq + (size_t)row * 32 + fq * 8 + 4);
        float t = ((a[0] + a[1]) + (a[2] + a[3])) + ((b[0] + b[1]) + (b[2] + b[3]));
        t += __shfl_xor(t, 16); t += __shfl_xor(t, 32);
        return rsqrtf(t * (1.f / 2048.f) + 1e-6f);
    }
    static __device__ __forceinline__ unsigned ror1(unsigned x) { return (unsigned)__builtin_amdgcn_update_dpp(0, (int)x, 0x121, 0xf, 0xf, false); }
    static __device__ __forceinline__ unsigned ror2(unsigned x) { return (unsigned)__builtin_amdgcn_update_dpp(0, (int)x, 0x122, 0xf, 0xf, false); }
    __device__ __forceinline__ void ffn_gate(const f32x4 (&acc)[2][2][4][2], const Unit& u, int wr, int wc, int fr, int fq) const {
        unsigned row0 = (unsigned)(u.pm * BM + wr * 64 + fr), ch0 = (unsigned)(u.pn * HALF + wc * 32 + 8 * fq);
        asm volatile("" : "+v"(row0), "+v"(ch0));
        u32x2 pk[2][2][4][2];
#pragma unroll
        for (int h = 0; h < 2; ++h) {
            f32x4 pa[4], pb[4];
#pragma unroll
            for (int i = 0; i < 4; ++i) { const unsigned qo = (row0 + h * HALF + i * 16) * 32u + fq * 8u; pa[i] = *(const f32x4*)(ssq + qo); pb[i] = *(const f32x4*)(ssq + qo + 4u); }
#pragma unroll
            for (int i = 0; i < 4; ++i) { float t = ((pa[i][0] + pa[i][1]) + (pa[i][2] + pa[i][3])) + ((pb[i][0] + pb[i][1]) + (pb[i][2] + pb[i][3]));
                t += __shfl_xor(t, 16); t += __shfl_xor(t, 32); const float rsr = rsqrtf(t * (1.f / 2048.f) + 1e-6f);
#pragma unroll
                for (int bj = 0; bj < 2; ++bj)
#pragma unroll
                    for (int n = 0; n < 2; ++n) { const f32x4 v = acc[h][bj][i][n] * rsr; pk[h][bj][i][n].x = cvt_pk_bf16(v[0], v[1]); pk[h][bj][i][n].y = cvt_pk_bf16(v[2], v[3]); } }
            __builtin_amdgcn_sched_barrier(0);
        }
#pragma unroll
        for (int n = 0; n < 2; ++n) {
            __builtin_amdgcn_sched_barrier(0);
            const unsigned ch = ch0 + 4u * n;
            const f32x4 wg0 = *(const f32x4*)(cw + ch), wg1 = *(const f32x4*)(cw + (11264u + ch)), wg2 = *(const f32x4*)(cw + (22528u + ch)), bg = *(const f32x4*)(cb + ch);
            const f32x4 wv0 = *(const f32x4*)(cw + (5632u + ch)), wv1 = *(const f32x4*)(cw + (16896u + ch)), wv2 = *(const f32x4*)(cw + (28160u + ch)), bv = *(const f32x4*)(cb + (5632u + ch));
#pragma unroll
            for (int ai = 0; ai < 2; ++ai) {
                u32x2 gp = (u32x2){0u, 0u}, vp = gp;
#pragma unroll
                for (int m = 0; m < 4; ++m) {
                    const unsigned row = row0 + ai * HALF + m * 16;
                    const u32x2 gc = pk[ai][0][m][n], vc = pk[ai][1][m][n];
                    u32x2 g1, g2, v1, v2;
#pragma unroll
                    for (int q = 0; q < 2; ++q) {
                        const unsigned a1 = ror1(gc[q]), b1 = ror1(gp[q]), a2 = ror2(gc[q]), b2 = ror2(gp[q]);
                        const unsigned c1 = ror1(vc[q]), d1 = ror1(vp[q]), c2 = ror2(vc[q]), d2 = ror2(vp[q]);
                        g1[q] = fr >= 1 ? a1 : b1; g2[q] = fr >= 2 ? a2 : b2; v1[q] = fr >= 1 ? c1 : d1; v2[q] = fr >= 2 ? c2 : d2;
                    }
                    float o[4];
#pragma unroll
                    for (int q = 0; q < 2; ++q) {
                        const f32x2 G0 = (f32x2){bf_lo(gc[q]), bf_hi(gc[q])}, G1 = (f32x2){bf_lo(g1[q]), bf_hi(g1[q])}, G2 = (f32x2){bf_lo(g2[q]), bf_hi(g2[q])};
                        const f32x2 V0 = (f32x2){bf_lo(vc[q]), bf_hi(vc[q])}, V1 = (f32x2){bf_lo(v1[q]), bf_hi(v1[q])}, V2 = (f32x2){bf_lo(v2[q]), bf_hi(v2[q])};
                        const f32x2 WG0 = (f32x2){wg0[2 * q], wg0[2 * q + 1]}, WG1 = (f32x2){wg1[2 * q], wg1[2 * q + 1]}, WG2 = (f32x2){wg2[2 * q], wg2[2 * q + 1]}, BG = (f32x2){bg[2 * q], bg[2 * q + 1]};
                        const f32x2 WV0 = (f32x2){wv0[2 * q], wv0[2 * q + 1]}, WV1 = (f32x2){wv1[2 * q], wv1[2 * q + 1]}, WV2 = (f32x2){wv2[2 * q], wv2[2 * q + 1]}, BV = (f32x2){bv[2 * q], bv[2 * q + 1]};
                        const f32x2 cg = ((BG + WG0 * G2) + WG1 * G1) + WG2 * G0;
                        const f32x2 cv = ((BV + WV0 * V2) + WV1 * V1) + WV2 * V0;
                        f32x2 sg; sg.x = __fdividef(cg.x, 1.f + __expf(-cg.x)); sg.y = __fdividef(cg.y, 1.f + __expf(-cg.y));
                        const f32x2 ov = sg * cv;
                        o[2 * q] = ov.x; o[2 * q + 1] = ov.y;
                    }
                    { u32x2 w; w.x = cvt_pk_bf16(o[0], o[1]); w.y = cvt_pk_bf16(o[2], o[3]); *(u32x2*)(G + (row * 5632u + ch)) = w; }
                    if ((m == 0 && fr < 2) || (m == 3 && fr >= 14)) {
                        const unsigned slot = (m == 0) ? (unsigned)fr : (unsigned)(fr - 12), uo = ((row >> 6) * 4u + slot) * 11264u + ch;
                        *(u32x2*)(US + uo) = gc; *(u32x2*)(US + (uo + 5632u)) = vc;
                    }
                    gp = gc; vp = vc;
                    __builtin_amdgcn_sched_barrier(0);
                }
            }
        }
    }
    template <int KIND> __device__ __forceinline__ void init_acc(f32x4 (&acc)[2][2][4][2], const Unit& u, int wr, int wc, int fr, int fq) const {
        const int row0 = u.pm * BM + wr * 64 + fr, col0 = u.pn * BM + wc * 32 + 8 * fq;
#pragma unroll
        for (int ai = 0; ai < 2; ++ai)
#pragma unroll
            for (int bj = 0; bj < 2; ++bj)
#pragma unroll
                for (int m = 0; m < 4; ++m)
#pragma unroll
                    for (int n = 0; n < 2; ++n) {
                        if (KIND == 1) {
                            const size_t eo = (size_t)(row0 + ai * HALF + m * 16) * ldc + col0 + bj * HALF + 4 * n;
                            const u32x2 hi = *(const u32x2*)(XB + eo), lo = *(const u32x2*)((const bf16_t*)X + eo);
                            acc[ai][bj][m][n] = (f32x4){bf_lo(hi.x) + bf_lo(lo.x), bf_hi(hi.x) + bf_hi(lo.x), bf_lo(hi.y) + bf_lo(lo.y), bf_hi(hi.y) + bf_hi(lo.y)};
                        } else acc[ai][bj][m][n] = (f32x4){0.f, 0.f, 0.f, 0.f};
                    }
    }
    template <int KIND> __device__ __forceinline__ void run(const f32x4 (&acc)[2][2][4][2], const Unit& u, int wr, int wc, int fr, int fq) const {
        const int row0 = u.pm * BM + wr * 64 + fr, col0 = u.pn * BM + wc * 32 + 8 * fq;
        if (KIND == 2) { ffn_gate(acc, u, wr, wc, fr, fq); return; }
        if (KIND == 0) {
            const int sm = u.which ? smode2 : smode, ld = u.which ? ldc2 : ldc; bf16_t* Oo = u.which ? O2 : O;
            LAS float* wsc = (LAS float*)(lds + 131072) + (wr * 4 + wc) * 64;
            if (sm == 2) {
                const int i = fq * 16 + fr, tok = u.pn * BM + wc * 32 + (i & 31) + (i >> 5) * HALF;
                float t = 0.f;
#pragma unroll
                for (int j = 0; j < 8; ++j) { const f32x4 a = *(const f32x4*)(ssq + (size_t)tok * 32 + 4 * j); t += (a[0] + a[1]) + (a[2] + a[3]); }
                wsc[i] = rsqrtf(t * (1.f / 2048.f) + 1e-6f);
                asm volatile("s_waitcnt lgkmcnt(0)" ::: "memory");
            }
            float rs8[8];
            if (sm == 1) {
                f32x4 pa[8], pb[8];
#pragma unroll
                for (int i = 0; i < 8; ++i) { const float* q = ssq + (size_t)(row0 + (i >> 2) * HALF + (i & 3) * 16) * 32 + fq * 8; pa[i] = *(const f32x4*)q; pb[i] = *(const f32x4*)(q + 4); }
#pragma unroll
                for (int i = 0; i < 8; ++i) { float t = ((pa[i][0] + pa[i][1]) + (pa[i][2] + pa[i][3])) + ((pb[i][0] + pb[i][1]) + (pb[i][2] + pb[i][3]));
                    t += __shfl_xor(t, 16); t += __shfl_xor(t, 32); rs8[i] = rsqrtf(t * (1.f / 2048.f) + 1e-6f); }
            } else {
#pragma unroll
                for (int i = 0; i < 8; ++i) rs8[i] = 1.f;
            }
#pragma unroll
            for (int ai = 0; ai < 2; ++ai)
#pragma unroll
                for (int m = 0; m < 4; ++m) { const int row = row0 + ai * HALF + m * 16; bf16_t* rowp = Oo + (size_t)row * ld + col0;
                    const float rsr = rs8[ai * 4 + m];
#pragma unroll
                    for (int bj = 0; bj < 2; ++bj) { f32x4 v0 = acc[ai][bj][m][0] * rsr, v1 = acc[ai][bj][m][1] * rsr;
                        if (sm == 2) { const f32x4 q0 = *(const LAS f32x4*)(wsc + bj * 32 + 8 * fq), q1 = *(const LAS f32x4*)(wsc + bj * 32 + 8 * fq + 4); v0 = v0 * q0; v1 = v1 * q1; }
                        u32x4 w; w.x = cvt_pk_bf16(v0[0], v0[1]); w.y = cvt_pk_bf16(v0[2], v0[3]); w.z = cvt_pk_bf16(v1[0], v1[1]); w.w = cvt_pk_bf16(v1[2], v1[3]);
                        *(u32x4*)(rowp + bj * HALF) = w; } }
            if (sm == 2) asm volatile("s_waitcnt lgkmcnt(0)" ::: "memory");
        } else {
#pragma unroll
            for (int ai = 0; ai < 2; ++ai)
#pragma unroll
                for (int m = 0; m < 4; ++m) { const int row = row0 + ai * HALF + m * 16; bf16_t* lp = (bf16_t*)X + (size_t)row * ldc + col0; bf16_t* bp = XB + (size_t)row * ldc + col0;
                    float ss = 0.f;
#pragma unroll
                    for (int bj = 0; bj < 2; ++bj) {
                        const f32x4 v0 = acc[ai][bj][m][0], v1 = acc[ai][bj][m][1];
                        ss += (v0[0] * v0[0] + v0[1] * v0[1]) + (v0[2] * v0[2] + v0[3] * v0[3]) + (v1[0] * v1[0] + v1[1] * v1[1]) + (v1[2] * v1[2] + v1[3] * v1[3]);
                        u32x4 w; w.x = cvt_pk_bf16(v0[0], v0[1]); w.y = cvt_pk_bf16(v0[2], v0[3]); w.z = cvt_pk_bf16(v1[0], v1[1]); w.w = cvt_pk_bf16(v1[2], v1[3]);
                        u32x4 wl; wl.x = cvt_pk_bf16(v0[0] - bf_lo(w.x), v0[1] - bf_hi(w.x)); wl.y = cvt_pk_bf16(v0[2] - bf_lo(w.y), v0[3] - bf_hi(w.y));
                        wl.z = cvt_pk_bf16(v1[0] - bf_lo(w.z), v1[1] - bf_hi(w.z)); wl.w = cvt_pk_bf16(v1[2] - bf_lo(w.w), v1[3] - bf_hi(w.w));
                        *(u32x4*)(bp + bj * HALF) = w; *(u32x4*)(lp + bj * HALF) = wl;
                    }
                    ss += __shfl_xor(ss, 16); ss += __shfl_xor(ss, 32);
                    if (fq == 0) ssq[(size_t)row * 32 + u.pn * 4 + wc] = ss;
                }
        }
    }
};

template <int KIND> __device__ __forceinline__ void gemm_phase(LAS unsigned char* lds, const Gemm g, const Order& S, const Epi& E) {
    const int tid = otid(), wid = __builtin_amdgcn_readfirstlane(tid >> 6), lane = tid & 63, wr = wid >> 2, wc = wid & 3, fr = lane & 15, fq = lane >> 4;
    const int K = g.K, nt = K / BK;
    unsigned voffA[2], voffB[2];
#pragma unroll
    for (int i = 0; i < 2; ++i) { int R, C; stage_rc(tid * 16 + i * 8192, R, C); const int Rb = (R & ~31) + perm32(R & 31);
        voffA[i] = (unsigned)(R * K + C) * 2u; voffB[i] = (unsigned)(Rb * K + C) * 2u; }
    const size_t kstep = (size_t)(BK * 2);
    const size_t hstep = (size_t)HALF * K * 2;
    const size_t tstep = 2 * hstep;
    const unsigned ldsw = (unsigned)wid * 1024u;
    const int aoff = lds_byte(wr * 64 + fr, fq * 8), boff = lds_byte(wc * 32 + fr, fq * 8);
#define PG8_SA(b, h) (((b) * 2 + (h)) * HTB)
#define PG8_SB(b, h) ((4 + (b) * 2 + (h)) * HTB)
#define PG8_STAGE(bufoff, gbase, voff) do { _Pragma("unroll") for (int _i = 0; _i < 2; ++_i) \
        __builtin_amdgcn_global_load_lds((const unsigned*)((const char*)(gbase) + (voff)[_i]), (LAS unsigned*)(lds + (bufoff) + ldsw + _i * 8192), 16, 0, 0); } while (0)
#define PG8_LDA(dst, b, h) do { _Pragma("unroll") for (int m = 0; m < 4; ++m) _Pragma("unroll") for (int k = 0; k < 2; ++k) dst[m][k] = *(const LAS bf16x8*)(lds + PG8_SA(b, h) + aoff + m * 2048 + k * 1024); } while (0)
#define PG8_LDB(dst, b, h) do { _Pragma("unroll") for (int n = 0; n < 2; ++n) _Pragma("unroll") for (int k = 0; k < 2; ++k) dst[n][k] = *(const LAS bf16x8*)(lds + PG8_SB(b, h) + boff + n * 2048 + k * 1024); } while (0)
#define PG8_MMA(ai, bj, At, Bt) do { __builtin_amdgcn_s_setprio(1); _Pragma("unroll") for (int m = 0; m < 4; ++m) _Pragma("unroll") for (int n = 0; n < 2; ++n) _Pragma("unroll") for (int k = 0; k < 2; ++k) \
        acc[ai][bj][m][n] = __builtin_amdgcn_mfma_f32_16x16x32_bf16(Bt[n][k], At[m][k], acc[ai][bj][m][n], 0, 0, 0); __builtin_amdgcn_s_setprio(0); } while (0)
#define PG8_WAIT_V(n) asm volatile("s_waitcnt vmcnt(" #n ")" ::: "memory")
#define PG8_WAIT_L(n) asm volatile("s_waitcnt lgkmcnt(" #n ")" ::: "memory")
#define PG8_BAR __builtin_amdgcn_s_barrier()
#define PG8_SCHED __builtin_amdgcn_sched_barrier(0)
    Unit cur, nxt; int ui = 0;
    if (!S.next(0, cur)) return;
    f32x4 acc[2][2][4][2];
    E.template init_acc<KIND>(acc, cur, wr, wc, fr, fq);
    bf16x8 At[4][2], B0[2][2], B1[2][2];
    const char* cA = (const char*)(cur.which ? g.A2 : g.A) + (size_t)cur.pm * tstep; const char* cB = (const char*)(cur.which ? g.Bt2 : g.Bt) + (size_t)cur.pn * tstep;
    PG8_STAGE(PG8_SB(0, 0), cB, voffB); PG8_STAGE(PG8_SA(0, 0), cA, voffA); PG8_STAGE(PG8_SB(0, 1), cB + hstep, voffB); PG8_STAGE(PG8_SA(0, 1), cA + hstep, voffA);
    if (wr == 1) PG8_BAR;
    PG8_WAIT_V(4); PG8_BAR;
    PG8_STAGE(PG8_SB(1, 0), cB + kstep, voffB); PG8_STAGE(PG8_SA(1, 0), cA + kstep, voffA); PG8_STAGE(PG8_SB(1, 1), cB + hstep + kstep, voffB);
    PG8_WAIT_V(6); PG8_BAR;
    for (;;) {
        const bool has_next = S.next(ui + 1, nxt);
        const char* nA = has_next ? (const char*)(nxt.which ? g.A2 : g.A) + (size_t)nxt.pm * tstep : cA; const char* nB = has_next ? (const char*)(nxt.which ? g.Bt2 : g.Bt) + (size_t)nxt.pn * tstep : cB;
        for (int t = 0; t < nt; t += 2) {
            const bool last = (t == nt - 2);
            const char* a1 = cA + (size_t)(t + 1) * kstep;
            const char* a2 = last ? nA : cA + (size_t)(t + 2) * kstep; const char* b2 = last ? nB : cB + (size_t)(t + 2) * kstep;
            const char* a3 = a2 + kstep; const char* b3 = b2 + kstep;
            PG8_LDB(B0, 0, 0); PG8_SCHED; PG8_LDA(At, 0, 0); PG8_STAGE(PG8_SA(1, 1), a1 + hstep, voffA);
            PG8_WAIT_L(8); PG8_BAR; PG8_WAIT_L(0); PG8_MMA(0, 0, At, B0); PG8_BAR; PG8_SCHED;
            PG8_LDB(B1, 0, 1); PG8_STAGE(PG8_SB(0, 0), b2, voffB);
            PG8_BAR; PG8_WAIT_L(0); PG8_MMA(0, 1, At, B1); PG8_BAR;
            PG8_LDA(At, 0, 1); PG8_STAGE(PG8_SA(0, 0), a2, voffA);
            PG8_BAR; PG8_WAIT_L(0); PG8_MMA(1, 0, At, B0); PG8_BAR; PG8_SCHED;
            PG8_STAGE(PG8_SB(0, 1), b2 + hstep, voffB);
            PG8_WAIT_V(6); PG8_BAR; PG8_MMA(1, 1, At, B1); PG8_BAR;
            PG8_LDB(B0, 1, 0); PG8_SCHED; PG8_LDA(At, 1, 0); PG8_STAGE(PG8_SA(0, 1), a2 + hstep, voffA);
            PG8_WAIT_L(8); PG8_BAR; PG8_WAIT_L(0); PG8_MMA(0, 0, At, B0); PG8_BAR; PG8_SCHED;
            PG8_LDB(B1, 1, 1); PG8_STAGE(PG8_SB(1, 0), b3, voffB);
            PG8_BAR; PG8_WAIT_L(0); PG8_MMA(0, 1, At, B1); PG8_BAR;
            PG8_LDA(At, 1, 1); PG8_STAGE(PG8_SA(1, 0), a3, voffA);
            PG8_BAR; PG8_WAIT_L(0); PG8_MMA(1, 0, At, B0); PG8_BAR; PG8_SCHED;
            PG8_STAGE(PG8_SB(1, 1), b3 + hstep, voffB);
            PG8_WAIT_V(6); PG8_BAR; PG8_MMA(1, 1, At, B1); PG8_BAR;
        }
        E.template run<KIND>(acc, cur, wr, wc, fr, fq);
        if (!has_next) break;
        E.template init_acc<KIND>(acc, nxt, wr, wc, fr, fq);
        cur = nxt; cA = nA; cB = nB; ++ui;
    }
    PG8_WAIT_V(0);
    if (wr == 0) PG8_BAR;
    PG8_BAR;
#undef PG8_SA
#undef PG8_SB
#undef PG8_STAGE
#undef PG8_LDA
#undef PG8_LDB
#undef PG8_MMA
#undef PG8_WAIT_V
#undef PG8_WAIT_L
#undef PG8_BAR
#undef PG8_SCHED
}
}

struct GemmDesc { const bf16_t* A; const bf16_t* Bt; int M, N, K; int kind; bf16_t* O; float* X; int ldc; int diag; int smode; };

struct Seg { const float* src; bf16_t* dst; const float* gain; int K, ldw, c0, ncols, rep, cstride, dstride, nitems; };
constexpr int NSEG = 37;

__device__ __forceinline__ void set_seg(LAS Seg* s, const float* src, bf16_t* dst, int K, int ldw, int c0, int ncols, int rep = 1, int cstride = 0, int dstride = 0, const float* gain = nullptr) {
    { int z = 0; asm volatile("" : "+v"(z)); K += z; ldw += z; c0 += z; ncols += z; rep += z; cstride += z; dstride += z; }
    { unsigned long long u0 = (unsigned long long)src, u1 = (unsigned long long)dst, u2 = (unsigned long long)gain; asm volatile("" : "+v"(u0), "+v"(u1), "+v"(u2));
      src = (const float*)u0; dst = (bf16_t*)u1; gain = (const float*)u2; }
    s->src = src; s->dst = dst; s->gain = gain; s->K = K; s->ldw = ldw; s->c0 = c0; s->ncols = ncols; s->rep = rep; s->cstride = cstride; s->dstride = dstride; s->nitems = (K / 64) * (ncols / 64) * rep;
}
__device__ void build_segs(const Params& p, LAS Seg* sg) {
    unsigned char* ws = p.ws; int n = 0;
    for (int i = 0; i < 4; ++i) {
        set_seg(sg + n++, p.in[I_WUP] + (size_t)i * 2048 * 11264, (bf16_t*)(ws + W_UP) + (size_t)i * 11264 * 2048, 2048, 11264, 0, 128, 44, 128, 256, p.in[I_FFN_NORM] + i * 2048);
        set_seg(sg + n++, p.in[I_WUP] + (size_t)i * 2048 * 11264, (bf16_t*)(ws + W_UP) + (size_t)i * 11264 * 2048 + (size_t)128 * 2048, 2048, 11264, 5632, 128, 44, 128, 256, p.in[I_FFN_NORM] + i * 2048);
        set_seg(sg + n++, p.in[I_WDOWN] + (size_t)i * 5632 * 2048, (bf16_t*)(ws + W_DOWN) + (size_t)i * 2048 * 5632, 5632, 2048, 0, 2048);
    }
    set_seg(sg + n++, p.in[I_SB_IN], (bf16_t*)(ws + W_SB_IN1), 2048, 6656, 0, 4096, 1, 0, 0, p.in[I_ATTN_NORM] + 0 * 2048);
    set_seg(sg + n++, p.in[I_SB_IN], (bf16_t*)(ws + W_SB_IN1) + (size_t)4096 * 2048, 2048, 6656, 6144, 512, 1, 0, 0, p.in[I_ATTN_NORM] + 0 * 2048);
    set_seg(sg + n++, p.in[I_SB_IN], (bf16_t*)(ws + W_SB_V), 2048, 6656, 4096, 2048, 1, 0, 0, p.in[I_ATTN_NORM] + 0 * 2048);
    set_seg(sg + n++, p.in[I_SB_OUT], (bf16_t*)(ws + W_SB_OUT), 2560, 2048, 0, 2048);
    set_seg(sg + n++, p.in[I_FOX_IN], (bf16_t*)(ws + W_FOX_IN1), 2048, 6672, 0, 4096, 1, 0, 0, p.in[I_ATTN_NORM] + 1 * 2048);
    set_seg(sg + n++, p.in[I_FOX_IN], (bf16_t*)(ws + W_FOX_IN1) + (size_t)4096 * 2048, 2048, 6672, 6160, 512, 1, 0, 0, p.in[I_ATTN_NORM] + 1 * 2048);
    set_seg(sg + n++, p.in[I_FOX_IN], (bf16_t*)(ws + W_FOX_V), 2048, 6672, 4096, 2048, 1, 0, 0, p.in[I_ATTN_NORM] + 1 * 2048);
    set_seg(sg + n++, p.in[I_FOX_OUT], (bf16_t*)(ws + W_FOX_OUT), 2560, 2048, 0, 2048);
    set_seg(sg + n++, p.in[I_SWA_IN], (bf16_t*)(ws + W_SWA_IN1), 2048, 3072, 0, 2304, 1, 0, 0, p.in[I_ATTN_NORM] + 2 * 2048);
    set_seg(sg + n++, p.in[I_SWA_IN], (bf16_t*)(ws + W_SWA_IN1) + (size_t)2304 * 2048, 2048, 3072, 2560, 512, 1, 0, 0, p.in[I_ATTN_NORM] + 2 * 2048);
    set_seg(sg + n++, p.in[I_SWA_IN], (bf16_t*)(ws + W_SWA_V), 2048, 3072, 2304, 256, 1, 0, 0, p.in[I_ATTN_NORM] + 2 * 2048);
    set_seg(sg + n++, p.in[I_SWA_OUT], (bf16_t*)(ws + W_SWA_OUT), 2560, 2048, 0, 2048);
    set_seg(sg + n++, p.in[I_MLA_IN], (bf16_t*)(ws + W_MLA_IN), 2048, 1344, 0, 1344, 1, 0, 0, p.in[I_ATTN_NORM] + 3 * 2048);
    set_seg(sg + n++, p.in[I_MLA_UQ], (bf16_t*)(ws + W_MLA_UQ), 512, 3072, 0, 3072);
    set_seg(sg + n++, p.in[I_MLA_UKV], (bf16_t*)(ws + W_MLA_KN), 256, 4096, 0, 128, 16, 256, 128);
    set_seg(sg + n++, p.in[I_MLA_UKV], (bf16_t*)(ws + W_MLA_V), 256, 4096, 128, 128, 16, 256, 128);
    set_seg(sg + n++, p.in[I_MLA_OUT], (bf16_t*)(ws + W_MLA_OUT), 2560, 2048, 0, 2048);
    for (int i = 0; i < 4; ++i) {
        set_seg(sg + n++, p.in[I_WMEMKV] + (size_t)i * 2048 * 1024, (bf16_t*)(ws + W_MEMK) + (size_t)i * 512 * 2048, 2048, 1024, 0, 512);
        set_seg(sg + n++, p.in[I_WMEMKV] + (size_t)i * 2048 * 1024, (bf16_t*)(ws + W_MEMV) + (size_t)i * 512 * 2048, 2048, 1024, 512, 512);
    }
}

__device__ __forceinline__ void transpose_item(const float* W, int ldw, int K, int c0, bf16_t* WT, int item, int nblk, LAS float* scr, int lane, const float* gain, bool nt) {
    const int kb = item / nblk, nb = item % nblk, k0 = 64 * kb, n0 = 64 * nb;
    const float* src = W + (size_t)(k0 + (lane >> 4)) * ldw + c0 + n0 + (lane & 15) * 4;
    f32x4 v[16];
#pragma unroll
    for (int j = 0; j < 16; ++j) v[j] = __builtin_nontemporal_load((const f32x4*)(src + (size_t)(4 * j) * ldw));
    if (gain) {
#pragma unroll
        for (int j = 0; j < 16; ++j) v[j] = v[j] * gain[k0 + 4 * j + (lane >> 4)];
    }
#pragma unroll
    for (int j = 0; j < 16; ++j) { LAS float* d = scr + (4 * j + (lane >> 4)) * 65 + (lane & 15) * 4; d[0] = v[j].x; d[1] = v[j].y; d[2] = v[j].z; d[3] = v[j].w; }
    asm volatile("s_waitcnt lgkmcnt(0)" ::: "memory");
    const int c = lane & 7;
#pragma unroll
    for (int j = 0; j < 8; ++j) { const int n = (lane >> 3) + 8 * j; const LAS float* sp = scr + (8 * c) * 65 + n;
        u32x4 o; o.x = cvt_pk_bf16(sp[0 * 65], sp[1 * 65]); o.y = cvt_pk_bf16(sp[2 * 65], sp[3 * 65]); o.z = cvt_pk_bf16(sp[4 * 65], sp[5 * 65]); o.w = cvt_pk_bf16(sp[6 * 65], sp[7 * 65]);
        u32x4* dp = (u32x4*)(WT + (size_t)(n0 + n) * K + k0 + 8 * c);
        if (nt) __builtin_nontemporal_store(o, dp); else *dp = o; }
    asm volatile("s_waitcnt lgkmcnt(0)" ::: "memory");
}

__device__ __forceinline__ void rms_row_bf16(const float* xrow, const float* g, bf16_t* orow, float* xcopy, int lane, f32x4 (&y)[8]) {
    const f32x4* xr = (const f32x4*)xrow + lane; float ss = 0.f;
#pragma unroll
    for (int j = 0; j < 8; ++j) { y[j] = xr[64 * j]; ss += (y[j].x * y[j].x + y[j].y * y[j].y) + (y[j].z * y[j].z + y[j].w * y[j].w); }
    if (xcopy) {
#pragma unroll
        for (int j = 0; j < 8; ++j) ((f32x4*)xcopy + lane)[64 * j] = y[j];
    }
    const float rs = rsqrtf(wave_sum(ss) * (1.f / 2048.f) + 1e-6f);
    const f32x4* gr = (const f32x4*)g + lane; u32x2* o8 = (u32x2*)orow + lane;
#pragma unroll
    for (int j = 0; j < 8; ++j) { const f32x4 gg = gr[64 * j]; y[j] = (y[j] * rs) * gg; u32x2 w; w.x = cvt_pk_bf16(y[j].x, y[j].y); w.y = cvt_pk_bf16(y[j].z, y[j].w); o8[64 * j] = w; }
}

__device__ void phase_conv(const Params& p, LAS unsigned char* lds) {
    LAS Seg* sg = (LAS Seg*)lds;
    const int tid = otid(), wave = tid >> 6, lane = tid & 63;
    if (tid == 0) build_segs(p, sg);
    __syncthreads();
    LAS float* scr = (LAS float*)(lds + 4096 + wave * 16640);
    const int gw = blockIdx.x * NWAVE + wave, NGW = gridDim.x * NWAVE;
    int total = 0;
    for (int s = 0; s < NSEG; ++s) total += sg[s].nitems;
    for (int it = gw; it < total; it += NGW) {
        int r = it, s = 0;
        while (r >= sg[s].nitems) { r -= sg[s].nitems; ++s; }
        const int K = sg[s].K, nblk = sg[s].ncols / 64, per = (K / 64) * nblk, ri = r / per, within = r - ri * per;
        const size_t doff = (size_t)((const unsigned char*)sg[s].dst - p.ws);
        const bool keep = (doff >= W_SB_IN1 && doff < W_FOX_IN1) || (doff >= W_MEMK && doff < W_UP + (size_t)11264 * 2048 * 2) || (doff >= W_DOWN && doff < W_DOWN + (size_t)2048 * 5632 * 2);
        transpose_item(sg[s].src, sg[s].ldw, K, sg[s].c0 + ri * sg[s].cstride, sg[s].dst + (size_t)ri * sg[s].dstride * K, within, nblk, scr, lane, sg[s].gain, !keep);
    }
    for (int rt = gw; rt < 2048; rt += NGW) {
        const int l = rt >> 9, r = rt & 511; f32x4 y[8];
        rms_row_bf16(p.in[I_MEM] + (size_t)r * 2048, p.in[I_MEM_NORM] + l * 2048, (bf16_t*)(p.ws + OFF_MEMH) + (size_t)rt * 2048, nullptr, lane, y);
    }
    const int gt = blockIdx.x * NTHR + tid, NT = gridDim.x * NTHR;
    for (int i = gt; i < 32 * 128; i += NT) {
        const int h = i >> 7, dist = i & 127; int bucket;
        if (dist < 16) bucket = dist;
        else { const float d = (float)dist; int large = 16 + (int)(logf(d / 16.f) / 2.0794415416798357f * 16.f); bucket = large < 31 ? large : 31; }
        ((float*)(p.ws + OFF_BIAST))[i] = p.in[I_RELB][bucket * 32 + h];
    }
    for (int i = gt; i < 16 * 2048; i += NT) { const int j = i >> 11, k = i & 2047; ((float*)(p.ws + OFF_WF))[i] = p.in[I_FOX_IN][(size_t)k * 6672 + 6144 + j]; }
    for (int i = gt; i < 192 * 2048 / 8; i += NT) ((u32x4*)((bf16_t*)(p.ws + W_MLA_IN) + (size_t)1344 * 2048))[i] = (u32x4){0u, 0u, 0u, 0u};
}

__device__ void phase_norm(const Params& p, const float* xin, const float* g, int mode) {
    const int tid = otid(), wave = tid >> 6, lane = tid & 63;
    const int gw = blockIdx.x * NWAVE + wave, NGW = gridDim.x * NWAVE;
    for (int row = gw; row < T; row += NGW) {
        f32x4 y[8]; float ss = 0.f;
        u32x2* h8 = (u32x2*)((bf16_t*)(p.ws + OFF_H) + (size_t)row * 2048) + lane; u32x2* l8 = (u32x2*)((bf16_t*)(p.ws + OFF_XR) + (size_t)row * 2048) + lane;
        if (mode == 1) {
            const f32x4* xr = (const f32x4*)(xin + (size_t)row * 2048) + lane;
#pragma unroll
            for (int j = 0; j < 8; ++j) y[j] = xr[64 * j];
        } else {
#pragma unroll
            for (int j = 0; j < 8; ++j) { const u32x2 a = h8[64 * j], b = l8[64 * j]; y[j] = (f32x4){bf_lo(a.x) + bf_lo(b.x), bf_hi(a.x) + bf_hi(b.x), bf_lo(a.y) + bf_lo(b.y), bf_hi(a.y) + bf_hi(b.y)}; }
        }
#pragma unroll
        for (int j = 0; j < 8; ++j) ss += (y[j].x * y[j].x + y[j].y * y[j].y) + (y[j].z * y[j].z + y[j].w * y[j].w);
        ss = wave_sum(ss);
        if (mode == 1) {
#pragma unroll
            for (int j = 0; j < 8; ++j) { u32x2 w; w.x = cvt_pk_bf16(y[j].x, y[j].y); w.y = cvt_pk_bf16(y[j].z, y[j].w); h8[64 * j] = w;
                u32x2 wl; wl.x = cvt_pk_bf16(y[j].x - bf_lo(w.x), y[j].y - bf_hi(w.x)); wl.y = cvt_pk_bf16(y[j].z - bf_lo(w.y), y[j].w - bf_hi(w.y)); l8[64 * j] = wl; }
            if (lane < 32) ((float*)(p.ws + OFF_SSQ))[(size_t)row * 32 + lane] = lane == 0 ? ss : 0.f;
            continue;
        }
        const float rs = rsqrtf(ss * (1.f / 2048.f) + 1e-6f);
        const f32x4* gr = (const f32x4*)g + lane;
        if (mode == 3) {
            f32x4* o = (f32x4*)(p.out + (size_t)row * 2048) + lane;
#pragma unroll
            for (int j = 0; j < 8; ++j) o[64 * j] = (y[j] * rs) * gr[64 * j];
            continue;
        }
#pragma unroll
        for (int j = 0; j < 8; ++j) y[j] = (y[j] * rs) * gr[64 * j];
        const float* wf = (const float*)(p.ws + OFF_WF);
        float mine = 0.f;
#pragma unroll 1
        for (int jf = 0; jf < 16; ++jf) {
            const f32x4* wr_ = (const f32x4*)(wf + jf * 2048) + lane; float d = 0.f;
#pragma unroll
            for (int j = 0; j < 8; ++j) { const f32x4 w = wr_[64 * j]; d += (y[j].x * w.x + y[j].y * w.y) + (y[j].z * w.z + y[j].w * w.w); }
            d = wave_sum(d);
            if (lane == jf) mine = d;
        }
        if (lane < 16) { const float xv = mine + p.in[I_FOX_BF][lane]; const float ls = fminf(xv, 0.f) - __logf(1.f + __expf(-fabsf(xv))); ((float*)(p.ws + OFF_LF))[(size_t)row * 16 + lane] = ls; }
    }
}

__device__ void fox_scan(const Params& p, LAS unsigned char* lds) {
    LAS float* sh = (LAS float*)lds; const int tid = otid();
    for (int bh = blockIdx.x; bh < 32; bh += gridDim.x) {
        const int bb = bh >> 4, head = bh & 15; const float* lf = (const float*)(p.ws + OFF_LF); float* lfc = (float*)(p.ws + OFF_LFC) + (size_t)bh * 4096;
        float v[8]; float run = 0.f;
#pragma unroll
        for (int e = 0; e < 8; ++e) { run += lf[(size_t)(bb * 4096 + tid * 8 + e) * 16 + head]; v[e] = run; }
        sh[tid] = run; __syncthreads();
        for (int off = 1; off < 512; off <<= 1) { float x = sh[tid]; if (tid >= off) x += sh[tid - off]; __syncthreads(); sh[tid] = x; __syncthreads(); }
        const float excl = sh[tid] - run;
#pragma unroll
        for (int e = 0; e < 8; ++e) lfc[tid * 8 + e] = excl + v[e];
        __syncthreads();
    }
}

__device__ void ffn_fixup(const Params& p, int layer, int pm) {
    const bf16_t* us = (const bf16_t*)(p.ws + OFF_U); bf16_t* g = (bf16_t*)(p.ws + OFF_G);
    const float* cw = p.in[I_CONVW] + (size_t)layer * 3 * 11264; const float* cb = p.in[I_CONVB] + (size_t)layer * 11264;
    constexpr int NCH = DFF / 8;
    for (int item = otid(); item < 8 * NCH; item += NTHR) {
        const int ri = item / NCH, chunk = item - ri * NCH, c = chunk * 8, w = ri & 1, t = pm * 256 + (ri >> 1) * 64 + w, blk = t >> 6, tl = t & (SEQ - 1);
        const bf16_t* r0 = us + ((size_t)blk * 4 + w) * 11264 + c;
        const bf16_t* r1 = w == 1 ? us + ((size_t)blk * 4 + 0) * 11264 + c : us + ((size_t)(blk - 1) * 4 + 3) * 11264 + c;
        const bf16_t* r2 = w == 1 ? us + ((size_t)(blk - 1) * 4 + 3) * 11264 + c : us + ((size_t)(blk - 1) * 4 + 2) * 11264 + c;
        const bool has1 = tl >= 1, has2 = tl >= 2;
        const u32x4 z4 = (u32x4){0u, 0u, 0u, 0u};
        const u32x4 a0 = *(const u32x4*)r0, b0 = *(const u32x4*)(r0 + DFF);
        const u32x4 a1 = has1 ? *(const u32x4*)r1 : z4, b1 = has1 ? *(const u32x4*)(r1 + DFF) : z4;
        const u32x4 a2 = has2 ? *(const u32x4*)r2 : z4, b2 = has2 ? *(const u32x4*)(r2 + DFF) : z4;
        float o[8];
#pragma unroll
        for (int e = 0; e < 8; ++e) {
            const int q = e >> 1; const bool hi = e & 1;
            const float g0 = hi ? bf_hi(a0[q]) : bf_lo(a0[q]), g1 = hi ? bf_hi(a1[q]) : bf_lo(a1[q]), g2 = hi ? bf_hi(a2[q]) : bf_lo(a2[q]);
            const float v0 = hi ? bf_hi(b0[q]) : bf_lo(b0[q]), v1 = hi ? bf_hi(b1[q]) : bf_lo(b1[q]), v2 = hi ? bf_hi(b2[q]) : bf_lo(b2[q]);
            const float cg = cb[c + e] + cw[c + e] * g2 + cw[11264 + c + e] * g1 + cw[22528 + c + e] * g0;
            const float cv = cb[DFF + c + e] + cw[DFF + c + e] * v2 + cw[11264 + DFF + c + e] * v1 + cw[22528 + DFF + c + e] * v0;
            o[e] = cg / (1.f + __expf(-cg)) * cv;
        }
        u32x4 wv; wv.x = cvt_pk_bf16(o[0], o[1]); wv.y = cvt_pk_bf16(o[2], o[3]); wv.z = cvt_pk_bf16(o[4], o[5]); wv.w = cvt_pk_bf16(o[6], o[7]);
        *(u32x4*)(g + (size_t)t * DFF + c) = wv;
    }
}

__device__ void phase_mla_mid(const Params& p) {
    const int tid = otid(), wave = tid >> 6, lane = tid & 63;
    const int gw = blockIdx.x * NWAVE + wave, NGW = gridDim.x * NWAVE;
    const bf16_t* pr = (const bf16_t*)(p.ws + OFF_PROJ);
    for (int row = gw; row < T; row += NGW) {
        const bf16_t* rp = pr + (size_t)row * 1536;
        { const u32x4 a = *(const u32x4*)(rp + lane * 8); float v[8];
#pragma unroll
          for (int e = 0; e < 4; ++e) { v[2 * e] = bf_lo(a[e]); v[2 * e + 1] = bf_hi(a[e]); }
          float ss = 0.f;
#pragma unroll
          for (int e = 0; e < 8; ++e) ss += v[e] * v[e];
          const float rs = rsqrtf(wave_sum(ss) * (1.f / 512.f) + 1e-6f);
          const f32x4 g0 = *(const f32x4*)(p.in[I_MLA_QN] + lane * 8), g1 = *(const f32x4*)(p.in[I_MLA_QN] + lane * 8 + 4);
          u32x4 w; w.x = cvt_pk_bf16(v[0] * rs * g0[0], v[1] * rs * g0[1]); w.y = cvt_pk_bf16(v[2] * rs * g0[2], v[3] * rs * g0[3]);
          w.z = cvt_pk_bf16(v[4] * rs * g1[0], v[5] * rs * g1[1]); w.w = cvt_pk_bf16(v[6] * rs * g1[2], v[7] * rs * g1[3]);
          *(u32x4*)((bf16_t*)(p.ws + OFF_CQN) + (size_t)row * 512 + lane * 8) = w; }
        { const u32x2 a = *(const u32x2*)(rp + 512 + lane * 4); float v[4] = {bf_lo(a.x), bf_hi(a.x), bf_lo(a.y), bf_hi(a.y)};
          const float ss = v[0] * v[0] + v[1] * v[1] + v[2] * v[2] + v[3] * v[3];
          const float rs = rsqrtf(wave_sum(ss) * (1.f / 256.f) + 1e-6f);
          const f32x4 g0 = *(const f32x4*)(p.in[I_MLA_KVN] + lane * 4);
          u32x2 w; w.x = cvt_pk_bf16(v[0] * rs * g0[0], v[1] * rs * g0[1]); w.y = cvt_pk_bf16(v[2] * rs * g0[2], v[3] * rs * g0[3]);
          *(u32x2*)((bf16_t*)(p.ws + OFF_CKVN) + (size_t)row * 256 + lane * 4) = w; }
        if (lane < 32) {
            const float x1 = __uint_as_float((unsigned)rp[768 + lane] << 16), x2 = __uint_as_float((unsigned)rp[800 + lane] << 16);
            const float pos = (float)((const int*)p.in[I_POS])[row]; float s, c; sincos_big(pos * rope_inv_freq(lane), s, c);
            bf16_t* ko = (bf16_t*)(p.ws + OFF_KPE) + (size_t)row * 64;
            const unsigned w = cvt_pk_bf16(x1 * c - x2 * s, x2 * c + x1 * s);
            ko[lane] = (bf16_t)(w & 0xffffu); ko[32 + lane] = (bf16_t)(w >> 16);
        }
    }
}

struct AttnArgs {
    const bf16_t* q; int ldq, qoff;
    const bf16_t* k; int ldk, koff;
    const bf16_t* k2;
    const bf16_t* vt; int ldvt, vrow0, vcol_base;
    int qrow_base, krow_base;
    bf16_t* o; int ocol;
    int q0;
    const float* lfc; const float* biasrow; float sink; const int* pos;
    float scale;
};

#ifndef NQB_SB
#define NQB_SB 2
#endif
#ifndef NQB_FOX
#define NQB_FOX 2
#endif
#ifndef NQB_SWA
#define NQB_SWA 2
#endif
#ifndef NQB_MLA
#define NQB_MLA 2
#endif
#ifndef NQB_MEM
#define NQB_MEM 1
#endif
template <int MODE, int NQB, int NNB, bool MASKED>
__device__ __forceinline__ void att_scores(f32x4 (&st)[4][NQB], f32x4 (&oacc)[NNB][NQB], float (&mrun)[NQB], float (&lsum)[NQB], float (&carry)[NQB], const float (&ct)[NQB],
                                           int wr0, int r, int quad, int kt, float scale2, LAS unsigned char* tbl) {
    const int key0 = kt * 64 + quad * 4;
#pragma unroll
    for (int qb = 0; qb < NQB; ++qb) {
        const int t = wr0 + qb * 16 + r;
        if (MODE == 0) {
            float gprod[4];
#pragma unroll
            for (int kb = 0; kb < 4; ++kb) {
                float pe = 1.f;
#pragma unroll
                for (int j = 3; j >= 0; --j) {
                    const float u = __builtin_amdgcn_fmed3f(st[kb][qb][j] * scale2, -115.f, 115.f);
                    const float e = fast_exp2(u);
                    float beta = __builtin_amdgcn_rcpf(1.f + e), omb = e * beta;
                    if (MASKED) { const bool valid = (key0 + kb * 16 + j) < t; beta = valid ? beta : 0.f; omb = valid ? omb : 1.f; }
                    st[kb][qb][j] = beta * pe;
                    pe *= omb;
                }
                gprod[kb] = pe;
            }
            float Hh[4], Tt[4];
#pragma unroll
            for (int kb = 0; kb < 4; ++kb) {
                const float g0 = gprod[kb], g1 = __shfl_xor(g0, 16), g2 = __shfl_xor(g0, 32), g3 = __shfl_xor(g0, 48);
                Tt[kb] = (g0 * g1) * (g2 * g3);
                Hh[kb] = (((quad ^ 1) > quad) ? g1 : 1.f) * (((quad ^ 2) > quad) ? g2 : 1.f) * (((quad ^ 3) > quad) ? g3 : 1.f);
            }
            float Bs = carry[qb];
#pragma unroll
            for (int kb = 3; kb >= 0; --kb) {
                const float mul = Hh[kb] * Bs;
#pragma unroll
                for (int j = 0; j < 4; ++j) st[kb][qb][j] *= mul;
                Bs *= Tt[kb];
            }
            carry[qb] = Bs;
        } else {
            float mx = -INFINITY;
#pragma unroll
            for (int kb = 0; kb < 4; ++kb) {
                f32x4 cs = (f32x4){0.f, 0.f, 0.f, 0.f};
                if (MODE == 1) cs = *(const LAS f32x4*)(tbl + (kt * 64 + kb * 16 + quad * 4) * 4);
#pragma unroll
                for (int j = 0; j < 4; ++j) {
                    const int key = key0 + kb * 16 + j;
                    float v = st[kb][qb][j] * scale2;
                    if (MODE == 1) v += ct[qb] - cs[j];
                    if (MODE == 2) { const int dist = t - key; const bool valid = dist >= 0 && dist < 128; const int di = dist < 0 ? 0 : (dist > 127 ? 127 : dist); v += ((const LAS float*)tbl)[di]; v = valid ? v : -INFINITY; }
                    else if (MASKED) v = (key <= t) ? v : -INFINITY;
                    st[kb][qb][j] = v; mx = fmaxf(mx, v);
                }
            }
            mx = fmaxf(mx, __shfl_xor(mx, 16)); mx = fmaxf(mx, __shfl_xor(mx, 32));
            const float m_old = mrun[qb], m_new = fmaxf(m_old, mx), m_use = (m_new == -INFINITY) ? 0.f : m_new;
            const float alpha = fast_exp2(m_old - m_use);
            mrun[qb] = m_new;
            float ps = 0.f;
#pragma unroll
            for (int kb = 0; kb < 4; ++kb)
#pragma unroll
                for (int j = 0; j < 4; ++j) { const float pv = fast_exp2(st[kb][qb][j] - m_use); st[kb][qb][j] = pv; ps += pv; }
            lsum[qb] = lsum[qb] * alpha + ps;
            if (RESCALE_ALWAYS || __builtin_amdgcn_ballot_w64(m_new != m_old) != 0ull) {
#pragma unroll
                for (int nb = 0; nb < NNB; ++nb) oacc[nb][qb] = oacc[nb][qb] * alpha;
            }
        }
    }
}

template <int MODE, int NQB>
__device__ __forceinline__ void attn_item(LAS unsigned char* lds, const AttnArgs& a) {
    constexpr int WROWS = 16 * NQB, QR = 128 * NQB;
    constexpr int DK = (MODE == 2) ? 64 : (MODE == 3 ? 192 : 128);
    constexpr int DV = (MODE == 2) ? 64 : 128;
    constexpr int NKK = DK / 32, NNB = DV / 16;
    constexpr int K128_BYTES = (MODE == 2) ? 0 : 16384;
    constexpr int K64_BYTES = (MODE == 2 || MODE == 3) ? 8192 : 0;
    constexpr int KT_BYTES = K128_BYTES + K64_BYTES, VT_BYTES = DV * 128, BUF_BYTES = KT_BYTES + VT_BYTES + 256;
    constexpr int NP128 = K128_BYTES / 8192, NPV = VT_BYTES / 8192;
    constexpr int NBUF = 3, TBL_OFF = NBUF * BUF_BYTES;
    constexpr int NDMA = NP128 + (K64_BYTES ? 1 : 0) + NPV;
    const int tid = otid(), wave = __builtin_amdgcn_readfirstlane(tid >> 6), lane = tid & 63, r = lane & 15, quad = lane >> 4;
    const int wr0 = a.q0 + wave * WROWS;
    int kt_hi, kt_lo, wkt_hi, wkt_lo;
    if (MODE == 4) { kt_lo = 0; kt_hi = 3; wkt_lo = 0; wkt_hi = 3; }
    else if (MODE == 2) { kt_hi = (a.q0 + QR - 1) >> 6; kt_lo = a.q0 >= 128 ? (a.q0 - 128) >> 6 : 0; wkt_hi = (wr0 + WROWS - 1) >> 6; wkt_lo = wr0 >= 127 ? (wr0 - 127) >> 6 : 0; }
    else { kt_hi = (a.q0 + QR - 1) >> 6; kt_lo = 0; wkt_hi = (wr0 + WROWS - 1) >> 6; wkt_lo = 0; }

    unsigned ko128[NP128 > 0 ? NP128 : 1], ko64 = 0, vo[NPV];
#pragma unroll
    for (int i = 0; i < NP128; ++i) { const int s = (wave + 8 * i) * 64 + lane, row = s >> 4, cp = s & 15, c = cp ^ (row & 15); ko128[i] = (unsigned)(row * a.ldk + c * 8) * 2u; }
    if (K64_BYTES) { const int s = wave * 64 + lane, row = s >> 3, cp = s & 7, c = cp ^ ((row >> 1) & 7); ko64 = (unsigned)(row * (MODE == 3 ? 64 : a.ldk) + c * 8) * 2u; }
#pragma unroll
    for (int i = 0; i < NPV; ++i) { const int s = (wave + 8 * i) * 64 + lane, row = s >> 3, cp = s & 7, c = cp ^ ((row >> 1) & 7); vo[i] = (unsigned)(row * a.ldvt + c * 8) * 2u; }
    const int x128 = quad ^ r, x64 = quad ^ (r >> 1), y0 = (quad >> 1) ^ (r >> 1);
    const int krd128 = r * 256, krd64 = r * 128, vrd = r * 128 + (quad & 1) * 8;

    bf16x8 qf[NQB][NKK];
#pragma unroll
    for (int qb = 0; qb < NQB; ++qb) {
        const int t = wr0 + qb * 16 + r;
        const bf16_t* qp = a.q + (size_t)(a.qrow_base + t) * a.ldq + a.qoff;
#pragma unroll
        for (int kk = 0; kk < (MODE == 3 ? 4 : NKK); ++kk) qf[qb][kk] = *(const bf16x8*)(qp + kk * 32 + quad * 8);
        if (MODE == 3) {
            const bf16x8 c1 = *(const bf16x8*)(qp + 128 + quad * 8), c2 = *(const bf16x8*)(qp + 160 + quad * 8);
            const float pos = (float)a.pos[t];
            bf16x8 o1, o2;
#pragma unroll
            for (int e = 0; e < 8; e += 2) {
                float s0, c0, s1, cc1; sincos_big(pos * rope_inv_freq(quad * 8 + e), s0, c0); sincos_big(pos * rope_inv_freq(quad * 8 + e + 1), s1, cc1);
                const float x10 = __uint_as_float((unsigned)(unsigned short)c1[e] << 16), x20 = __uint_as_float((unsigned)(unsigned short)c2[e] << 16);
                const float x11 = __uint_as_float((unsigned)(unsigned short)c1[e + 1] << 16), x21 = __uint_as_float((unsigned)(unsigned short)c2[e + 1] << 16);
                const unsigned wa = cvt_pk_bf16(x10 * c0 - x20 * s0, x11 * cc1 - x21 * s1), wb = cvt_pk_bf16(x20 * c0 + x10 * s0, x21 * cc1 + x11 * s1);
                o1[e] = (short)(wa & 0xffffu); o1[e + 1] = (short)(wa >> 16); o2[e] = (short)(wb & 0xffffu); o2[e + 1] = (short)(wb >> 16);
            }
            qf[qb][NKK - 2] = o1; qf[qb][NKK - 1] = o2;
        }
    }
    f32x4 oacc[NNB][NQB];
#pragma unroll
    for (int nb = 0; nb < NNB; ++nb)
#pragma unroll
        for (int qb = 0; qb < NQB; ++qb) oacc[nb][qb] = (f32x4){0.f, 0.f, 0.f, 0.f};
    float mrun[NQB], lsum[NQB], carry[NQB], ct[NQB];
#pragma unroll
    for (int qb = 0; qb < NQB; ++qb) {
        mrun[qb] = (MODE == 2) ? a.sink * LOG2E : -INFINITY; lsum[qb] = (MODE == 2 && quad == 0) ? 1.f : 0.f; carry[qb] = 1.f;
        ct[qb] = (MODE == 1) ? a.lfc[wr0 + qb * 16 + r] * LOG2E : 0.f;
    }
    if (MODE == 2) { if (tid < 128) ((LAS float*)(lds + TBL_OFF))[tid] = a.biasrow[tid] * LOG2E; }
    const float scale2 = (MODE == 0) ? -a.scale * LOG2E : a.scale * LOG2E;

    const char* kbase = (const char*)(a.k + (size_t)a.krow_base * a.ldk + a.koff);
    const char* k2base = (MODE == 3) ? (const char*)(a.k2 + (size_t)a.krow_base * 64) : kbase;
    const char* vbase = (const char*)(a.vt + (size_t)a.vrow0 * a.ldvt + a.vcol_base);
#define ATT_DMA(kt_, buf_) do { LAS unsigned char* bp = lds + (buf_) * BUF_BYTES + wave * 1024; \
        const char* kg = kbase + (size_t)(kt_) * 64 * a.ldk * 2; \
        _Pragma("unroll") for (int i = 0; i < NP128; ++i) __builtin_amdgcn_global_load_lds((const unsigned*)(kg + ko128[i]), (LAS unsigned*)(bp + i * 8192), 16, 0, 0); \
        if (K64_BYTES) { const char* k2g = (MODE == 3) ? k2base + (size_t)(kt_) * 64 * 64 * 2 : kg; \
            __builtin_amdgcn_global_load_lds((const unsigned*)(k2g + ko64), (LAS unsigned*)(bp + K128_BYTES), 16, 0, 0); } \
        const char* vg = vbase + (size_t)(kt_) * 64 * 2; \
        _Pragma("unroll") for (int i = 0; i < NPV; ++i) __builtin_amdgcn_global_load_lds((const unsigned*)(vg + vo[i]), (LAS unsigned*)(bp + KT_BYTES + i * 8192), 16, 0, 0); \
    } while (0)
#define ATT_WAIT_TILE(more_) do { if (more_) { if (NDMA == 2) asm volatile("s_waitcnt vmcnt(2) lgkmcnt(0)" ::: "memory"); else if (NDMA == 4) asm volatile("s_waitcnt vmcnt(4) lgkmcnt(0)" ::: "memory"); \
            else asm volatile("s_waitcnt vmcnt(5) lgkmcnt(0)" ::: "memory"); } else asm volatile("s_waitcnt vmcnt(0) lgkmcnt(0)" ::: "memory"); \
        __builtin_amdgcn_s_barrier(); asm volatile("" ::: "memory"); } while (0)

    const int n_tiles = kt_hi - kt_lo + 1;
    if (MODE == 1) { const int n4 = (a.q0 + QR) >> 2; for (int i = tid; i < n4; i += NTHR) *(LAS f32x4*)(lds + TBL_OFF + i * 16) = *(const f32x4*)(a.lfc + i * 4) * LOG2E; }
    asm volatile("s_waitcnt vmcnt(0)" ::: "memory");
    ATT_DMA(kt_hi, 0);
    if (n_tiles > 1) ATT_DMA(kt_hi - 1, 1);
    ATT_WAIT_TILE(n_tiles > 1);
    int cur = 0;
    for (int it = 0; it < n_tiles; ++it) {
        const int kt = kt_hi - it;
        if (it + 2 < n_tiles) { const int b2 = cur + 2 >= NBUF ? cur + 2 - NBUF : cur + 2; ATT_DMA(kt - 2, b2); }
        if (kt >= wkt_lo && kt <= wkt_hi) {
            LAS unsigned char* kbuf = lds + cur * BUF_BYTES; LAS unsigned char* vbuf = kbuf + KT_BYTES;
            f32x4 st[4][NQB];
#pragma unroll
            for (int kb = 0; kb < 4; ++kb)
#pragma unroll
                for (int qb = 0; qb < NQB; ++qb) st[kb][qb] = (f32x4){0.f, 0.f, 0.f, 0.f};
#pragma unroll
            for (int kb = 0; kb < 4; ++kb) {
#pragma unroll
                for (int kk = 0; kk < NKK; ++kk) {
                    bf16x8 af;
                    if (MODE == 2) af = *(const LAS bf16x8*)(kbuf + kb * 2048 + krd64 + ((x64 ^ (kk * 4)) * 16));
                    else if (MODE == 3 && kk >= 4) af = *(const LAS bf16x8*)(kbuf + K128_BYTES + kb * 2048 + krd64 + ((x64 ^ ((kk - 4) * 4)) * 16));
                    else af = *(const LAS bf16x8*)(kbuf + kb * 4096 + krd128 + ((x128 ^ (kk * 4)) * 16));
#pragma unroll
                    for (int qb = 0; qb < NQB; ++qb) st[kb][qb] = __builtin_amdgcn_mfma_f32_16x16x32_bf16(af, qf[qb][kk], st[kb][qb], 0, 0, 0);
                }
            }
            const bool need_mask = (MODE == 2) ? true : (MODE == 4) ? false : (kt * 64 + 63 >= wr0);
            if (need_mask) att_scores<MODE, NQB, NNB, true>(st, oacc, mrun, lsum, carry, ct, wr0, r, quad, kt, scale2, lds + TBL_OFF);
            else att_scores<MODE, NQB, NNB, false>(st, oacc, mrun, lsum, carry, ct, wr0, r, quad, kt, scale2, lds + TBL_OFF);
#pragma unroll
            for (int k2 = 0; k2 < 2; ++k2) {
                bf16x8 pf[NQB];
#pragma unroll
                for (int qb = 0; qb < NQB; ++qb) {
                    u32x4 w; w.x = cvt_pk_bf16(st[2 * k2][qb][0], st[2 * k2][qb][1]); w.y = cvt_pk_bf16(st[2 * k2][qb][2], st[2 * k2][qb][3]);
                    w.z = cvt_pk_bf16(st[2 * k2 + 1][qb][0], st[2 * k2 + 1][qb][1]); w.w = cvt_pk_bf16(st[2 * k2 + 1][qb][2], st[2 * k2 + 1][qb][3]);
                    pf[qb] = __builtin_bit_cast(bf16x8, w);
                }
                const int vlo = vrd + ((y0 ^ (k2 * 4)) * 16), vhi = vrd + (((y0 ^ 2) ^ (k2 * 4)) * 16);
#pragma unroll
                for (int nb = 0; nb < NNB; ++nb) {
                    const u32x2 lo = *(const LAS u32x2*)(vbuf + nb * 2048 + vlo), hi = *(const LAS u32x2*)(vbuf + nb * 2048 + vhi);
                    const bf16x8 vf = __builtin_bit_cast(bf16x8, (u32x4){lo.x, lo.y, hi.x, hi.y});
#pragma unroll
                    for (int qb = 0; qb < NQB; ++qb) oacc[nb][qb] = __builtin_amdgcn_mfma_f32_16x16x32_bf16(vf, pf[qb], oacc[nb][qb], 0, 0, 0);
                }
            }
        }
        ATT_WAIT_TILE(it + 2 < n_tiles);
        cur = cur + 1 == NBUF ? 0 : cur + 1;
    }
#undef ATT_DMA
#undef ATT_WAIT_TILE
#pragma unroll
    for (int qb = 0; qb < NQB; ++qb) {
        float inv = 1.f;
        if (MODE != 0) { float l = lsum[qb]; l += __shfl_xor(l, 16); l += __shfl_xor(l, 32); inv = 1.f / l; }
        const int t = wr0 + qb * 16 + r;
        bf16_t* op = a.o + (size_t)(a.qrow_base + t) * ATTW + a.ocol + quad * 4;
#pragma unroll
        for (int nb = 0; nb < NNB; ++nb) { const f32x4 v = oacc[nb][qb] * inv; u32x2 w; w.x = cvt_pk_bf16(v[0], v[1]); w.y = cvt_pk_bf16(v[2], v[3]); *(u32x2*)(op + nb * 16) = w; }
    }
}

__device__ __forceinline__ void mem_attn_item(const Params& p, LAS unsigned char* lds, int layer, int idx, const bf16_t* q, int ldq, int qoff) {
    constexpr int NQBLK = SEQ / (128 * NQB_MEM);
    const int qblk = idx % NQBLK, mh = (idx / NQBLK) & 3, b = idx / (4 * NQBLK);
    AttnArgs a;
    a.q = q; a.ldq = ldq; a.qoff = qoff + mh * 128;
    a.k = (const bf16_t*)(p.ws + OFF_MEMK); a.ldk = 2048; a.koff = layer * 512 + mh * 128; a.k2 = nullptr;
    a.vt = (const bf16_t*)(p.ws + OFF_MEMVT); a.ldvt = 2048; a.vrow0 = layer * 512 + mh * 128; a.vcol_base = layer * 512 + b * 256;
    a.qrow_base = b * SEQ; a.krow_base = layer * 512 + b * 256;
    a.o = (bf16_t*)(p.ws + OFF_ATT); a.ocol = 2048 + mh * 128; a.q0 = qblk * 128 * NQB_MEM;
    a.lfc = nullptr; a.biasrow = nullptr; a.sink = 0.f; a.pos = nullptr; a.scale = 0.08838834764831845f;
    attn_item<4, NQB_MEM>(lds, a);
}

__device__ void phase_attn(const Params& p, LAS unsigned char* lds, int layer) {
    const bf16_t* proj = (const bf16_t*)(p.ws + OFF_PROJ);
    if (layer == 2) {
        constexpr int NQBLK = SEQ / (128 * NQB_SWA);
        for (int idx = blockIdx.x; idx < 64 * NQBLK; idx += gridDim.x) {
            const int qblk = idx % NQBLK, head = (idx / NQBLK) & 31, b = idx / (32 * NQBLK), kvh = head >> 3;
            AttnArgs a;
            a.q = proj; a.ldq = 2816; a.qoff = head * 64;
            a.k = proj; a.ldk = 2816; a.koff = 2048 + kvh * 64; a.k2 = nullptr;
            a.vt = (const bf16_t*)(p.ws + OFF_VT); a.ldvt = T; a.vrow0 = kvh * 64; a.vcol_base = b * SEQ;
            a.qrow_base = b * SEQ; a.krow_base = b * SEQ;
            a.o = (bf16_t*)(p.ws + OFF_ATT); a.ocol = head * 64; a.q0 = qblk * 128 * NQB_SWA;
            a.lfc = nullptr; a.biasrow = (const float*)(p.ws + OFF_BIAST) + head * 128; a.sink = p.in[I_SWA_SINKS][head]; a.pos = nullptr; a.scale = 0.125f;
            attn_item<2, NQB_SWA>(lds, a);
        }
    } else {
        const int nqb = layer == 0 ? NQB_SB : layer == 1 ? NQB_FOX : NQB_MLA, NQBLK = SEQ / (128 * nqb);
        for (int ps = blockIdx.x; ps < 32 * (NQBLK / 2); ps += gridDim.x) {
            const int xcd = ps & 7, j = ps >> 3, combo = xcd * 4 + (j & 3), pair = j >> 2, b = combo >> 4, head = combo & 15;
            for (int s = 0; s < 2; ++s) {
                const int qblk = s == 0 ? NQBLK - 1 - pair : pair;
                AttnArgs a;
                a.vt = (const bf16_t*)(p.ws + OFF_VT); a.ldvt = T; a.vrow0 = head * 128; a.vcol_base = b * SEQ;
                a.qrow_base = b * SEQ; a.krow_base = b * SEQ;
                a.o = (bf16_t*)(p.ws + OFF_ATT); a.ocol = head * 128; a.q0 = qblk * 128 * nqb;
                a.lfc = nullptr; a.biasrow = nullptr; a.sink = 0.f; a.pos = nullptr; a.k2 = nullptr;
                if (layer == 3) {
                    a.q = (const bf16_t*)(p.ws + OFF_Q3); a.ldq = 3072; a.qoff = head * 192;
                    a.k = (const bf16_t*)(p.ws + OFF_KN); a.ldk = 2048; a.koff = head * 128; a.k2 = (const bf16_t*)(p.ws + OFF_KPE);
                    a.pos = (const int*)p.in[I_POS] + b * SEQ; a.scale = 0.07216878364870322f;
                    attn_item<3, NQB_MLA>(lds, a);
                } else {
                    a.q = proj; a.ldq = 4608; a.qoff = head * 128;
                    a.k = proj; a.ldk = 4608; a.koff = 2048 + head * 128; a.scale = 0.08838834764831845f;
                    if (layer == 1) { a.lfc = (const float*)(p.ws + OFF_LFC) + (size_t)(b * 16 + head) * 4096; attn_item<1, NQB_FOX>(lds, a); }
                    else attn_item<0, NQB_SB>(lds, a);
                }
            }
        }
    }
    for (int idx = blockIdx.x; idx < 8 * (SEQ / (128 * NQB_MEM)); idx += gridDim.x) {
        if (layer == 2) mem_attn_item(p, lds, layer, idx, proj, 2816, 2304);
        else if (layer == 3) mem_attn_item(p, lds, layer, idx, proj, 1536, 832);
        else mem_attn_item(p, lds, layer, idx, proj, 4608, 4096);
    }
}

enum { K_GIN = 0, K_ATT, K_GOUT, K_NORMF, K_GUP, K_CONVG, K_GDOWN, K_NORMA, K_MID, K_G2, K_FINAL, K_CONV, K_NORM0 };

__device__ __forceinline__ bool get_gemm(const Params& p, int kind, int layer, int gi, GemmDesc& d) {
    unsigned char* ws = p.ws;
    d.kind = 0; d.O = nullptr; d.X = nullptr; d.diag = 0; d.smode = 0;
    const bf16_t* h = (const bf16_t*)(ws + OFF_H);
    if (kind == K_GIN && layer == 0 && gi >= 2) {
        gi -= 2;
        if (gi == 0) { d.A = (const bf16_t*)(ws + OFF_MEMH); d.Bt = (const bf16_t*)(ws + W_MEMK); d.M = 2048; d.N = 2048; d.K = 2048; d.O = (bf16_t*)(ws + OFF_MEMK); d.ldc = 2048; d.diag = 1; return true; }
        if (gi == 1) { d.A = (const bf16_t*)(ws + W_MEMV); d.Bt = (const bf16_t*)(ws + OFF_MEMH); d.M = 2048; d.N = 2048; d.K = 2048; d.O = (bf16_t*)(ws + OFF_MEMVT); d.ldc = 2048; d.diag = 1; return true; }
        return false;
    }
    if (kind == K_GIN) {
        const size_t w1 = layer == 0 ? W_SB_IN1 : layer == 1 ? W_FOX_IN1 : layer == 2 ? W_SWA_IN1 : W_MLA_IN;
        const size_t wv = layer == 0 ? W_SB_V : layer == 1 ? W_FOX_V : W_SWA_V;
        const int n1 = layer < 2 ? 4608 : layer == 2 ? 2816 : 1536; const int mv = layer < 2 ? 2048 : layer == 2 ? 256 : 0;
        if (gi == 0) { d.A = h; d.Bt = (const bf16_t*)(ws + w1); d.M = T; d.N = n1; d.K = 2048; d.O = (bf16_t*)(ws + OFF_PROJ); d.ldc = n1; d.smode = 1; return true; }
        if (gi == 1 && mv) { d.A = (const bf16_t*)(ws + wv); d.Bt = h; d.M = mv; d.N = T; d.K = 2048; d.O = (bf16_t*)(ws + OFF_VT); d.ldc = T; d.smode = 2; return true; }
        return false;
    }
    if (kind == K_G2) {
        if (gi == 0) { d.A = (const bf16_t*)(ws + OFF_CQN); d.Bt = (const bf16_t*)(ws + W_MLA_UQ); d.M = T; d.N = 3072; d.K = 512; d.O = (bf16_t*)(ws + OFF_Q3); d.ldc = 3072; return true; }
        if (gi == 1) { d.A = (const bf16_t*)(ws + OFF_CKVN); d.Bt = (const bf16_t*)(ws + W_MLA_KN); d.M = T; d.N = 2048; d.K = 256; d.O = (bf16_t*)(ws + OFF_KN); d.ldc = 2048; return true; }
        if (gi == 2) { d.A = (const bf16_t*)(ws + W_MLA_V); d.Bt = (const bf16_t*)(ws + OFF_CKVN); d.M = 2048; d.N = T; d.K = 256; d.O = (bf16_t*)(ws + OFF_VT); d.ldc = T; return true; }
        return false;
    }
    if (kind == K_GOUT) {
        if (gi) return false;
        const size_t wo = layer == 0 ? W_SB_OUT : layer == 1 ? W_FOX_OUT : layer == 2 ? W_SWA_OUT : W_MLA_OUT;
        d.A = (const bf16_t*)(ws + OFF_ATT); d.Bt = (const bf16_t*)(ws + wo); d.M = T; d.N = 2048; d.K = 2560; d.kind = 1; d.X = (float*)(ws + OFF_XR); d.ldc = 2048; return true;
    }
    if (kind == K_GUP) {
        if (gi) return false;
        d.A = h; d.Bt = (const bf16_t*)(ws + W_UP) + (size_t)layer * 11264 * 2048; d.M = T; d.N = 11264; d.K = 2048; d.kind = 2; d.ldc = 11264; d.smode = 1; return true;
    }
    if (kind == K_GDOWN) {
        if (gi) return false;
        d.A = (const bf16_t*)(ws + OFF_G); d.Bt = (const bf16_t*)(ws + W_DOWN) + (size_t)layer * 2048 * 5632; d.M = T; d.N = 2048; d.K = 5632; d.kind = 1; d.X = (float*)(ws + OFF_XR); d.ldc = 2048; return true;
    }
    return false;
}

constexpr int N_PHASES = 1 + 6 + 5 + 5 + 8;
__device__ __forceinline__ void decode_phase(int ph, int& kind, int& layer) {
    if (ph == 0) { kind = K_CONV; layer = 0; return; }
    const int q = ph - 1;
    if (q < 16) {
        int k;
        if (q < 6) { layer = 0; k = q; } else if (q < 11) { layer = 1; k = q - 6; } else { layer = 2; k = q - 11; }
        kind = k == 0 ? K_GIN : k == 1 ? K_ATT : k == 2 ? K_GOUT : k == 3 ? K_GUP : k == 4 ? K_GDOWN : K_NORMA;
        return;
    }
    layer = 3; const int k = q - 16;
    kind = k == 0 ? K_GIN : k == 1 ? K_MID : k == 2 ? K_G2 : k == 3 ? K_ATT : k == 4 ? K_GOUT : k == 5 ? K_GUP : k == 6 ? K_GDOWN : K_FINAL;
}

__global__ void __launch_bounds__(NTHR, 2) fwd_megakernel(Params p) {
    extern __shared__ __attribute__((aligned(16))) unsigned char shm[];
    LAS unsigned char* lds = (LAS unsigned char*)shm;
    volatile LAS unsigned* xst = (volatile LAS unsigned*)(lds + LDS_BYTES - 16);
    if (threadIdx.x == 0) { xst[0] = 0u; xst[1] = 0u; xst[2] = 0u; xst[3] = 0u; }
    __syncthreads();
    const XcdBarrier xb = xcd_barrier_post((unsigned*)(p.ws + OFF_BAR), xst);
    for (int ph = p.ph_lo; ph < p.ph_hi; ++ph) {
        if (ph != p.ph_lo) { if (ph == p.ph_lo + 1) cg::this_grid().sync(); else xcd_barrier(xb); }
        int kind, layer; decode_phase(ph, kind, layer);
        if (kind == K_CONV) { phase_conv(p, lds); phase_norm(p, p.in[I_X], p.in[I_ATTN_NORM], 1); }
        else if (kind == K_NORMA) phase_norm(p, (const float*)(p.ws + OFF_XR), p.in[I_ATTN_NORM] + 1 * 2048, 2);
        else if (kind == K_FINAL) phase_norm(p, (const float*)(p.ws + OFF_XR), p.in[I_FINAL_NORM], 3);
        else if (kind == K_MID) phase_mla_mid(p);
        else if (kind == K_ATT) { for (int rep = 0; rep < PROBE_ATT_REPS; ++rep) { if (rep) xcd_barrier(xb); phase_attn(p, lds, layer); } }
        else if (kind == K_GIN && layer == 1) fox_scan(p, lds);
        if (kind == K_GIN || kind == K_G2 || kind == K_GOUT || kind == K_GUP || kind == K_GDOWN) {
            if (kind == K_GDOWN) {
                pg8::Order S0; S0.init(T, 2048, (int)gridDim.x, (int)blockIdx.x, 0); pg8::Unit u0;
                for (int i = 0; S0.next(i, u0); ++i) ffn_fixup(p, layer, u0.pm);
                asm volatile("s_waitcnt vmcnt(0)" ::: "memory");
            }
            const int greps = (kind == K_GIN || kind == K_G2 || kind == K_GUP) ? PROBE_GEMM_REPS : 1;
            for (int grep_ = 0; grep_ < greps; ++grep_) {
            if (grep_) xcd_barrier(xb);
            __syncthreads();
            int shift = 0;
            for (int gi = 0; gi < 4; ++gi) {
                GemmDesc d, d2; d2.M = 0; d2.N = 0; d2.A = nullptr; d2.Bt = nullptr; d2.O = nullptr; d2.ldc = 0; d2.smode = 0;
                if (!get_gemm(p, kind, layer, gi, d)) break;
                const bool merged = (kind == K_GIN && gi == 0) ? get_gemm(p, kind, layer, 1, d2) : false;
                pg8::Order S; const int G = (int)gridDim.x;
                S.init(d.M, d.N, G, (int)((blockIdx.x + G - shift) % G), d.diag, merged ? d2.M : 0, merged ? d2.N : 0);
                pg8::Epi E; E.kind = d.kind; E.smode = d.smode; E.O = d.O; E.X = d.X; E.XB = (bf16_t*)(p.ws + OFF_H); E.ssq = (float*)(p.ws + OFF_SSQ); E.ldc = d.ldc; E.lds = lds;
                E.cw = p.in[I_CONVW] + (size_t)layer * 3 * 11264; E.cb = p.in[I_CONVB] + (size_t)layer * 11264; E.G = (bf16_t*)(p.ws + OFF_G); E.US = (bf16_t*)(p.ws + OFF_U);
                pg8::Gemm g; g.A = d.A; g.Bt = d.Bt; g.M = d.M; g.N = d.N; g.K = d.K; g.A2 = d2.A; g.Bt2 = d2.Bt;
                E.O2 = d2.O; E.ldc2 = d2.ldc; E.smode2 = d2.smode;
                if (d.kind == 0) pg8::gemm_phase<0>(lds, g, S, E); else if (d.kind == 1) pg8::gemm_phase<1>(lds, g, S, E); else pg8::gemm_phase<2>(lds, g, S, E);
                const int nu = (d.diag ? 16 : (d.M / 256) * (d.N / 256)) + (merged ? (d2.M / 256) * (d2.N / 256) : 0);
                shift = ((shift + nu) % G) & ~7;
                if (merged) ++gi;
            }
            }
        }
    }
}

extern "C" void kernel_launch(void* const* d_in, const int* in_sizes, int n_in, void* d_out, int out_size, void* d_ws, size_t ws_size, hipStream_t stream) {
    static int grid = 0;
    if (grid == 0) {
        if (n_in != N_IN || ws_size < WS_END) { fprintf(stderr, "kernel_launch: unexpected n_in %d or ws_size %zu (< %zu)\n", n_in, ws_size, (size_t)WS_END); grid = -1; return; }
        int dev = 0, cus = 0, per_cu = 0;
        hipGetDevice(&dev); hipDeviceGetAttribute(&cus, hipDeviceAttributeMultiprocessorCount, dev);
        if (hipFuncSetAttribute((const void*)fwd_megakernel, hipFuncAttributeMaxDynamicSharedMemorySize, LDS_BYTES) != hipSuccess) { fprintf(stderr, "kernel_launch: hipFuncSetAttribute failed\n"); grid = -1; return; }
        if (hipOccupancyMaxActiveBlocksPerMultiprocessor(&per_cu, (const void*)fwd_megakernel, NTHR, LDS_BYTES) != hipSuccess || per_cu < 1) { fprintf(stderr, "kernel_launch: occupancy query says %d\n", per_cu); per_cu = 1; }
        (void)hipGetLastError();
        grid = cus;
        fprintf(stderr, "kernel_launch: grid %d (cus %d, per_cu %d)\n", grid, cus, per_cu);
    }
    if (grid < 0) return;
    if (hipMemsetAsync((char*)d_ws + OFF_BAR, 0, BAR_BYTES, stream) != hipSuccess) { fprintf(stderr, "kernel_launch: memset of barrier words failed\n"); return; }
    Params p{};
    for (int i = 0; i < N_IN; ++i) p.in[i] = (const float*)d_in[i];
    p.out = (float*)d_out; p.ws = (unsigned char*)d_ws;
#if N_LAUNCH_MODE == 1
    p.ph_lo = 0; p.ph_hi = N_PHASES;
    void* args[] = {&p};
    hipError_t e = hipLaunchCooperativeKernel((const void*)fwd_megakernel, dim3(grid), dim3(NTHR), args, LDS_BYTES, stream);
    if (e != hipSuccess) fprintf(stderr, "cooperative launch failed: %s (grid %d)\n", hipGetErrorString(e), grid);
#else
    for (int ph = 0; ph < N_PHASES; ++ph) {
        p.ph_lo = ph; p.ph_hi = ph + 1;
        hipLaunchKernelGGL(fwd_megakernel, dim3(grid), dim3(NTHR), LDS_BYTES, stream, p);
    }
#endif
}
```
